# Optimizing an MI355X kernel written in HIP

```python
import math
import jax, jax.numpy as jnp
from jax import lax
import numpy as np

D_MODEL = 1024
BATCH = 16
SEQ = 2048
DEPTH = 2

N_META = 16
BLOCK = 128
PAD_FRONT = BLOCK - N_META

ATT_HEADS = 8
ATT_KV_HEADS = 2
ATT_HEAD_DIM = 64
ATT_WIDTH = ATT_HEADS * ATT_HEAD_DIM
ATT_KV_WIDTH = ATT_KV_HEADS * ATT_HEAD_DIM
WINDOW = 128
N_BUCKETS = 32
MAX_EXACT = N_BUCKETS // 2
MAX_DISTANCE = 128

RET_HEADS = 4
RET_HEAD_DIM = 128
RET_WIDTH = RET_HEADS * RET_HEAD_DIM
ROT_BASE = 10000.0

CONV_WIDTH = 512
CONV_K = 3

N_BRANCH = 3
BRANCH_WIDTH = 512
SPLITS = (ATT_WIDTH, ATT_KV_WIDTH, ATT_KV_WIDTH, ATT_WIDTH,
          RET_WIDTH, RET_WIDTH, RET_WIDTH, RET_WIDTH,
          CONV_WIDTH, CONV_WIDTH, CONV_WIDTH, CONV_WIDTH,
          N_BRANCH * D_MODEL)
PROJ_WIDTH = 8448
RMS_EPS = 1e-6
GN_EPS = 1e-6
NEG_INF = -1e30

kernel_name = "hybrid_gated_swa_retention_shortconv"


def _split_points():
    return [int(v) for v in np.cumsum(SPLITS)[:-1]]


def rms_norm(x, g):
    xf = x.astype(jnp.float32)
    y = xf * lax.rsqrt(jnp.mean(xf * xf, axis=-1, keepdims=True) + RMS_EPS)
    return (y * g.astype(jnp.float32)).astype(x.dtype)


def t5_causal_bucket(dist):
    n = jnp.maximum(dist, 0)
    nf = jnp.maximum(n, 1).astype(jnp.float32)
    large = MAX_EXACT + (jnp.log(nf / MAX_EXACT) / math.log(MAX_DISTANCE / MAX_EXACT)
                         * (N_BUCKETS - MAX_EXACT)).astype(jnp.int32)
    large = jnp.minimum(large, N_BUCKETS - 1)
    return jnp.where(n < MAX_EXACT, n, large)


def sliding_window_attention(q, k, v, sinks, rel_bias, valid):
    B, Lp = q.shape[0], q.shape[1]
    nc = Lp // BLOCK
    G = ATT_HEADS // ATT_KV_HEADS
    qb = q.reshape(B, nc, BLOCK, ATT_KV_HEADS, G, ATT_HEAD_DIM)

    def band(t):
        tb = t.reshape((B, nc, BLOCK) + t.shape[2:])
        prev = jnp.concatenate([jnp.zeros_like(tb[:, :1]), tb[:, :-1]], axis=1)
        return jnp.concatenate([prev, tb], axis=2)

    kb, vb = band(k), band(v)
    vblk = valid.reshape(nc, BLOCK)
    vprev = jnp.concatenate([jnp.zeros_like(vblk[:1]), vblk[:-1]], axis=0)
    valid_band = jnp.concatenate([vprev, vblk], axis=1)

    r = jnp.arange(BLOCK)[:, None]
    c = jnp.arange(2 * BLOCK)[None, :]
    dist = BLOCK + r - c
    in_window = (dist >= 0) & (dist < WINDOW)
    bias = rel_bias[t5_causal_bucket(dist)]
    bias = bias.reshape(BLOCK, 2 * BLOCK, ATT_KV_HEADS, G).transpose(2, 3, 0, 1).astype(jnp.float32)
    mask = in_window[None] & valid_band[:, None, :]

    s = jnp.einsum('bnqhgd,bnkhd->bnhgqk', qb, kb).astype(jnp.float32) * (ATT_HEAD_DIM ** -0.5) + bias
    s = jnp.where(mask[None, :, None, None], s, NEG_INF)
    sink = sinks.astype(jnp.float32).reshape(ATT_KV_HEADS, G)[None, None, :, :, None, None]
    m = jnp.maximum(jnp.max(s, axis=-1, keepdims=True), sink)
    p = jnp.exp(s - m)
    denom = jnp.sum(p, axis=-1, keepdims=True) + jnp.exp(sink - m)
    p = (p / denom).astype(v.dtype)
    o = jnp.einsum('bnhgqk,bnkhd->bnqhgd', p, vb)
    return o.reshape(B, Lp, ATT_WIDTH)


def rotate(t, pos):
    half = t.shape[-1] // 2
    theta = 1.0 / (ROT_BASE ** jnp.linspace(0.0, 1.0, half, dtype=jnp.float32))
    ang = pos.astype(jnp.float32)[:, None] * theta[None, :]
    cos = jnp.cos(ang)[None, :, None, :]
    sin = jnp.sin(ang)[None, :, None, :]
    t1, t2 = t[..., :half].astype(jnp.float32), t[..., half:].astype(jnp.float32)
    return jnp.concatenate([t1 * cos - t2 * sin, t1 * sin + t2 * cos], axis=-1).astype(t.dtype)


def retention(q, k, v, valid, pos):
    B, Lp = q.shape[0], q.shape[1]
    nc = Lp // BLOCK
    q = rotate(q, pos)
    k = rotate(k, pos) * (RET_HEAD_DIM ** -0.5)
    k = k * valid[None, :, None, None].astype(k.dtype)
    log_gamma = jnp.log1p(-(2.0 ** (-5.0 - jnp.arange(RET_HEADS, dtype=jnp.float32))))
    i = jnp.arange(BLOCK, dtype=jnp.float32)
    diff = i[:, None] - i[None, :]
    decay = jnp.where(diff[None] >= 0, jnp.exp(diff[None] * log_gamma[:, None, None]), 0.0)
    zeta = jnp.exp((BLOCK - 1 - i)[None, :] * log_gamma[:, None])
    xi = jnp.exp((i + 1)[None, :] * log_gamma[:, None])
    gamma_chunk = jnp.exp(BLOCK * log_gamma)[None, :, None, None]

    shp = (B, nc, BLOCK, RET_HEADS, RET_HEAD_DIM)
    qc, kc, vc = q.reshape(shp), k.reshape(shp), v.reshape(shp)
    inner_s = jnp.einsum('bnihd,bnjhd->bnhij', qc, kc) * decay
    inner = jnp.einsum('bnhij,bnjhe->bnihe', inner_s, vc)
    chunk_kv = jnp.einsum('bnjhd,bnjhe,hj->nbhde', kc, vc, zeta)

    def step(state, kv):
        return gamma_chunk * state + kv, state

    _, prev_states = lax.scan(step, jnp.zeros_like(chunk_kv[0]), chunk_kv)
    cross = jnp.einsum('bnihd,nbhde,hi->bnihe', qc, prev_states, xi)
    o = (inner + cross).astype(jnp.float32)
    mu = jnp.mean(o, axis=-1, keepdims=True)
    var = jnp.mean(jnp.square(o - mu), axis=-1, keepdims=True)
    o = (o - mu) * lax.rsqrt(var + GN_EPS)
    return o.reshape(B, Lp, RET_WIDTH).astype(q.dtype)


def short_conv_mixer(b_gate, c_gate, x_in, conv_w, valid):
    u = c_gate * x_in * valid[None, :, None].astype(x_in.dtype)
    y = lax.conv_general_dilated(u, conv_w[:, None, :].astype(u.dtype), window_strides=(1,),
                                 padding=[(CONV_K - 1, 0)],
                                 dimension_numbers=('NWC', 'WIO', 'NWC'),
                                 feature_group_count=CONV_WIDTH)
    return b_gate * y


def hybrid_layer(x, valid, pos, rel_bias, g_pre, w_in, conv_w, sinks, w_branch, w_out, g_post):
    B, Lp, _ = x.shape
    h = rms_norm(x, g_pre)
    proj = h @ w_in
    (aq, ak, av, ag, rq, rk, rv, rg, cb, cc, cx, cg, merge) = jnp.split(proj, _split_points(), axis=-1)

    ya = sliding_window_attention(aq.reshape(B, Lp, ATT_HEADS, ATT_HEAD_DIM),
                                  ak.reshape(B, Lp, ATT_KV_HEADS, ATT_HEAD_DIM),
                                  av.reshape(B, Lp, ATT_KV_HEADS, ATT_HEAD_DIM),
                                  sinks, rel_bias, valid) * jax.nn.silu(ag)
    yr = retention(rq.reshape(B, Lp, RET_HEADS, RET_HEAD_DIM),
                   rk.reshape(B, Lp, RET_HEADS, RET_HEAD_DIM),
                   rv.reshape(B, Lp, RET_HEADS, RET_HEAD_DIM), valid, pos) * jax.nn.silu(rg)
    yc = short_conv_mixer(cb, cc, cx, conv_w, valid) * jax.nn.silu(cg)

    branches = jnp.stack([ya, yr, yc], axis=2)
    branch_out = jnp.einsum('blgc,gcd->blgd', branches, w_branch)
    gates = jax.nn.sigmoid(merge.reshape(B, Lp, N_BRANCH, D_MODEL))
    mixed = jnp.sum(gates * branch_out, axis=2) @ w_out
    return x + rms_norm(mixed, g_post).astype(x.dtype)


def setup_inputs(seed: int = 0) -> dict:
    key = jax.random.key(seed)
    ks = jax.random.split(key, 10)
    f32 = jnp.float32
    x = jax.random.normal(ks[0], (BATCH, SEQ, D_MODEL), f32)
    meta_tokens = jax.random.normal(ks[1], (N_META, D_MODEL), f32)
    rel_bias = 0.1 * jax.random.normal(ks[2], (N_BUCKETS, ATT_HEADS), f32)
    norm_pre = 1.0 + 0.01 * jax.random.normal(ks[3], (DEPTH, D_MODEL), f32)
    w_in = jax.random.normal(ks[4], (DEPTH, D_MODEL, PROJ_WIDTH), f32) * (D_MODEL ** -0.5)
    conv_w = jax.random.normal(ks[5], (DEPTH, CONV_K, CONV_WIDTH), f32) * (CONV_K ** -0.5)
    attn_sinks = 0.5 * jax.random.normal(ks[6], (DEPTH, ATT_HEADS), f32)
    w_branch = jax.random.normal(ks[7], (DEPTH, N_BRANCH, BRANCH_WIDTH, D_MODEL), f32) * (BRANCH_WIDTH ** -0.5)
    w_out = jax.random.normal(ks[8], (DEPTH, D_MODEL, D_MODEL), f32) * (D_MODEL ** -0.5)
    norm_post = 1.0 + 0.01 * jax.random.normal(ks[9], (DEPTH, D_MODEL), f32)
    return {"x": x, "meta_tokens": meta_tokens, "rel_bias": rel_bias, "norm_pre": norm_pre,
            "w_in": w_in, "conv_w": conv_w, "attn_sinks": attn_sinks, "w_branch": w_branch,
            "w_out": w_out, "norm_post": norm_post}


def reference(x, meta_tokens, rel_bias, norm_pre, w_in, conv_w, attn_sinks, w_branch, w_out, norm_post):
    B, S, _ = x.shape
    pad = jnp.zeros((B, PAD_FRONT, D_MODEL), x.dtype)
    meta = jnp.broadcast_to(meta_tokens[None].astype(x.dtype), (B, N_META, D_MODEL))
    h = jnp.concatenate([pad, meta, x], axis=1)
    idx = jnp.arange(PAD_FRONT + N_META + S)
    valid = idx >= PAD_FRONT
    pos = idx - PAD_FRONT
    for l in range(DEPTH):
        h = hybrid_layer(h, valid, pos, rel_bias, norm_pre[l], w_in[l], conv_w[l],
                         attn_sinks[l], w_branch[l], w_out[l], norm_post[l])
    return h[:, PAD_FRONT + N_META:]
```

```cpp
#include <hip/hip_runtime.h>
#include <cstdio>
#include <cstdint>
#include <cmath>
namespace pg8 {
#define PG8_LAS __attribute__((address_space(3)))
typedef unsigned short bf16_t;
typedef short bf16x8 __attribute__((ext_vector_type(8)));
typedef float f32x4 __attribute__((ext_vector_type(4)));
typedef unsigned u32x4 __attribute__((ext_vector_type(4)));
constexpr int BM = 256, BK = 64, HALF = 128, HTB = HALF * BK * 2  , STAGE_BYTES = 8 * HTB, NXCD = 8, WGM = 8;

__host__ __device__ __forceinline__ int lds_byte(int r, int c) { const int st = (r >> 4) * 2 + (c >> 5), rr = r & 15, cc = c & 31, ob = rr * 64 + cc * 2; return st * 1024 + (ob ^ (((ob >> 9) & 1) << 5)); }
__host__ __device__ __forceinline__ void stage_rc(int b, int& R, int& C) { const int st = b / 1024, sb = b % 1024, swz = sb ^ (((sb >> 9) & 1) << 5); R = (st >> 1) * 16 + swz / 64; C = (st & 1) * 32 + (swz % 64) / 2; }
__host__ __device__ __forceinline__ int perm32(int rho) { const int n = rho >> 4, i = rho & 15; return 8 * (i >> 2) + 4 * n + (i & 3); }

struct Unit { int pm, pn; };
struct Gemm { const bf16_t* A; const bf16_t* Bt; int M, N, K; };

struct StaticOrder {
    int nM, nN, nwg, G, c;
    __host__ __device__ void init(int M, int N, int G_, int c_) { nM = M / BM; nN = N / BM; nwg = nM * nN; G = G_; c = c_; }
    __host__ __device__ bool next(int i, Unit& u) const {
        const long L = (long)i * G + c; if (L >= nwg) return false;
        int wgid = (int)L; { const int q = nwg / NXCD, r = nwg % NXCD, xcd = wgid % NXCD, off = wgid / NXCD; wgid = (xcd < r ? xcd * (q + 1) : r * (q + 1) + (xcd - r) * q) + off; }
        const int nig = WGM * nN, gid = wgid / nig, fm = gid * WGM, gsz = (nM - fm) < WGM ? (nM - fm) : WGM;
        u.pm = fm + ((wgid % nig) % gsz); u.pn = (wgid % nig) / gsz; return true;
    }
    __device__ __forceinline__ void a_ready(const Unit&) const {}
    __device__ __forceinline__ void done(const Unit&) const {}
};


__device__ __forceinline__ unsigned cvt_pk_bf16(float lo, float hi) { unsigned r; asm volatile("v_cvt_pk_bf16_f32 %0, %1, %2" : "=v"(r) : "v"(lo), "v"(hi)); return r; }
__device__ __forceinline__ float bflo(unsigned w) { return __uint_as_float(w << 16); }
__device__ __forceinline__ float bfhi(unsigned w) { return __uint_as_float(w & 0xffff0000u); }

struct EpiF32 {
    static constexpr bool PERM = false, AFTER_DRAIN = false, MID = false;
    float* C; int ldc;
    __device__ __forceinline__ void operator()(const f32x4 (&acc)[2][2][4][2], const Unit& u, int wr, int wc, int fr, int fq) const {
        const int row0 = u.pm * BM + wr * 64 + fr, col0 = u.pn * BM + wc * 32 + 4 * fq;
#pragma unroll
        for (int ai = 0; ai < 2; ++ai)
#pragma unroll
            for (int m = 0; m < 4; ++m) { float* rowp = C + (size_t)(row0 + ai * HALF + m * 16) * ldc + col0;
#pragma unroll
                for (int bj = 0; bj < 2; ++bj)
#pragma unroll
                    for (int n = 0; n < 2; ++n) *(f32x4*)(rowp + bj * HALF + n * 16) = acc[ai][bj][m][n]; }
    }
};
struct EpiBf16 {
    static constexpr bool PERM = true, AFTER_DRAIN = false, MID = false;
    bf16_t* O; int ldc;
    __device__ __forceinline__ void operator()(const f32x4 (&acc)[2][2][4][2], const Unit& u, int wr, int wc, int fr, int fq) const {
        const int row0 = u.pm * BM + wr * 64 + fr; const int col0 = u.pn * BM + wc * 32 + 8 * fq;
#pragma unroll
        for (int ai = 0; ai < 2; ++ai)
#pragma unroll
            for (int m = 0; m < 4; ++m) { bf16_t* rowp = O + (size_t)(row0 + ai * HALF + m * 16) * ldc + col0;
#pragma unroll
                for (int bj = 0; bj < 2; ++bj) { const f32x4 v0 = acc[ai][bj][m][0], v1 = acc[ai][bj][m][1];
                    u32x4 w; w.x = cvt_pk_bf16(v0[0], v0[1]); w.y = cvt_pk_bf16(v0[2], v0[3]); w.z = cvt_pk_bf16(v1[0], v1[1]); w.w = cvt_pk_bf16(v1[2], v1[3]);
                    *(u32x4*)(rowp + bj * HALF) = w; } }
    }
};
struct EpiGate {
    static constexpr bool PERM = true, AFTER_DRAIN = false, MID = true;
    static constexpr int LDG = 8448;
    bf16_t* O; int ldc; const bf16_t* G;
    __device__ __forceinline__ void scale(f32x4 (&acc)[2][2][4][2], const Unit& u, int which, int wr, int wc, int fr, int fq) const {
        unsigned off0 = ((unsigned)(u.pm * BM + wr * 64 + fr) * (unsigned)LDG + (unsigned)(u.pn * BM + wc * 32 + 8 * fq)) * 2u;
        asm volatile("" : "+v"(off0));
        const char* gb = (const char*)G + (size_t)((which == 3 ? 2 : which - 1) * 1024) * 2;
#pragma unroll
        for (int ai = 0; ai < 2; ++ai)
#pragma unroll
            for (int m = 0; m < 4; ++m) {
#pragma unroll
                for (int bj = 0; bj < 2; ++bj) {
                    const unsigned off = off0 + (unsigned)((ai * HALF + m * 16) * LDG * 2 + bj * HALF * 2);
                    const u32x4 wa = *(const u32x4*)(gb + off);
                    const u32x4 wb = *(const u32x4*)(gb + off + 2048);
                    float a[8] = {bflo(wa.x), bfhi(wa.x), bflo(wa.y), bfhi(wa.y), bflo(wa.z), bfhi(wa.z), bflo(wa.w), bfhi(wa.w)};
                    float b[8] = {bflo(wb.x), bfhi(wb.x), bflo(wb.y), bfhi(wb.y), bflo(wb.z), bfhi(wb.z), bflo(wb.w), bfhi(wb.w)};
                    float f[8];
#pragma unroll
                    for (int e = 0; e < 8; ++e) {
                        const float ea = __expf(-a[e]);
                        if (which == 3) f[e] = __builtin_amdgcn_rcpf(1.0f + ea);
                        else { const float eb = __expf(-b[e]); f[e] = (1.0f + eb) * __builtin_amdgcn_rcpf(1.0f + ea); }
                    }
                    f32x4 v0 = acc[ai][bj][m][0], v1 = acc[ai][bj][m][1];
                    v0[0] *= f[0]; v0[1] *= f[1]; v0[2] *= f[2]; v0[3] *= f[3]; v1[0] *= f[4]; v1[1] *= f[5]; v1[2] *= f[6]; v1[3] *= f[7];
                    acc[ai][bj][m][0] = v0; acc[ai][bj][m][1] = v1; }
                asm volatile("" ::: "memory"); }
    }
    __device__ __forceinline__ void mid(f32x4 (&acc)[2][2][4][2], const Unit& u, int which, int wr, int wc, int fr, int fq) const { scale(acc, u, which, wr, wc, fr, fq); }
    __device__ __forceinline__ void operator()(f32x4 (&acc)[2][2][4][2], const Unit& u, int wr, int wc, int fr, int fq) const {
        scale(acc, u, 3, wr, wc, fr, fq);
        const int row0 = u.pm * BM + wr * 64 + fr; const int col0 = u.pn * BM + wc * 32 + 8 * fq;
#pragma unroll
        for (int ai = 0; ai < 2; ++ai)
#pragma unroll
            for (int m = 0; m < 4; ++m) { bf16_t* rowp = O + (size_t)(row0 + ai * HALF + m * 16) * ldc + col0;
#pragma unroll
                for (int bj = 0; bj < 2; ++bj) { const f32x4 v0 = acc[ai][bj][m][0], v1 = acc[ai][bj][m][1];
                    u32x4 w; w.x = cvt_pk_bf16(v0[0], v0[1]); w.y = cvt_pk_bf16(v0[2], v0[3]); w.z = cvt_pk_bf16(v1[0], v1[1]); w.w = cvt_pk_bf16(v1[2], v1[3]);
                    *(u32x4*)(rowp + bj * HALF) = w; } }
    }
};
template <class Epi, class Sched, bool ALIGN_EPI = false, bool SP2 = false>
__device__ __forceinline__ void gemm_phase(PG8_LAS unsigned char* lds, const Gemm g, const Sched& S, const Epi& E) {
    const int tid = threadIdx.x, wid = __builtin_amdgcn_readfirstlane(tid >> 6), lane = tid & 63, wr = wid >> 2, wc = wid & 3, fr = lane & 15, fq = lane >> 4;
    const int K = g.K, nt = K / BK;
    unsigned voffA[2], voffB[2];
#pragma unroll
    for (int i = 0; i < 2; ++i) { int R, C; stage_rc(tid * 16 + i * 8192, R, C); const int Rb = Epi::PERM ? ((R & ~31) + perm32(R & 31)) : R;
        voffA[i] = (unsigned)(R * K + C) * 2u; voffB[i] = (unsigned)(Rb * K + C) * 2u; }
    const size_t kstep = (size_t)(BK * 2);
    const size_t hstep = (size_t)HALF * K * 2;
    const size_t tstep = 2 * hstep;
    const unsigned ldsw = (unsigned)wid * 1024u;
    const int aoff = lds_byte(wr * 64 + fr, fq * 8), boff = lds_byte(wc * 32 + fr, fq * 8);
#define PG8_SA(b, h) (((b) * 2 + (h)) * HTB)
#define PG8_SB(b, h) ((4 + (b) * 2 + (h)) * HTB)
#define PG8_STAGE(bufoff, gbase, voff) do { _Pragma("unroll") for (int _i = 0; _i < 2; ++_i) \
        __builtin_amdgcn_global_load_lds((const unsigned*)((const char*)(gbase) + (voff)[_i]), (PG8_LAS unsigned*)(lds + (bufoff) + ldsw + _i * 8192), 16, 0, 0); } while (0)
#define PG8_LDA(dst, b, h) do { _Pragma("unroll") for (int m = 0; m < 4; ++m) _Pragma("unroll") for (int k = 0; k < 2; ++k) dst[m][k] = *(const PG8_LAS bf16x8*)(lds + PG8_SA(b, h) + aoff + m * 2048 + k * 1024); } while (0)
#define PG8_LDB(dst, b, h) do { _Pragma("unroll") for (int n = 0; n < 2; ++n) _Pragma("unroll") for (int k = 0; k < 2; ++k) dst[n][k] = *(const PG8_LAS bf16x8*)(lds + PG8_SB(b, h) + boff + n * 2048 + k * 1024); } while (0)
#define PG8_MMA(ai, bj, At, Bt) do { __builtin_amdgcn_s_setprio(1); _Pragma("unroll") for (int m = 0; m < 4; ++m) _Pragma("unroll") for (int n = 0; n < 2; ++n) _Pragma("unroll") for (int k = 0; k < 2; ++k) \
        acc[ai][bj][m][n] = __builtin_amdgcn_mfma_f32_16x16x32_bf16(Bt[n][k], At[m][k], acc[ai][bj][m][n], 0, 0, 0); __builtin_amdgcn_s_setprio(0); } while (0)
#define PG8_WAIT_V(n) asm volatile("s_waitcnt vmcnt(" #n ")" ::: "memory")
#define PG8_WAIT_L(n) asm volatile("s_waitcnt lgkmcnt(" #n ")" ::: "memory")
#define PG8_BAR __builtin_amdgcn_s_barrier()
#define PG8_SCHED __builtin_amdgcn_sched_barrier(0)
    Unit cur, nxt; int ui = 0;
    if (!S.next(0, cur)) return;
    f32x4 acc[2][2][4][2];
#pragma unroll
    for (int a = 0; a < 2; ++a)
#pragma unroll
        for (int b = 0; b < 2; ++b)
#pragma unroll
            for (int m = 0; m < 4; ++m)
#pragma unroll
                for (int n = 0; n < 2; ++n) acc[a][b][m][n] = (f32x4){0.f, 0.f, 0.f, 0.f};
    bf16x8 At[4][2], B0[2][2], B1[2][2];
    const char* cA = (const char*)g.A + (size_t)cur.pm * tstep; const char* cB = (const char*)g.Bt + (size_t)cur.pn * tstep;
    S.a_ready(cur);
    if constexpr (SP2) {
        PG8_STAGE(PG8_SB(0, 0), cB, voffB); PG8_STAGE(PG8_SB(0, 1), cB + hstep, voffB); PG8_STAGE(PG8_SA(0, 0), cA, voffA); PG8_STAGE(PG8_SA(0, 1), cA + hstep, voffA);
        if (wr == 1) PG8_BAR;
        PG8_WAIT_V(2); PG8_BAR;
        PG8_STAGE(PG8_SB(1, 0), cB + kstep, voffB); PG8_STAGE(PG8_SA(1, 0), cA + kstep, voffA); PG8_STAGE(PG8_SB(1, 1), cB + hstep + kstep, voffB);
        PG8_WAIT_V(6); PG8_BAR;
    } else {
        PG8_STAGE(PG8_SB(0, 0), cB, voffB); PG8_STAGE(PG8_SA(0, 0), cA, voffA); PG8_STAGE(PG8_SB(0, 1), cB + hstep, voffB); PG8_STAGE(PG8_SA(0, 1), cA + hstep, voffA);
        if (wr == 1) PG8_BAR;
        PG8_WAIT_V(4); PG8_BAR;
        PG8_STAGE(PG8_SB(1, 0), cB + kstep, voffB); PG8_STAGE(PG8_SA(1, 0), cA + kstep, voffA); PG8_STAGE(PG8_SB(1, 1), cB + hstep + kstep, voffB);
        PG8_WAIT_V(6); PG8_BAR;
    }
    for (;;) {
        const bool has_next = S.next(ui + 1, nxt);
        const char* nA = has_next ? (const char*)g.A + (size_t)nxt.pm * tstep : cA; const char* nB = has_next ? (const char*)g.Bt + (size_t)nxt.pn * tstep : cB;
        const int seg = Epi::MID ? 8 : nt;
        for (int t0 = 0; t0 < nt; t0 += seg) {
        for (int t = t0; t < t0 + seg; t += 2) {
            const bool last = (t == nt - 2);
            const char* a1 = cA + (size_t)(t + 1) * kstep;
            const char* a2 = last ? nA : cA + (size_t)(t + 2) * kstep; const char* b2 = last ? nB : cB + (size_t)(t + 2) * kstep;
            const char* a3 = a2 + kstep; const char* b3 = b2 + kstep;
            if (last && has_next) S.a_ready(nxt);
            if constexpr (SP2) {
            PG8_LDB(B0, 0, 0); PG8_LDB(B1, 0, 1); PG8_SCHED; PG8_LDA(At, 0, 0); PG8_STAGE(PG8_SA(1, 1), a1 + hstep, voffA);
            PG8_WAIT_V(8); PG8_WAIT_L(0); PG8_BAR; PG8_MMA(0, 0, At, B0); PG8_MMA(0, 1, At, B1); PG8_BAR; PG8_SCHED;
            PG8_LDA(At, 0, 1); PG8_STAGE(PG8_SB(0, 0), b2, voffB); PG8_STAGE(PG8_SB(0, 1), b2 + hstep, voffB); PG8_STAGE(PG8_SA(0, 0), a2, voffA);
            PG8_WAIT_V(8); PG8_WAIT_L(0); PG8_BAR; PG8_MMA(1, 0, At, B0); PG8_MMA(1, 1, At, B1); PG8_BAR; PG8_SCHED;
            PG8_LDB(B0, 1, 0); PG8_LDB(B1, 1, 1); PG8_SCHED; PG8_LDA(At, 1, 0); PG8_STAGE(PG8_SA(0, 1), a2 + hstep, voffA);
            PG8_WAIT_V(8); PG8_WAIT_L(0); PG8_BAR; PG8_MMA(0, 0, At, B0); PG8_MMA(0, 1, At, B1); PG8_BAR; PG8_SCHED;
            PG8_LDA(At, 1, 1); PG8_STAGE(PG8_SB(1, 0), b3, voffB); PG8_STAGE(PG8_SB(1, 1), b3 + hstep, voffB); PG8_STAGE(PG8_SA(1, 0), a3, voffA);
            PG8_WAIT_V(8); PG8_WAIT_L(0); PG8_BAR; PG8_MMA(1, 0, At, B0); PG8_MMA(1, 1, At, B1); PG8_BAR; PG8_SCHED;
            } else {
            PG8_LDB(B0, 0, 0); PG8_SCHED; PG8_LDA(At, 0, 0); PG8_STAGE(PG8_SA(1, 1), a1 + hstep, voffA);
            PG8_WAIT_L(8); PG8_BAR; PG8_WAIT_L(0); PG8_MMA(0, 0, At, B0); PG8_BAR; PG8_SCHED;
            PG8_LDB(B1, 0, 1); PG8_STAGE(PG8_SB(0, 0), b2, voffB);
            PG8_BAR; PG8_WAIT_L(0); PG8_MMA(0, 1, At, B1); PG8_BAR;
            PG8_LDA(At, 0, 1); PG8_STAGE(PG8_SA(0, 0), a2, voffA);
            PG8_BAR; PG8_WAIT_L(0); PG8_MMA(1, 0, At, B0); PG8_BAR; PG8_SCHED;
            PG8_STAGE(PG8_SB(0, 1), b2 + hstep, voffB);
            PG8_WAIT_V(6); PG8_BAR; PG8_MMA(1, 1, At, B1); PG8_BAR;
            PG8_LDB(B0, 1, 0); PG8_SCHED; PG8_LDA(At, 1, 0); PG8_STAGE(PG8_SA(0, 1), a2 + hstep, voffA);
            PG8_WAIT_L(8); PG8_BAR; PG8_WAIT_L(0); PG8_MMA(0, 0, At, B0); PG8_BAR; PG8_SCHED;
            PG8_LDB(B1, 1, 1); PG8_STAGE(PG8_SB(1, 0), b3, voffB);
            PG8_BAR; PG8_WAIT_L(0); PG8_MMA(0, 1, At, B1); PG8_BAR;
            PG8_LDA(At, 1, 1); PG8_STAGE(PG8_SA(1, 0), a3, voffA);
            PG8_BAR; PG8_WAIT_L(0); PG8_MMA(1, 0, At, B0); PG8_BAR; PG8_SCHED;
            PG8_STAGE(PG8_SB(1, 1), b3 + hstep, voffB);
            PG8_WAIT_V(6); PG8_BAR; PG8_MMA(1, 1, At, B1); PG8_BAR;
            }
        }
        if constexpr (Epi::MID) { if (t0 + seg < nt) E.mid(acc, cur, t0 / seg + 1, wr, wc, fr, fq); }
        }
        if constexpr (ALIGN_EPI) { if (wr == 0) PG8_BAR; }
        if constexpr (!Epi::AFTER_DRAIN) { E(acc, cur, wr, wc, fr, fq); S.done(cur); }
        if (!has_next) break;
#pragma unroll
        for (int a = 0; a < 2; ++a)
#pragma unroll
            for (int b = 0; b < 2; ++b)
#pragma unroll
                for (int m = 0; m < 4; ++m)
#pragma unroll
                    for (int n = 0; n < 2; ++n) acc[a][b][m][n] = (f32x4){0.f, 0.f, 0.f, 0.f};
        cur = nxt; cA = nA; cB = nB; ++ui;
        if constexpr (ALIGN_EPI) { if (wr == 1) PG8_BAR; }
    }
    PG8_WAIT_V(0);
    if constexpr (!ALIGN_EPI) { if (wr == 0) PG8_BAR; }
    PG8_BAR;
    if constexpr (Epi::AFTER_DRAIN) { E.fused(acc, cur, wr, wc, fr, fq, lds, wid, lane); S.done(cur); }
#undef PG8_SA
#undef PG8_SB
#undef PG8_STAGE
#undef PG8_LDA
#undef PG8_LDB
#undef PG8_MMA
#undef PG8_WAIT_V
#undef PG8_WAIT_L
#undef PG8_BAR
#undef PG8_SCHED
}
}

constexpr int NWAVES = 8, NTHR = 512;
constexpr int D = 1024, BATCH = 16, SEQ = 2048, BLK = 128, NMETA = 16, PADF = 112, LP = 2176, NCH = 17;
constexpr int PW = 8448;
constexpr int HB = 8, MH = HB * LP;
constexpr int C_AQ = 0, C_AK = 512, C_AV = 640, C_AG = 768, C_RQ = 1280, C_RK = 1792, C_RV = 2304, C_RG = 2816, C_CB = 3328, C_CC = 3840, C_CX = 4352, C_CG = 4864, C_MG = 5376;
constexpr int BRW = 1536;
constexpr float RMS_EPS = 1e-6f, GN_EPS = 1e-6f;
constexpr int NSTEPS = 21;

constexpr size_t MiB = 1u << 20;
constexpr size_t WS_CTL = 0, CTL_ZERO_BYTES = 1 * MiB;
constexpr size_t WS_WIN = 1 * MiB, WIN_BYTES = (size_t)PW * D * 2;
constexpr size_t WS_WBR = 34 * MiB, WBR_BYTES = (size_t)D * BRW * 2;
constexpr size_t WS_WOUT = 40 * MiB, WOUT_BYTES = (size_t)D * D * 2;
constexpr size_t WS_ROT = 44 * MiB;
constexpr size_t WS_XN = 46 * MiB;
constexpr size_t WS_BR = 80 * MiB;
constexpr size_t WS_H = 131 * MiB;
constexpr size_t WS_PROJ = 199 * MiB;
constexpr size_t WS_END = 480 * MiB;
static_assert(WS_WIN + 2 * WIN_BYTES <= WS_WBR && WS_WBR + 2 * WBR_BYTES <= WS_WOUT && WS_WOUT + 2 * WOUT_BYTES <= WS_ROT && WS_ROT + (size_t)LP * 64 * 8 <= WS_XN, "ws map 1");
static_assert(WS_XN + (size_t)MH * D * 2 <= WS_BR && WS_BR + (size_t)MH * BRW * 2 <= WS_H && WS_H + (size_t)MH * D * 4 <= WS_PROJ && WS_PROJ + (size_t)MH * PW * 2 <= WS_END, "ws map 2");
constexpr int CW_TMO = 0, CW_CODE = 1, CW_BAR = 4096;

constexpr int RING_OFF = 0, RING_BYTES = 131072;
constexpr int LDSCTL_OFF = RING_BYTES, MISC_OFF = LDSCTL_OFF + 320;
constexpr int LDS_BYTES = 147456;

#define GAS __attribute__((address_space(1)))
#define LAS __attribute__((address_space(3)))
typedef unsigned short bf16;
typedef unsigned v4u __attribute__((ext_vector_type(4)));
typedef unsigned v2u __attribute__((ext_vector_type(2)));
typedef float f32x4 __attribute__((ext_vector_type(4)));
typedef GAS unsigned gu32;
#define RLX_AGENT __ATOMIC_RELAXED, __HIP_MEMORY_SCOPE_AGENT
#define LDS_WAIT() asm volatile("s_waitcnt lgkmcnt(0)" ::: "memory")
#define VM_WAIT() asm volatile("s_waitcnt vmcnt(0)" ::: "memory")
__device__ __forceinline__ unsigned f2bf(float f) { unsigned u = __builtin_bit_cast(unsigned, f); return (u + 0x7fffu + ((u >> 16) & 1u)) >> 16; }
__device__ __forceinline__ unsigned pk2(float lo, float hi) { return f2bf(lo) | (f2bf(hi) << 16); }
__device__ __forceinline__ float bf2f(bf16 h) { return __uint_as_float((unsigned)h << 16); }
__device__ __forceinline__ float bflo(unsigned w) { return __uint_as_float(w << 16); }
__device__ __forceinline__ float bfhi(unsigned w) { return __uint_as_float(w & 0xffff0000u); }
__device__ __forceinline__ float silu(float g) { return g / (1.0f + __expf(-g)); }
__device__ __forceinline__ float wave_sum(float v) {
#pragma unroll
    for (int o = 1; o < 64; o <<= 1) v += __shfl_xor(v, o);
    return v;
}
__device__ __forceinline__ float wave_max(float v) {
#pragma unroll
    for (int o = 1; o < 64; o <<= 1) v = fmaxf(v, __shfl_xor(v, o));
    return v;
}
__device__ __forceinline__ int t5_bucket(int n) {
    return n < 16 ? n : 16 + (n >= 19) + (n >= 21) + (n >= 24) + (n >= 27) + (n >= 31) + (n >= 35) + (n >= 40) + (n >= 46) + (n >= 52) + (n >= 59) + (n >= 67) + (n >= 77) + (n >= 87) + (n >= 99) + (n >= 113);
}

#define XB_TMO      128
#define XB_XCNT(j)  (256  + 64 * (j))
#define XB_XSUB(j)  (1280 + 64 * (j))
#define XB_XGEN(j)  (2304 + 64 * (j))
#define XB_TOP      3328
#define XB_TOPGEN   3392
#define XCD_BAR_WORDS 3456
#define XB_SPIN_CAP (1u << 18)

__device__ __forceinline__ unsigned xb_ld(unsigned* p)              { return __hip_atomic_load(p, __ATOMIC_RELAXED, __HIP_MEMORY_SCOPE_AGENT); }
__device__ __forceinline__ unsigned xb_add(unsigned* p, unsigned v) { return __hip_atomic_fetch_add(p, v, __ATOMIC_RELAXED, __HIP_MEMORY_SCOPE_AGENT); }
__device__ __forceinline__ unsigned xb_xcc_id() { return (unsigned)__builtin_amdgcn_s_getreg((3 << 11) | 20) & 0xFu; }
#define XB_SPIN(cond, bar) do { unsigned _sp = 0; while (cond) { __builtin_amdgcn_s_sleep(1); \
    if ((++_sp & 255u) == 0u) { if (xb_ld(&(bar)[XB_TMO])) break; if (_sp > XB_SPIN_CAP) { atomicAdd(&(bar)[XB_TMO], 1u); break; } } } } while (0)

struct XcdBarrier {
    unsigned* bar; unsigned x;
    volatile LAS unsigned* st;
};

__device__ __forceinline__ XcdBarrier xcd_barrier_post(unsigned* bar, volatile LAS unsigned* st) {
    XcdBarrier b; b.bar = bar; b.x = xb_xcc_id(); b.st = st;
    if (threadIdx.x == 0) (void)xb_add(&bar[XB_XCNT(b.x)], 1u);
    return b;
}
__device__ __forceinline__ void xcd_barrier_complete(unsigned* bar, unsigned x, unsigned& nloc, unsigned& nx) {
    const unsigned G = gridDim.x * gridDim.y * gridDim.z;
    unsigned sum, cnt, mine, sp = 0u;
    for (;;) {
        sum = 0u; cnt = 0u; mine = 0u;
#pragma unroll
        for (unsigned j = 0; j < 16; ++j) { const unsigned c = xb_ld(&bar[XB_XCNT(j)]); sum += c; cnt += (c > 0u) ? 1u : 0u; mine = (j == x) ? c : mine; }
        if (sum == G) break;
        __builtin_amdgcn_s_sleep(1);
        if ((++sp & 255u) == 0u) { if (xb_ld(&bar[XB_TMO])) break; if (sp > XB_SPIN_CAP) { atomicAdd(&bar[XB_TMO], 1u); break; } }
    }
    nloc = mine > 0u ? mine : 1u; nx = cnt > 0u ? cnt : 1u;
}

__device__ __forceinline__ void xcd_barrier(const XcdBarrier& b) {
    asm volatile("s_waitcnt vmcnt(0)" ::: "memory");
    __syncthreads();
    if (threadIdx.x == 0) {
        unsigned* bar = b.bar;
        __builtin_amdgcn_s_waitcnt(0);
        unsigned nloc = b.st[0], nx = b.st[1];
        if (nloc == 0u) { xcd_barrier_complete(bar, b.x, nloc, nx); b.st[0] = nloc; b.st[1] = nx; }
        const unsigned old = xb_add(&bar[XB_XSUB(b.x)], 1u);
        const unsigned gen = old / nloc;
        if (old + 1u == (gen + 1u) * nloc) {
            __builtin_amdgcn_fence(__ATOMIC_RELEASE, "agent");
            asm volatile("s_waitcnt vmcnt(0)" ::: "memory");
            const unsigned og = xb_add(&bar[XB_TOP], 1u);
            const unsigned tg = og / nx;
            if (og + 1u == (tg + 1u) * nx) xb_add(&bar[XB_TOPGEN], 1u);
            else XB_SPIN(xb_ld(&bar[XB_TOPGEN]) == tg, bar);
            __builtin_amdgcn_fence(__ATOMIC_ACQUIRE, "agent");
            xb_add(&bar[XB_XGEN(b.x)], 1u);
            asm volatile("s_waitcnt vmcnt(0)" ::: "memory");
        } else {
            XB_SPIN(xb_ld(&bar[XB_XGEN(b.x)]) == gen, bar);
            __builtin_amdgcn_fence(__ATOMIC_ACQUIRE, "agent");
            asm volatile("s_waitcnt vmcnt(0)" ::: "memory");
        }
    }
    __syncthreads();
}


struct Args { const float* in[10]; float* out; unsigned char* ws; int ph_lo, ph_hi; };

__device__ __forceinline__ void p0_transpose_item(const float* W, int K, int N, bf16* WT, int ldt, int koff, LAS float* scr, int item, int lane) {
    const int nblk = N / 32, kb = item / nblk, nb = item % nblk, k0 = 64 * kb, n0 = 32 * nb;
#pragma unroll 8
    for (int i = 0; i < 32; ++i) { const int kk = 2 * i + (lane >> 5); scr[kk * 33 + (lane & 31)] = W[(size_t)(k0 + kk) * N + n0 + (lane & 31)]; }
    LDS_WAIT(); asm volatile("" ::: "memory");
    const int c = lane & 7;
#pragma unroll
    for (int j = 0; j < 4; ++j) { const int n = (lane >> 3) + 8 * j; const LAS float* s = scr + (8 * c) * 33 + n;
        v4u o; o.x = pk2(s[0 * 33], s[1 * 33]); o.y = pk2(s[2 * 33], s[3 * 33]); o.z = pk2(s[4 * 33], s[5 * 33]); o.w = pk2(s[6 * 33], s[7 * 33]);
        *(GAS v4u*)(WT + (size_t)(n0 + n) * ldt + koff + k0 + 8 * c) = o; }
    LDS_WAIT(); asm volatile("" ::: "memory");
}

__device__ __forceinline__ void rms_row_to_bf16(const f32x4 (&v)[4], const float* g, bf16* orow, int lane) {
    float s2 = 0.f;
#pragma unroll
    for (int j = 0; j < 4; ++j) s2 += (v[j].x * v[j].x + v[j].y * v[j].y) + (v[j].z * v[j].z + v[j].w * v[j].w);
    const float rstd = 1.0f / sqrtf(wave_sum(s2) * (1.f / D) + RMS_EPS);
    GAS v2u* o8 = (GAS v2u*)orow + lane;
#pragma unroll
    for (int j = 0; j < 4; ++j) { const f32x4 gg = ((const f32x4*)g)[lane + 64 * j]; v2u w; w.x = pk2(v[j].x * rstd * gg.x, v[j].y * rstd * gg.y); w.y = pk2(v[j].z * rstd * gg.z, v[j].w * rstd * gg.w); o8[64 * j] = w; }
}
__device__ __forceinline__ void zero_row_bf16(bf16* orow, int lane) {
    GAS v2u* o8 = (GAS v2u*)orow + lane;
#pragma unroll
    for (int j = 0; j < 4; ++j) o8[64 * j] = (v2u){0u, 0u};
}
__device__ __forceinline__ void xn_from_input(const Args& a, int half, int gw, int NGW, int lane) {
    bf16* XN = (bf16*)(a.ws + WS_XN);
    for (int r = gw; r < MH; r += NGW) {
        const int bl = r / LP, idx = r - bl * LP, b = half * HB + bl;
        bf16* orow = XN + (size_t)r * D;
        if (idx < PADF) { zero_row_bf16(orow, lane); continue; }
        const float* src = idx < BLK ? a.in[1] + (size_t)(idx - PADF) * D : a.in[0] + ((size_t)b * SEQ + (idx - BLK)) * D;
        f32x4 v[4];
#pragma unroll
        for (int j = 0; j < 4; ++j) v[j] = ((const f32x4*)src)[lane + 64 * j];
        rms_row_to_bf16(v, a.in[3], orow, lane);
    }
}

__device__ __forceinline__ void p0_prologue(const Args& a, LAS unsigned char* lds, int wave, int lane) {
    LAS float* scr = (LAS float*)(lds + RING_OFF + wave * 16384);
    const int gw = blockIdx.x * NWAVES + wave, NGW = gridDim.x * NWAVES;
    constexpr int I_IN = (D / 64) * (PW / 32), I_BR = (512 / 64) * (D / 32), I_OUT = (D / 64) * (D / 32);
    constexpr int PER_LAYER = I_IN + 3 * I_BR + I_OUT, NITEMS = 2 * PER_LAYER;
    for (int it = gw; it < NITEMS; it += NGW) {
        const int l = it / PER_LAYER; int r = it - l * PER_LAYER;
        if (r < I_IN) { p0_transpose_item(a.in[4] + (size_t)l * D * PW, D, PW, (bf16*)(a.ws + WS_WIN + l * WIN_BYTES), D, 0, scr, r, lane); continue; } r -= I_IN;
        if (r < 3 * I_BR) { const int g = r / I_BR; p0_transpose_item(a.in[7] + ((size_t)l * 3 + g) * 512 * D, 512, D, (bf16*)(a.ws + WS_WBR + l * WBR_BYTES), BRW, g * 512, scr, r - g * I_BR, lane); continue; } r -= 3 * I_BR;
        p0_transpose_item(a.in[8] + (size_t)l * D * D, D, D, (bf16*)(a.ws + WS_WOUT + l * WOUT_BYTES), D, 0, scr, r, lane);
    }
    float* rc = (float*)(a.ws + WS_ROT); float* rs = rc + LP * 64;
    for (int e = (blockIdx.x * NTHR + threadIdx.x); e < LP * 64; e += gridDim.x * NTHR) {
        const int idx = e >> 6, i = e & 63;
        const float lin = (float)i / 63.0f;
        const float theta = (float)(1.0 / pow(10000.0, (double)lin));
        const float ang = (float)(idx - PADF) * theta;
        rc[e] = (float)cos((double)ang); rs[e] = (float)sin((double)ang);
    }
    xn_from_input(a, 0, gw, NGW, lane);
}

__device__ __forceinline__ void p5_norm_residual(const Args& a, int half, int layer, int gw, int NGW, int lane) {
    const float* Y = (const float*)(a.ws + WS_PROJ); float* H = (float*)(a.ws + WS_H); bf16* XN = (bf16*)(a.ws + WS_XN);
    const float* gpost = a.in[9] + layer * D;
    for (int r = gw; r < MH; r += NGW) {
        const int bl = r / LP, idx = r - bl * LP, b = half * HB + bl;
        if (idx < PADF) {
            if (layer == 0) { zero_row_bf16(XN + (size_t)r * D, lane);
#pragma unroll
                for (int j = 0; j < 4; ++j) ((f32x4*)(H + (size_t)r * D))[lane + 64 * j] = (f32x4){0.f, 0.f, 0.f, 0.f}; }
            continue;
        }
        if (layer == 1 && idx < BLK) continue;
        f32x4 y[4], h[4]; float s2 = 0.f;
        const float* hsrc = layer == 0 ? (idx < BLK ? a.in[1] + (size_t)(idx - PADF) * D : a.in[0] + ((size_t)b * SEQ + (idx - BLK)) * D) : H + (size_t)r * D;
#pragma unroll
        for (int j = 0; j < 4; ++j) { y[j] = ((const f32x4*)(Y + (size_t)r * D))[lane + 64 * j]; h[j] = ((const f32x4*)hsrc)[lane + 64 * j]; s2 += (y[j].x * y[j].x + y[j].y * y[j].y) + (y[j].z * y[j].z + y[j].w * y[j].w); }
        const float rstd = 1.0f / sqrtf(wave_sum(s2) * (1.f / D) + RMS_EPS);
#pragma unroll
        for (int j = 0; j < 4; ++j) { const f32x4 gg = ((const f32x4*)gpost)[lane + 64 * j];
            h[j].x += y[j].x * rstd * gg.x; h[j].y += y[j].y * rstd * gg.y; h[j].z += y[j].z * rstd * gg.z; h[j].w += y[j].w * rstd * gg.w; }
        if (layer == 0) {
#pragma unroll
            for (int j = 0; j < 4; ++j) ((f32x4*)(H + (size_t)r * D))[lane + 64 * j] = h[j];
            rms_row_to_bf16(h, a.in[3] + D, XN + (size_t)r * D, lane);
        } else {
            float* orow = a.out + ((size_t)b * SEQ + (idx - BLK)) * D;
#pragma unroll
            for (int j = 0; j < 4; ++j) ((f32x4*)orow)[lane + 64 * j] = h[j];
        }
    }
}

__device__ __forceinline__ void attn_simple(const Args& a, int layer, int wave, int lane) {
    const bf16* PROJ = (const bf16*)(a.ws + WS_PROJ); bf16* BR = (bf16*)(a.ws + WS_BR);
    const float* rel_bias = a.in[2]; const float* sinks = a.in[6] + layer * 8;
    const int gw = blockIdx.x * NWAVES + wave, NGW = gridDim.x * NWAVES;
    for (int task = gw; task < MH * 8; task += NGW) {
        const int r = task >> 3, hq = task & 7, hk = hq >> 2;
        const int idx = r % LP;
        bf16* op = BR + (size_t)r * BRW + hq * 64 + lane;
        if (idx < PADF) { *op = 0; continue; }
        const bf16* prow = PROJ + (size_t)r * PW;
        float q[64];
#pragma unroll
        for (int c = 0; c < 8; ++c) { const v4u w = ((const v4u*)(prow + C_AQ + hq * 64))[c];
            q[8 * c + 0] = bflo(w.x); q[8 * c + 1] = bfhi(w.x); q[8 * c + 2] = bflo(w.y); q[8 * c + 3] = bfhi(w.y); q[8 * c + 4] = bflo(w.z); q[8 * c + 5] = bfhi(w.z); q[8 * c + 6] = bflo(w.w); q[8 * c + 7] = bfhi(w.w); }
        float s[2];
#pragma unroll
        for (int t = 0; t < 2; ++t) {
            const int dist = t * 64 + lane; float acc = 0.f;
            if (idx - dist >= PADF) {
                const v4u* kp = (const v4u*)(PROJ + (size_t)(r - dist) * PW + C_AK + hk * 64);
#pragma unroll
                for (int c = 0; c < 8; ++c) { const v4u w = kp[c];
                    acc += q[8 * c + 0] * bflo(w.x) + q[8 * c + 1] * bfhi(w.x) + q[8 * c + 2] * bflo(w.y) + q[8 * c + 3] * bfhi(w.y) + q[8 * c + 4] * bflo(w.z) + q[8 * c + 5] * bfhi(w.z) + q[8 * c + 6] * bflo(w.w) + q[8 * c + 7] * bfhi(w.w); }
                s[t] = acc * 0.125f + rel_bias[t5_bucket(dist) * 8 + hq];
            } else s[t] = -1e30f;
        }
        const float sink = sinks[hq];
        const float m = fmaxf(wave_max(fmaxf(s[0], s[1])), sink);
        const float e0 = __expf(s[0] - m), e1 = __expf(s[1] - m);
        const float denom = wave_sum(e0 + e1) + __expf(sink - m);
        const float p0 = e0 / denom, p1 = e1 / denom;
        float o = 0.f;
        for (int dist = 0; dist < 128; ++dist) {
            const float pj = __shfl(dist < 64 ? p0 : p1, dist & 63);
            if (idx - dist >= PADF) o += pj * bf2f(PROJ[(size_t)(r - dist) * PW + C_AV + hk * 64 + lane]);
        }
        const float g = bf2f(prow[C_AG + hq * 64 + lane]);
        *op = (bf16)f2bf(o * silu(g));
    }
}
__device__ __forceinline__ void conv_simple(const Args& a, int layer) {
    const bf16* PROJ = (const bf16*)(a.ws + WS_PROJ); bf16* BR = (bf16*)(a.ws + WS_BR);
    const float* cw = a.in[5] + layer * 3 * 512;
    for (int i = blockIdx.x * NTHR + threadIdx.x; i < MH * 512; i += gridDim.x * NTHR) {
        const int r = i >> 9, c = i & 511, idx = r % LP;
        bf16* op = BR + (size_t)r * BRW + 1024 + c;
        if (idx < PADF) { *op = 0; continue; }
        const bf16* p = PROJ + (size_t)r * PW + c;
        const float u0 = bf2f(p[C_CC]) * bf2f(p[C_CX]);
        const float u1 = idx - 1 >= PADF ? bf2f(p[C_CC - PW]) * bf2f(p[C_CX - PW]) : 0.f;
        const float u2 = idx - 2 >= PADF ? bf2f(p[C_CC - 2 * PW]) * bf2f(p[C_CX - 2 * PW]) : 0.f;
        const float y = cw[2 * 512 + c] * u0 + cw[512 + c] * u1 + cw[c] * u2;
        *op = (bf16)f2bf(bf2f(p[C_CB]) * y * silu(bf2f(p[C_CG])));
    }
}
__device__ __forceinline__ void ret_simple(const Args& a, int unit, LAS unsigned char* lds, int wave, int lane) {
    const bf16* PROJ = (const bf16*)(a.ws + WS_PROJ); bf16* BR = (bf16*)(a.ws + WS_BR);
    const float* rc = (const float*)(a.ws + WS_ROT); const float* rs = rc + LP * 64;
    LAS float* qs = (LAS float*)lds; LAS float* ks = qs + 128; LAS float* vs = ks + 128; LAS float* red = vs + 128; LAS float* stat = red + 512;
    const int tid = threadIdx.x, bl = unit >> 2, h = unit & 3, e = tid & 127, dg = tid >> 7;
    const float gamma = 1.0f - exp2f(-5.0f - (float)h);
    float S[32];
#pragma unroll
    for (int i = 0; i < 32; ++i) S[i] = 0.f;
    if (tid < 128) for (int idx = 0; idx < PADF; ++idx) BR[(size_t)(bl * LP + idx) * BRW + 512 + h * 128 + tid] = 0;
    for (int idx = PADF; idx < LP; ++idx) {
        const int r = bl * LP + idx; const bf16* prow = PROJ + (size_t)r * PW;
        if (tid < 384) {
            const int which = tid >> 7, d = tid & 127;
            if (which == 2) vs[d] = bf2f(prow[C_RV + h * 128 + d]);
            else { const int base = (which == 0 ? C_RQ : C_RK) + h * 128, i = d & 63; const float c = rc[idx * 64 + i], s = rs[idx * 64 + i];
                const float t1 = bf2f(prow[base + i]), t2 = bf2f(prow[base + 64 + i]);
                float val = d < 64 ? t1 * c - t2 * s : t1 * s + t2 * c;
                if (which == 1) { val *= 0.08838834764831845f; ks[d] = val; } else qs[d] = val; }
        }
        __syncthreads();
        float part = 0.f; const float ve = vs[e];
#pragma unroll
        for (int i = 0; i < 32; ++i) { S[i] = gamma * S[i] + ks[dg * 32 + i] * ve; part += qs[dg * 32 + i] * S[i]; }
        red[dg * 128 + e] = part;
        __syncthreads();
        float o = 0.f, dv = 0.f;
        if (tid < 128) { o = (red[e] + red[128 + e]) + (red[256 + e] + red[384 + e]); const float ws_ = wave_sum(o); if (lane == 0) stat[wave] = ws_; }
        __syncthreads();
        if (tid < 128) { const float mu = (stat[0] + stat[1]) * (1.f / 128.f); dv = o - mu; const float wq = wave_sum(dv * dv); if (lane == 0) stat[2 + wave] = wq; }
        __syncthreads();
        if (tid < 128) { const float var = (stat[2] + stat[3]) * (1.f / 128.f); const float on = dv / sqrtf(var + GN_EPS);
            BR[(size_t)r * BRW + 512 + h * 128 + e] = (bf16)f2bf(on * silu(bf2f(prow[C_RG + h * 128 + e]))); }
    }
    __syncthreads();
}

#ifndef MK_PER_STEP
#define MK_PER_STEP 1
#endif
__global__ void __launch_bounds__(NTHR, 2) fwd_kernel(Args args) {
    extern __shared__ __attribute__((aligned(16))) unsigned char lds_raw[];
    LAS unsigned char* lds = (LAS unsigned char*)lds_raw;
    volatile LAS unsigned* MISC = (volatile LAS unsigned*)(lds + MISC_OFF);
    const int tid = threadIdx.x, lane = tid & 63, wave = __builtin_amdgcn_readfirstlane(tid >> 6);
    const int G = gridDim.x;
    gu32* ctl = (gu32*)(args.ws + WS_CTL);
    for (int u = tid; u < (LDS_BYTES - LDSCTL_OFF) / 4; u += NTHR) ((LAS unsigned*)(lds + LDSCTL_OFF))[u] = 0u;
    __syncthreads();
    const int lo = args.ph_lo, hi = args.ph_hi;
    const bool use_bar = (hi - lo) > 1;
    XcdBarrier bar; bar.bar = (unsigned*)(ctl + CW_BAR); bar.x = 0; bar.st = nullptr;
    if (use_bar) bar = xcd_barrier_post((unsigned*)(ctl + CW_BAR), MISC + 8);
    const int gw = blockIdx.x * NWAVES + wave, NGW = G * NWAVES;

#if MK_PER_STEP
    { const int s = lo;
#else
    for (int s = lo; s < hi; ++s) {
#endif
        if (s == 0) {
            p0_prologue(args, lds, wave, lane);
        } else {
            const int q = s - 1, hl = q / 5, ph = q - hl * 5, half = hl >> 1, layer = hl & 1;
            if (ph == 0) {
                pg8::Gemm g{(const pg8::bf16_t*)(args.ws + WS_XN), (const pg8::bf16_t*)(args.ws + WS_WIN + layer * WIN_BYTES), MH, PW, D};
                pg8::StaticOrder S; S.init(MH, PW, G, (int)blockIdx.x);
                pg8::EpiBf16 E{(pg8::bf16_t*)(args.ws + WS_PROJ), PW};
                pg8::gemm_phase<pg8::EpiBf16, pg8::StaticOrder, true, true>(lds + RING_OFF, g, S, E);
            } else if (ph == 1) {
                attn_simple(args, layer, wave, lane);
                conv_simple(args, layer);
                if ((int)blockIdx.x < HB * 4) ret_simple(args, (int)blockIdx.x, lds, wave, lane);
            } else if (ph == 2) {
                pg8::Gemm g{(const pg8::bf16_t*)(args.ws + WS_BR), (const pg8::bf16_t*)(args.ws + WS_WBR + layer * WBR_BYTES), MH, D, BRW};
                pg8::StaticOrder S; S.init(MH, D, G, (int)blockIdx.x);
                pg8::EpiGate E{(pg8::bf16_t*)(args.ws + WS_XN), D, (const pg8::bf16_t*)(args.ws + WS_PROJ) + C_MG};
                pg8::gemm_phase<pg8::EpiGate, pg8::StaticOrder, true, true>(lds + RING_OFF, g, S, E);
            } else if (ph == 3) {
                pg8::Gemm g{(const pg8::bf16_t*)(args.ws + WS_XN), (const pg8::bf16_t*)(args.ws + WS_WOUT + layer * WOUT_BYTES), MH, D, D};
                pg8::StaticOrder S; S.init(MH, D, G, (int)blockIdx.x);
                pg8::EpiF32 E{(float*)(args.ws + WS_PROJ), D};
                pg8::gemm_phase<pg8::EpiF32, pg8::StaticOrder, true, true>(lds + RING_OFF, g, S, E);
            } else {
                p5_norm_residual(args, half, layer, gw, NGW, lane);
                if (half == 0 && layer == 1) xn_from_input(args, 1, gw, NGW, lane);
            }
        }
        if (s + 1 < hi) xcd_barrier(bar);
    }
}

extern "C" void kernel_launch(void* const* d_in, const int* in_sizes, int n_in, void* d_out, int out_size, void* d_ws, size_t ws_size, hipStream_t stream) {
    static int grid = 0;
    if (grid == 0) {
        if (n_in != 10 || in_sizes[0] != BATCH * SEQ * D || out_size != BATCH * SEQ * D || ws_size < WS_END) { fprintf(stderr, "kernel_launch: unexpected shapes (n_in %d in0 %d out %d ws %zu)\n", n_in, n_in > 0 ? in_sizes[0] : -1, out_size, ws_size); grid = -1; return; }
        int dev = 0, cus = 0;
        if (hipGetDevice(&dev) != hipSuccess || hipDeviceGetAttribute(&cus, hipDeviceAttributeMultiprocessorCount, dev) != hipSuccess) { grid = -1; return; }
        if (hipFuncSetAttribute((const void*)fwd_kernel, hipFuncAttributeMaxDynamicSharedMemorySize, LDS_BYTES) != hipSuccess) { fprintf(stderr, "kernel_launch: hipFuncSetAttribute failed\n"); grid = -1; return; }
        (void)hipGetLastError();
        grid = cus;
    }
    if (grid < 0) return;
    if (hipMemsetAsync((char*)d_ws + WS_CTL, 0, CTL_ZERO_BYTES, stream) != hipSuccess) return;
    Args a{};
    for (int i = 0; i < 10; ++i) a.in[i] = (const float*)d_in[i];
    a.out = (float*)d_out; a.ws = (unsigned char*)d_ws;
#if MK_PER_STEP
    for (int s = 0; s < NSTEPS; ++s) { a.ph_lo = s; a.ph_hi = s + 1; hipLaunchKernelGGL(fwd_kernel, dim3(grid), dim3(NTHR), LDS_BYTES, stream, a); }
#else
    a.ph_lo = 0; a.ph_hi = NSTEPS; hipLaunchKernelGGL(fwd_kernel, dim3(grid), dim3(NTHR), LDS_BYTES, stream, a);
#endif
}
```

```cpp
#include <hip/hip_runtime.h>
#include <cstdio>
#include <cstdint>
#include <cmath>
namespace pg8 {
#define PG8_LAS __attribute__((address_space(3)))
typedef unsigned short bf16_t;
typedef short bf16x8 __attribute__((ext_vector_type(8)));
typedef float f32x4 __attribute__((ext_vector_type(4)));
typedef unsigned u32x4 __attribute__((ext_vector_type(4)));
constexpr int BM = 256, BK = 64, HALF = 128, HTB = HALF * BK * 2  , STAGE_BYTES = 8 * HTB, NXCD = 8, WGM = 8;

__host__ __device__ __forceinline__ int lds_byte(int r, int c) { const int st = (r >> 4) * 2 + (c >> 5), rr = r & 15, cc = c & 31, ob = rr * 64 + cc * 2; return st * 1024 + (ob ^ (((ob >> 9) & 1) << 5)); }
__host__ __device__ __forceinline__ void stage_rc(int b, int& R, int& C) { const int st = b / 1024, sb = b % 1024, swz = sb ^ (((sb >> 9) & 1) << 5); R = (st >> 1) * 16 + swz / 64; C = (st & 1) * 32 + (swz % 64) / 2; }
__host__ __device__ __forceinline__ int perm32(int rho) { const int n = rho >> 4, i = rho & 15; return 8 * (i >> 2) + 4 * n + (i & 3); }

struct Unit { int pm, pn; };
struct Gemm { const bf16_t* A; const bf16_t* Bt; int M, N, K; };

struct StaticOrder {
    int nM, nN, nwg, G, c;
    __host__ __device__ void init(int M, int N, int G_, int c_) { nM = M / BM; nN = N / BM; nwg = nM * nN; G = G_; c = c_; }
    __host__ __device__ bool next(int i, Unit& u) const {
        const long L = (long)i * G + c; if (L >= nwg) return false;
        int wgid = (int)L; { const int q = nwg / NXCD, r = nwg % NXCD, xcd = wgid % NXCD, off = wgid / NXCD; wgid = (xcd < r ? xcd * (q + 1) : r * (q + 1) + (xcd - r) * q) + off; }
        const int nig = WGM * nN, gid = wgid / nig, fm = gid * WGM, gsz = (nM - fm) < WGM ? (nM - fm) : WGM;
        u.pm = fm + ((wgid % nig) % gsz); u.pn = (wgid % nig) / gsz; return true;
    }
    __device__ __forceinline__ void a_ready(const Unit&) const {}
    __device__ __forceinline__ void done(const Unit&) const {}
};


__device__ __forceinline__ unsigned cvt_pk_bf16(float lo, float hi) { unsigned r; asm volatile("v_cvt_pk_bf16_f32 %0, %1, %2" : "=v"(r) : "v"(lo), "v"(hi)); return r; }
__device__ __forceinline__ float bflo(unsigned w) { return __uint_as_float(w << 16); }
__device__ __forceinline__ float bfhi(unsigned w) { return __uint_as_float(w & 0xffff0000u); }

struct EpiF32 {
    static constexpr bool PERM = false, AFTER_DRAIN = false, MID = false;
    float* C; int ldc;
    __device__ __forceinline__ void operator()(const f32x4 (&acc)[2][2][4][2], const Unit& u, int wr, int wc, int fr, int fq) const {
        const int row0 = u.pm * BM + wr * 64 + fr, col0 = u.pn * BM + wc * 32 + 4 * fq;
#pragma unroll
        for (int ai = 0; ai < 2; ++ai)
#pragma unroll
            for (int m = 0; m < 4; ++m) { float* rowp = C + (size_t)(row0 + ai * HALF + m * 16) * ldc + col0;
#pragma unroll
                for (int bj = 0; bj < 2; ++bj)
#pragma unroll
                    for (int n = 0; n < 2; ++n) *(f32x4*)(rowp + bj * HALF + n * 16) = acc[ai][bj][m][n]; }
    }
};
struct EpiBf16 {
    static constexpr bool PERM = true, AFTER_DRAIN = false, MID = false;
    bf16_t* O; int ldc;
    __device__ __forceinline__ void operator()(const f32x4 (&acc)[2][2][4][2], const Unit& u, int wr, int wc, int fr, int fq) const {
        const int row0 = u.pm * BM + wr * 64 + fr; const int col0 = u.pn * BM + wc * 32 + 8 * fq;
#pragma unroll
        for (int ai = 0; ai < 2; ++ai)
#pragma unroll
            for (int m = 0; m < 4; ++m) { bf16_t* rowp = O + (size_t)(row0 + ai * HALF + m * 16) * ldc + col0;
#pragma unroll
                for (int bj = 0; bj < 2; ++bj) { const f32x4 v0 = acc[ai][bj][m][0], v1 = acc[ai][bj][m][1];
                    u32x4 w; w.x = cvt_pk_bf16(v0[0], v0[1]); w.y = cvt_pk_bf16(v0[2], v0[3]); w.z = cvt_pk_bf16(v1[0], v1[1]); w.w = cvt_pk_bf16(v1[2], v1[3]);
                    *(u32x4*)(rowp + bj * HALF) = w; } }
    }
};
struct EpiGate {
    static constexpr bool PERM = true, AFTER_DRAIN = false, MID = true;
    static constexpr int LDG = 8448;
    bf16_t* O; int ldc; const bf16_t* G;
    __device__ __forceinline__ void scale(f32x4 (&acc)[2][2][4][2], const Unit& u, int which, int wr, int wc, int fr, int fq) const {
        unsigned off0 = ((unsigned)(u.pm * BM + wr * 64 + fr) * (unsigned)LDG + (unsigned)(u.pn * BM + wc * 32 + 8 * fq)) * 2u;
        asm volatile("" : "+v"(off0));
        const char* gb = (const char*)G + (size_t)((which == 3 ? 2 : which - 1) * 1024) * 2;
#pragma unroll
        for (int ai = 0; ai < 2; ++ai)
#pragma unroll
            for (int m = 0; m < 4; ++m) {
#pragma unroll
                for (int bj = 0; bj < 2; ++bj) {
                    const unsigned off = off0 + (unsigned)((ai * HALF + m * 16) * LDG * 2 + bj * HALF * 2);
                    const u32x4 wa = *(const u32x4*)(gb + off);
                    const u32x4 wb = *(const u32x4*)(gb + off + 2048);
                    float a[8] = {bflo(wa.x), bfhi(wa.x), bflo(wa.y), bfhi(wa.y), bflo(wa.z), bfhi(wa.z), bflo(wa.w), bfhi(wa.w)};
                    float b[8] = {bflo(wb.x), bfhi(wb.x), bflo(wb.y), bfhi(wb.y), bflo(wb.z), bfhi(wb.z), bflo(wb.w), bfhi(wb.w)};
                    float f[8];
#pragma unroll
                    for (int e = 0; e < 8; ++e) {
                        const float ea = __expf(-a[e]);
                        if (which == 3) f[e] = __builtin_amdgcn_rcpf(1.0f + ea);
                        else { const float eb = __expf(-b[e]); f[e] = (1.0f + eb) * __builtin_amdgcn_rcpf(1.0f + ea); }
                    }
                    f32x4 v0 = acc[ai][bj][m][0], v1 = acc[ai][bj][m][1];
                    v0[0] *= f[0]; v0[1] *= f[1]; v0[2] *= f[2]; v0[3] *= f[3]; v1[0] *= f[4]; v1[1] *= f[5]; v1[2] *= f[6]; v1[3] *= f[7];
                    acc[ai][bj][m][0] = v0; acc[ai][bj][m][1] = v1; }
                asm volatile("" ::: "memory"); }
    }
    __device__ __forceinline__ void mid(f32x4 (&acc)[2][2][4][2], const Unit& u, int which, int wr, int wc, int fr, int fq) const { scale(acc, u, which, wr, wc, fr, fq); }
    __device__ __forceinline__ void operator()(f32x4 (&acc)[2][2][4][2], const Unit& u, int wr, int wc, int fr, int fq) const {
        scale(acc, u, 3, wr, wc, fr, fq);
        const int row0 = u.pm * BM + wr * 64 + fr; const int col0 = u.pn * BM + wc * 32 + 8 * fq;
#pragma unroll
        for (int ai = 0; ai < 2; ++ai)
#pragma unroll
            for (int m = 0; m < 4; ++m) { bf16_t* rowp = O + (size_t)(row0 + ai * HALF + m * 16) * ldc + col0;
#pragma unroll
                for (int bj = 0; bj < 2; ++bj) { const f32x4 v0 = acc[ai][bj][m][0], v1 = acc[ai][bj][m][1];
                    u32x4 w; w.x = cvt_pk_bf16(v0[0], v0[1]); w.y = cvt_pk_bf16(v0[2], v0[3]); w.z = cvt_pk_bf16(v1[0], v1[1]); w.w = cvt_pk_bf16(v1[2], v1[3]);
                    *(u32x4*)(rowp + bj * HALF) = w; } }
    }
};
template <class Epi, class Sched, bool ALIGN_EPI = false, bool SP2 = false>
__device__ __forceinline__ void gemm_phase(PG8_LAS unsigned char* lds, const Gemm g, const Sched& S, const Epi& E, const int tid) {
    const int wid = __builtin_amdgcn_readfirstlane(tid >> 6), lane = tid & 63, wr = wid >> 2, wc = wid & 3, fr = lane & 15, fq = lane >> 4;
    const int K = g.K, nt = K / BK;
    unsigned voffA[2], voffB[2];
#pragma unroll
    for (int i = 0; i < 2; ++i) { int R, C; stage_rc(tid * 16 + i * 8192, R, C); const int Rb = Epi::PERM ? ((R & ~31) + perm32(R & 31)) : R;
        voffA[i] = (unsigned)(R * K + C) * 2u; voffB[i] = (unsigned)(Rb * K + C) * 2u; }
    const size_t kstep = (size_t)(BK * 2);
    const size_t hstep = (size_t)HALF * K * 2;
    const size_t tstep = 2 * hstep;
    const unsigned ldsw = (unsigned)wid * 1024u;
    const int aoff = lds_byte(wr * 64 + fr, fq * 8), boff = lds_byte(wc * 32 + fr, fq * 8);
#define PG8_SA(b, h) (((b) * 2 + (h)) * HTB)
#define PG8_SB(b, h) ((4 + (b) * 2 + (h)) * HTB)
#define PG8_STAGE(bufoff, gbase, voff) do { _Pragma("unroll") for (int _i = 0; _i < 2; ++_i) \
        __builtin_amdgcn_global_load_lds((const unsigned*)((const char*)(gbase) + (voff)[_i]), (PG8_LAS unsigned*)(lds + (bufoff) + ldsw + _i * 8192), 16, 0, 0); } while (0)
#define PG8_LDA(dst, b, h) do { _Pragma("unroll") for (int m = 0; m < 4; ++m) _Pragma("unroll") for (int k = 0; k < 2; ++k) dst[m][k] = *(const PG8_LAS bf16x8*)(lds + PG8_SA(b, h) + aoff + m * 2048 + k * 1024); } while (0)
#define PG8_LDB(dst, b, h) do { _Pragma("unroll") for (int n = 0; n < 2; ++n) _Pragma("unroll") for (int k = 0; k < 2; ++k) dst[n][k] = *(const PG8_LAS bf16x8*)(lds + PG8_SB(b, h) + boff + n * 2048 + k * 1024); } while (0)
#define PG8_MMA(ai, bj, At, Bt) do { __builtin_amdgcn_s_setprio(1); _Pragma("unroll") for (int m = 0; m < 4; ++m) _Pragma("unroll") for (int n = 0; n < 2; ++n) _Pragma("unroll") for (int k = 0; k < 2; ++k) \
        acc[ai][bj][m][n] = __builtin_amdgcn_mfma_f32_16x16x32_bf16(Bt[n][k], At[m][k], acc[ai][bj][m][n], 0, 0, 0); __builtin_amdgcn_s_setprio(0); } while (0)
#define PG8_WAIT_V(n) asm volatile("s_waitcnt vmcnt(" #n ")" ::: "memory")
#define PG8_WAIT_L(n) asm volatile("s_waitcnt lgkmcnt(" #n ")" ::: "memory")
#define PG8_BAR __builtin_amdgcn_s_barrier()
#define PG8_SCHED __builtin_amdgcn_sched_barrier(0)
    Unit cur, nxt; int ui = 0;
    if (!S.next(0, cur)) return;
    f32x4 acc[2][2][4][2];
#pragma unroll
    for (int a = 0; a < 2; ++a)
#pragma unroll
        for (int b = 0; b < 2; ++b)
#pragma unroll
            for (int m = 0; m < 4; ++m)
#pragma unroll
                for (int n = 0; n < 2; ++n) acc[a][b][m][n] = (f32x4){0.f, 0.f, 0.f, 0.f};
    bf16x8 At[4][2], B0[2][2], B1[2][2];
    const char* cA = (const char*)g.A + (size_t)cur.pm * tstep; const char* cB = (const char*)g.Bt + (size_t)cur.pn * tstep;
    S.a_ready(cur);
    if constexpr (SP2) {
        PG8_STAGE(PG8_SB(0, 0), cB, voffB); PG8_STAGE(PG8_SB(0, 1), cB + hstep, voffB); PG8_STAGE(PG8_SA(0, 0), cA, voffA); PG8_STAGE(PG8_SA(0, 1), cA + hstep, voffA);
        if (wr == 1) PG8_BAR;
        PG8_WAIT_V(2); PG8_BAR;
        PG8_STAGE(PG8_SB(1, 0), cB + kstep, voffB); PG8_STAGE(PG8_SA(1, 0), cA + kstep, voffA); PG8_STAGE(PG8_SB(1, 1), cB + hstep + kstep, voffB);
        PG8_WAIT_V(6); PG8_BAR;
    } else {
        PG8_STAGE(PG8_SB(0, 0), cB, voffB); PG8_STAGE(PG8_SA(0, 0), cA, voffA); PG8_STAGE(PG8_SB(0, 1), cB + hstep, voffB); PG8_STAGE(PG8_SA(0, 1), cA + hstep, voffA);
        if (wr == 1) PG8_BAR;
        PG8_WAIT_V(4); PG8_BAR;
        PG8_STAGE(PG8_SB(1, 0), cB + kstep, voffB); PG8_STAGE(PG8_SA(1, 0), cA + kstep, voffA); PG8_STAGE(PG8_SB(1, 1), cB + hstep + kstep, voffB);
        PG8_WAIT_V(6); PG8_BAR;
    }
    for (;;) {
        const bool has_next = S.next(ui + 1, nxt);
        const char* nA = has_next ? (const char*)g.A + (size_t)nxt.pm * tstep : cA; const char* nB = has_next ? (const char*)g.Bt + (size_t)nxt.pn * tstep : cB;
        const int seg = Epi::MID ? 8 : nt;
        for (int t0 = 0; t0 < nt; t0 += seg) {
        for (int t = t0; t < t0 + seg; t += 2) {
            const bool last = (t == nt - 2);
            const char* a1 = cA + (size_t)(t + 1) * kstep;
            const char* a2 = last ? nA : cA + (size_t)(t + 2) * kstep; const char* b2 = last ? nB : cB + (size_t)(t + 2) * kstep;
            const char* a3 = a2 + kstep; const char* b3 = b2 + kstep;
            if (last && has_next) S.a_ready(nxt);
            if constexpr (SP2) {
            PG8_LDB(B0, 0, 0); PG8_LDB(B1, 0, 1); PG8_SCHED; PG8_LDA(At, 0, 0); PG8_STAGE(PG8_SA(1, 1), a1 + hstep, voffA);
            PG8_WAIT_V(8); PG8_WAIT_L(0); PG8_BAR; PG8_MMA(0, 0, At, B0); PG8_MMA(0, 1, At, B1); PG8_BAR; PG8_SCHED;
            PG8_LDA(At, 0, 1); PG8_STAGE(PG8_SB(0, 0), b2, voffB); PG8_STAGE(PG8_SB(0, 1), b2 + hstep, voffB); PG8_STAGE(PG8_SA(0, 0), a2, voffA);
            PG8_WAIT_V(8); PG8_WAIT_L(0); PG8_BAR; PG8_MMA(1, 0, At, B0); PG8_MMA(1, 1, At, B1); PG8_BAR; PG8_SCHED;
            PG8_LDB(B0, 1, 0); PG8_LDB(B1, 1, 1); PG8_SCHED; PG8_LDA(At, 1, 0); PG8_STAGE(PG8_SA(0, 1), a2 + hstep, voffA);
            PG8_WAIT_V(8); PG8_WAIT_L(0); PG8_BAR; PG8_MMA(0, 0, At, B0); PG8_MMA(0, 1, At, B1); PG8_BAR; PG8_SCHED;
            PG8_LDA(At, 1, 1); PG8_STAGE(PG8_SB(1, 0), b3, voffB); PG8_STAGE(PG8_SB(1, 1), b3 + hstep, voffB); PG8_STAGE(PG8_SA(1, 0), a3, voffA);
            PG8_WAIT_V(8); PG8_WAIT_L(0); PG8_BAR; PG8_MMA(1, 0, At, B0); PG8_MMA(1, 1, At, B1); PG8_BAR; PG8_SCHED;
            } else {
            PG8_LDB(B0, 0, 0); PG8_SCHED; PG8_LDA(At, 0, 0); PG8_STAGE(PG8_SA(1, 1), a1 + hstep, voffA);
            PG8_WAIT_L(8); PG8_BAR; PG8_WAIT_L(0); PG8_MMA(0, 0, At, B0); PG8_BAR; PG8_SCHED;
            PG8_LDB(B1, 0, 1); PG8_STAGE(PG8_SB(0, 0), b2, voffB);
            PG8_BAR; PG8_WAIT_L(0); PG8_MMA(0, 1, At, B1); PG8_BAR;
            PG8_LDA(At, 0, 1); PG8_STAGE(PG8_SA(0, 0), a2, voffA);
            PG8_BAR; PG8_WAIT_L(0); PG8_MMA(1, 0, At, B0); PG8_BAR; PG8_SCHED;
            PG8_STAGE(PG8_SB(0, 1), b2 + hstep, voffB);
            PG8_WAIT_V(6); PG8_BAR; PG8_MMA(1, 1, At, B1); PG8_BAR;
            PG8_LDB(B0, 1, 0); PG8_SCHED; PG8_LDA(At, 1, 0); PG8_STAGE(PG8_SA(0, 1), a2 + hstep, voffA);
            PG8_WAIT_L(8); PG8_BAR; PG8_WAIT_L(0); PG8_MMA(0, 0, At, B0); PG8_BAR; PG8_SCHED;
            PG8_LDB(B1, 1, 1); PG8_STAGE(PG8_SB(1, 0), b3, voffB);
            PG8_BAR; PG8_WAIT_L(0); PG8_MMA(0, 1, At, B1); PG8_BAR;
            PG8_LDA(At, 1, 1); PG8_STAGE(PG8_SA(1, 0), a3, voffA);
            PG8_BAR; PG8_WAIT_L(0); PG8_MMA(1, 0, At, B0); PG8_BAR; PG8_SCHED;
            PG8_STAGE(PG8_SB(1, 1), b3 + hstep, voffB);
            PG8_WAIT_V(6); PG8_BAR; PG8_MMA(1, 1, At, B1); PG8_BAR;
            }
        }
        if constexpr (Epi::MID) { if (t0 + seg < nt) E.mid(acc, cur, t0 / seg + 1, wr, wc, fr, fq); }
        }
        if constexpr (ALIGN_EPI) { if (wr == 0) PG8_BAR; }
        if constexpr (!Epi::AFTER_DRAIN) { E(acc, cur, wr, wc, fr, fq); S.done(cur); }
        if (!has_next) break;
#pragma unroll
        for (int a = 0; a < 2; ++a)
#pragma unroll
            for (int b = 0; b < 2; ++b)
#pragma unroll
                for (int m = 0; m < 4; ++m)
#pragma unroll
                    for (int n = 0; n < 2; ++n) acc[a][b][m][n] = (f32x4){0.f, 0.f, 0.f, 0.f};
        cur = nxt; cA = nA; cB = nB; ++ui;
        if constexpr (ALIGN_EPI) { if (wr == 1) PG8_BAR; }
    }
    PG8_WAIT_V(0);
    if constexpr (!ALIGN_EPI) { if (wr == 0) PG8_BAR; }
    PG8_BAR;
    if constexpr (Epi::AFTER_DRAIN) { E.fused(acc, cur, wr, wc, fr, fq, lds, wid, lane); S.done(cur); }
#undef PG8_SA
#undef PG8_SB
#undef PG8_STAGE
#undef PG8_LDA
#undef PG8_LDB
#undef PG8_MMA
#undef PG8_WAIT_V
#undef PG8_WAIT_L
#undef PG8_BAR
#undef PG8_SCHED
}
}

constexpr int NWAVES = 8, NTHR = 512;
constexpr int D = 1024, BATCH = 16, SEQ = 2048, BLK = 128, NMETA = 16, PADF = 112, LP = 2176, NCH = 17;
constexpr int PW = 8448;
constexpr int HB = 8, MH = HB * LP;
constexpr int C_AQ = 0, C_AK = 512, C_AV = 640, C_AG = 768, C_RQ = 1280, C_RK = 1792, C_RV = 2304, C_RG = 2816, C_CB = 3328, C_CC = 3840, C_CX = 4352, C_CG = 4864, C_MG = 5376;
constexpr int BRW = 1536;
constexpr float RMS_EPS = 1e-6f, GN_EPS = 1e-6f;
constexpr int NSTEPS = 21;

constexpr size_t MiB = 1u << 20;
constexpr size_t WS_CTL = 0, CTL_ZERO_BYTES = 1 * MiB;
constexpr size_t WS_WIN = 1 * MiB, WIN_BYTES = (size_t)PW * D * 2;
constexpr size_t WS_WBR = 34 * MiB, WBR_BYTES = (size_t)D * BRW * 2;
constexpr size_t WS_WOUT = 40 * MiB, WOUT_BYTES = (size_t)D * D * 2;
constexpr size_t WS_ROT = 44 * MiB;
constexpr size_t WS_XN = 46 * MiB;
constexpr size_t WS_BR = 80 * MiB;
constexpr size_t WS_H = 131 * MiB;
constexpr size_t WS_PROJ = 199 * MiB;
constexpr size_t WS_END = 480 * MiB;
static_assert(WS_WIN + 2 * WIN_BYTES <= WS_WBR && WS_WBR + 2 * WBR_BYTES <= WS_WOUT && WS_WOUT + 2 * WOUT_BYTES <= WS_ROT && WS_ROT + (size_t)LP * 64 * 8 <= WS_XN, "ws map 1");
static_assert(WS_XN + (size_t)MH * D * 2 <= WS_BR && WS_BR + (size_t)MH * BRW * 2 <= WS_H && WS_H + (size_t)MH * D * 4 <= WS_PROJ && WS_PROJ + (size_t)MH * PW * 2 <= WS_END, "ws map 2");
constexpr int CW_TMO = 0, CW_CODE = 1, CW_BAR = 4096;

constexpr int RING_OFF = 0, RING_BYTES = 131072;
constexpr int LDSCTL_OFF = RING_BYTES, MISC_OFF = LDSCTL_OFF + 320;
constexpr int LDS_BYTES = 147456;

#define GAS __attribute__((address_space(1)))
#define LAS __attribute__((address_space(3)))
typedef unsigned short bf16;
typedef unsigned v4u __attribute__((ext_vector_type(4)));
typedef unsigned v2u __attribute__((ext_vector_type(2)));
typedef float f32x4 __attribute__((ext_vector_type(4)));
typedef GAS unsigned gu32;
#define RLX_AGENT __ATOMIC_RELAXED, __HIP_MEMORY_SCOPE_AGENT
#define LDS_WAIT() asm volatile("s_waitcnt lgkmcnt(0)" ::: "memory")
#define VM_WAIT() asm volatile("s_waitcnt vmcnt(0)" ::: "memory")
__device__ __forceinline__ unsigned f2bf(float f) { unsigned u = __builtin_bit_cast(unsigned, f); return (u + 0x7fffu + ((u >> 16) & 1u)) >> 16; }
__device__ __forceinline__ unsigned pk2(float lo, float hi) { return f2bf(lo) | (f2bf(hi) << 16); }
__device__ __forceinline__ float bf2f(bf16 h) { return __uint_as_float((unsigned)h << 16); }
__device__ __forceinline__ float bflo(unsigned w) { return __uint_as_float(w << 16); }
__device__ __forceinline__ float bfhi(unsigned w) { return __uint_as_float(w & 0xffff0000u); }
__device__ __forceinline__ float silu(float g) { return g / (1.0f + __expf(-g)); }
__device__ __forceinline__ float wave_sum(float v) {
#pragma unroll
    for (int o = 1; o < 64; o <<= 1) v += __shfl_xor(v, o);
    return v;
}
__device__ __forceinline__ float wave_max(float v) {
#pragma unroll
    for (int o = 1; o < 64; o <<= 1) v = fmaxf(v, __shfl_xor(v, o));
    return v;
}
__device__ __forceinline__ int t5_bucket(int n) {
    return n < 16 ? n : 16 + (n >= 19) + (n >= 21) + (n >= 24) + (n >= 27) + (n >= 31) + (n >= 35) + (n >= 40) + (n >= 46) + (n >= 52) + (n >= 59) + (n >= 67) + (n >= 77) + (n >= 87) + (n >= 99) + (n >= 113);
}

#define XB_TMO      128
#define XB_XCNT(j)  (256  + 64 * (j))
#define XB_XSUB(j)  (1280 + 64 * (j))
#define XB_XGEN(j)  (2304 + 64 * (j))
#define XB_TOP      3328
#define XB_TOPGEN   3392
#define XCD_BAR_WORDS 3456
#define XB_SPIN_CAP (1u << 18)

__device__ __forceinline__ unsigned xb_ld(unsigned* p)              { return __hip_atomic_load(p, __ATOMIC_RELAXED, __HIP_MEMORY_SCOPE_AGENT); }
__device__ __forceinline__ unsigned xb_add(unsigned* p, unsigned v) { return __hip_atomic_fetch_add(p, v, __ATOMIC_RELAXED, __HIP_MEMORY_SCOPE_AGENT); }
__device__ __forceinline__ unsigned xb_xcc_id() { return (unsigned)__builtin_amdgcn_s_getreg((3 << 11) | 20) & 0xFu; }
#define XB_SPIN(cond, bar) do { unsigned _sp = 0; while (cond) { __builtin_amdgcn_s_sleep(1); \
    if ((++_sp & 255u) == 0u) { if (xb_ld(&(bar)[XB_TMO])) break; if (_sp > XB_SPIN_CAP) { atomicAdd(&(bar)[XB_TMO], 1u); break; } } } } while (0)

struct XcdBarrier {
    unsigned* bar; unsigned x;
    volatile LAS unsigned* st;
};

__device__ __forceinline__ XcdBarrier xcd_barrier_post(unsigned* bar, volatile LAS unsigned* st) {
    XcdBarrier b; b.bar = bar; b.x = xb_xcc_id(); b.st = st;
    if (threadIdx.x == 0) (void)xb_add(&bar[XB_XCNT(b.x)], 1u);
    return b;
}
__device__ __forceinline__ void xcd_barrier_complete(unsigned* bar, unsigned x, unsigned& nloc, unsigned& nx) {
    const unsigned G = gridDim.x * gridDim.y * gridDim.z;
    unsigned sum, cnt, mine, sp = 0u;
    for (;;) {
        sum = 0u; cnt = 0u; mine = 0u;
#pragma unroll
        for (unsigned j = 0; j < 16; ++j) { const unsigned c = xb_ld(&bar[XB_XCNT(j)]); sum += c; cnt += (c > 0u) ? 1u : 0u; mine = (j == x) ? c : mine; }
        if (sum == G) break;
        __builtin_amdgcn_s_sleep(1);
        if ((++sp & 255u) == 0u) { if (xb_ld(&bar[XB_TMO])) break; if (sp > XB_SPIN_CAP) { atomicAdd(&bar[XB_TMO], 1u); break; } }
    }
    nloc = mine > 0u ? mine : 1u; nx = cnt > 0u ? cnt : 1u;
}

__device__ __forceinline__ void xcd_barrier(const XcdBarrier& b) {
    asm volatile("s_waitcnt vmcnt(0)" ::: "memory");
    __syncthreads();
    if (threadIdx.x == 0) {
        unsigned* bar = b.bar;
        __builtin_amdgcn_s_waitcnt(0);
        unsigned nloc = b.st[0], nx = b.st[1];
        if (nloc == 0u) { xcd_barrier_complete(bar, b.x, nloc, nx); b.st[0] = nloc; b.st[1] = nx; }
        const unsigned old = xb_add(&bar[XB_XSUB(b.x)], 1u);
        const unsigned gen = old / nloc;
        if (old + 1u == (gen + 1u) * nloc) {
            __builtin_amdgcn_fence(__ATOMIC_RELEASE, "agent");
            asm volatile("s_waitcnt vmcnt(0)" ::: "memory");
            const unsigned og = xb_add(&bar[XB_TOP], 1u);
            const unsigned tg = og / nx;
            if (og + 1u == (tg + 1u) * nx) xb_add(&bar[XB_TOPGEN], 1u);
            else XB_SPIN(xb_ld(&bar[XB_TOPGEN]) == tg, bar);
            __builtin_amdgcn_fence(__ATOMIC_ACQUIRE, "agent");
            xb_add(&bar[XB_XGEN(b.x)], 1u);
            asm volatile("s_waitcnt vmcnt(0)" ::: "memory");
        } else {
            XB_SPIN(xb_ld(&bar[XB_XGEN(b.x)]) == gen, bar);
            __builtin_amdgcn_fence(__ATOMIC_ACQUIRE, "agent");
            asm volatile("s_waitcnt vmcnt(0)" ::: "memory");
        }
    }
    __syncthreads();
}


struct Args { const float* in[10]; float* out; unsigned char* ws; int ph_lo, ph_hi; };

__device__ __forceinline__ void p0_transpose_item(const float* W, int K, int N, bf16* WT, int ldt, int koff, LAS float* scr, int item, int lane) {
    const int nblk = N / 32, kb = item / nblk, nb = item % nblk, k0 = 64 * kb, n0 = 32 * nb;
#pragma unroll 8
    for (int i = 0; i < 32; ++i) { const int kk = 2 * i + (lane >> 5); scr[kk * 33 + (lane & 31)] = W[(size_t)(k0 + kk) * N + n0 + (lane & 31)]; }
    LDS_WAIT(); asm volatile("" ::: "memory");
    const int c = lane & 7;
#pragma unroll
    for (int j = 0; j < 4; ++j) { const int n = (lane >> 3) + 8 * j; const LAS float* s = scr + (8 * c) * 33 + n;
        v4u o; o.x = pk2(s[0 * 33], s[1 * 33]); o.y = pk2(s[2 * 33], s[3 * 33]); o.z = pk2(s[4 * 33], s[5 * 33]); o.w = pk2(s[6 * 33], s[7 * 33]);
        *(GAS v4u*)(WT + (size_t)(n0 + n) * ldt + koff + k0 + 8 * c) = o; }
    LDS_WAIT(); asm volatile("" ::: "memory");
}

__device__ __forceinline__ void rms_row_to_bf16(const f32x4 (&v)[4], const float* g, bf16* orow, int lane) {
    float s2 = 0.f;
#pragma unroll
    for (int j = 0; j < 4; ++j) s2 += (v[j].x * v[j].x + v[j].y * v[j].y) + (v[j].z * v[j].z + v[j].w * v[j].w);
    const float rstd = 1.0f / sqrtf(wave_sum(s2) * (1.f / D) + RMS_EPS);
    GAS v2u* o8 = (GAS v2u*)orow + lane;
#pragma unroll
    for (int j = 0; j < 4; ++j) { const f32x4 gg = ((const f32x4*)g)[lane + 64 * j]; v2u w; w.x = pk2(v[j].x * rstd * gg.x, v[j].y * rstd * gg.y); w.y = pk2(v[j].z * rstd * gg.z, v[j].w * rstd * gg.w); o8[64 * j] = w; }
}
__device__ __forceinline__ void zero_row_bf16(bf16* orow, int lane) {
    GAS v2u* o8 = (GAS v2u*)orow + lane;
#pragma unroll
    for (int j = 0; j < 4; ++j) o8[64 * j] = (v2u){0u, 0u};
}
__device__ __forceinline__ void xn_from_input(const Args& a, int half, int gw, int NGW, int lane) {
    bf16* XN = (bf16*)(a.ws + WS_XN);
    for (int r = gw; r < MH; r += NGW) {
        const int bl = r / LP, idx = r - bl * LP, b = half * HB + bl;
        bf16* orow = XN + (size_t)r * D;
        if (idx < PADF) { zero_row_bf16(orow, lane); continue; }
        const float* src = idx < BLK ? a.in[1] + (size_t)(idx - PADF) * D : a.in[0] + ((size_t)b * SEQ + (idx - BLK)) * D;
        f32x4 v[4];
#pragma unroll
        for (int j = 0; j < 4; ++j) v[j] = ((const f32x4*)src)[lane + 64 * j];
        rms_row_to_bf16(v, a.in[3], orow, lane);
    }
}

__device__ __forceinline__ void p0_prologue(const Args& a, LAS unsigned char* lds, int tid, int wave, int lane) {
    LAS float* scr = (LAS float*)(lds + RING_OFF + wave * 16384);
    const int gw = blockIdx.x * NWAVES + wave, NGW = gridDim.x * NWAVES;
    constexpr int I_IN = (D / 64) * (PW / 32), I_BR = (512 / 64) * (D / 32), I_OUT = (D / 64) * (D / 32);
    constexpr int PER_LAYER = I_IN + 3 * I_BR + I_OUT, NITEMS = 2 * PER_LAYER;
    for (int it = gw; it < NITEMS; it += NGW) {
        const int l = it / PER_LAYER; int r = it - l * PER_LAYER;
        if (r < I_IN) { p0_transpose_item(a.in[4] + (size_t)l * D * PW, D, PW, (bf16*)(a.ws + WS_WIN + l * WIN_BYTES), D, 0, scr, r, lane); continue; } r -= I_IN;
        if (r < 3 * I_BR) { const int g = r / I_BR; p0_transpose_item(a.in[7] + ((size_t)l * 3 + g) * 512 * D, 512, D, (bf16*)(a.ws + WS_WBR + l * WBR_BYTES), BRW, g * 512, scr, r - g * I_BR, lane); continue; } r -= 3 * I_BR;
        p0_transpose_item(a.in[8] + (size_t)l * D * D, D, D, (bf16*)(a.ws + WS_WOUT + l * WOUT_BYTES), D, 0, scr, r, lane);
    }
    float* rc = (float*)(a.ws + WS_ROT); float* rs = rc + LP * 64;
    for (int e = (blockIdx.x * NTHR + tid); e < LP * 64; e += gridDim.x * NTHR) {
        const int idx = e >> 6, i = e & 63;
        const float lin = (float)i / 63.0f;
        const float theta = (float)(1.0 / pow(10000.0, (double)lin));
        const float ang = (float)(idx - PADF) * theta;
        rc[e] = (float)cos((double)ang); rs[e] = (float)sin((double)ang);
    }
    xn_from_input(a, 0, gw, NGW, lane);
}

__device__ __forceinline__ void p5_norm_residual(const Args& a, int half, int layer, int gw, int NGW, int lane) {
    const float* Y = (const float*)(a.ws + WS_PROJ); float* H = (float*)(a.ws + WS_H); bf16* XN = (bf16*)(a.ws + WS_XN);
    const float* gpost = a.in[9] + layer * D;
    for (int r = gw; r < MH; r += NGW) {
        const int bl = r / LP, idx = r - bl * LP, b = half * HB + bl;
        if (idx < PADF) {
            if (layer == 0) { zero_row_bf16(XN + (size_t)r * D, lane);
#pragma unroll
                for (int j = 0; j < 4; ++j) ((f32x4*)(H + (size_t)r * D))[lane + 64 * j] = (f32x4){0.f, 0.f, 0.f, 0.f}; }
            continue;
        }
        if (layer == 1 && idx < BLK) continue;
        f32x4 y[4], h[4]; float s2 = 0.f;
        const float* hsrc = layer == 0 ? (idx < BLK ? a.in[1] + (size_t)(idx - PADF) * D : a.in[0] + ((size_t)b * SEQ + (idx - BLK)) * D) : H + (size_t)r * D;
#pragma unroll
        for (int j = 0; j < 4; ++j) { y[j] = ((const f32x4*)(Y + (size_t)r * D))[lane + 64 * j]; h[j] = ((const f32x4*)hsrc)[lane + 64 * j]; s2 += (y[j].x * y[j].x + y[j].y * y[j].y) + (y[j].z * y[j].z + y[j].w * y[j].w); }
        const float rstd = 1.0f / sqrtf(wave_sum(s2) * (1.f / D) + RMS_EPS);
#pragma unroll
        for (int j = 0; j < 4; ++j) { const f32x4 gg = ((const f32x4*)gpost)[lane + 64 * j];
            h[j].x += y[j].x * rstd * gg.x; h[j].y += y[j].y * rstd * gg.y; h[j].z += y[j].z * rstd * gg.z; h[j].w += y[j].w * rstd * gg.w; }
        if (layer == 0) {
#pragma unroll
            for (int j = 0; j < 4; ++j) ((f32x4*)(H + (size_t)r * D))[lane + 64 * j] = h[j];
            rms_row_to_bf16(h, a.in[3] + D, XN + (size_t)r * D, lane);
        } else {
            float* orow = a.out + ((size_t)b * SEQ + (idx - BLK)) * D;
#pragma unroll
            for (int j = 0; j < 4; ++j) ((f32x4*)orow)[lane + 64 * j] = h[j];
        }
    }
}

__device__ __forceinline__ void attn_simple(const Args& a, int layer, int wave, int lane) {
    const bf16* PROJ = (const bf16*)(a.ws + WS_PROJ); bf16* BR = (bf16*)(a.ws + WS_BR);
    const float* rel_bias = a.in[2]; const float* sinks = a.in[6] + layer * 8;
    const int gw = blockIdx.x * NWAVES + wave, NGW = gridDim.x * NWAVES;
    for (int task = gw; task < MH * 8; task += NGW) {
        const int r = task >> 3, hq = task & 7, hk = hq >> 2;
        const int idx = r % LP;
        bf16* op = BR + (size_t)r * BRW + hq * 64 + lane;
        if (idx < PADF) { *op = 0; continue; }
        const bf16* prow = PROJ + (size_t)r * PW;
        float q[64];
#pragma unroll
        for (int c = 0; c < 8; ++c) { const v4u w = ((const v4u*)(prow + C_AQ + hq * 64))[c];
            q[8 * c + 0] = bflo(w.x); q[8 * c + 1] = bfhi(w.x); q[8 * c + 2] = bflo(w.y); q[8 * c + 3] = bfhi(w.y); q[8 * c + 4] = bflo(w.z); q[8 * c + 5] = bfhi(w.z); q[8 * c + 6] = bflo(w.w); q[8 * c + 7] = bfhi(w.w); }
        float s[2];
#pragma unroll
        for (int t = 0; t < 2; ++t) {
            const int dist = t * 64 + lane; float acc = 0.f;
            if (idx - dist >= PADF) {
                const v4u* kp = (const v4u*)(PROJ + (size_t)(r - dist) * PW + C_AK + hk * 64);
#pragma unroll
                for (int c = 0; c < 8; ++c) { const v4u w = kp[c];
                    acc += q[8 * c + 0] * bflo(w.x) + q[8 * c + 1] * bfhi(w.x) + q[8 * c + 2] * bflo(w.y) + q[8 * c + 3] * bfhi(w.y) + q[8 * c + 4] * bflo(w.z) + q[8 * c + 5] * bfhi(w.z) + q[8 * c + 6] * bflo(w.w) + q[8 * c + 7] * bfhi(w.w); }
                s[t] = acc * 0.125f + rel_bias[t5_bucket(dist) * 8 + hq];
            } else s[t] = -1e30f;
        }
        const float sink = sinks[hq];
        const float m = fmaxf(wave_max(fmaxf(s[0], s[1])), sink);
        const float e0 = __expf(s[0] - m), e1 = __expf(s[1] - m);
        const float denom = wave_sum(e0 + e1) + __expf(sink - m);
        const float p0 = e0 / denom, p1 = e1 / denom;
        float o = 0.f;
        for (int dist = 0; dist < 128; ++dist) {
            const float pj = __shfl(dist < 64 ? p0 : p1, dist & 63);
            if (idx - dist >= PADF) o += pj * bf2f(PROJ[(size_t)(r - dist) * PW + C_AV + hk * 64 + lane]);
        }
        const float g = bf2f(prow[C_AG + hq * 64 + lane]);
        *op = (bf16)f2bf(o * silu(g));
    }
}
__device__ __forceinline__ void conv_simple(const Args& a, int layer, int tid) {
    const bf16* PROJ = (const bf16*)(a.ws + WS_PROJ); bf16* BR = (bf16*)(a.ws + WS_BR);
    const float* cw = a.in[5] + layer * 3 * 512;
    for (int i = blockIdx.x * NTHR + tid; i < MH * 512; i += gridDim.x * NTHR) {
        const int r = i >> 9, c = i & 511, idx = r % LP;
        bf16* op = BR + (size_t)r * BRW + 1024 + c;
        if (idx < PADF) { *op = 0; continue; }
        const bf16* p = PROJ + (size_t)r * PW + c;
        const float u0 = bf2f(p[C_CC]) * bf2f(p[C_CX]);
        const float u1 = idx - 1 >= PADF ? bf2f(p[C_CC - PW]) * bf2f(p[C_CX - PW]) : 0.f;
        const float u2 = idx - 2 >= PADF ? bf2f(p[C_CC - 2 * PW]) * bf2f(p[C_CX - 2 * PW]) : 0.f;
        const float y = cw[2 * 512 + c] * u0 + cw[512 + c] * u1 + cw[c] * u2;
        *op = (bf16)f2bf(bf2f(p[C_CB]) * y * silu(bf2f(p[C_CG])));
    }
}
__device__ __forceinline__ void ret_simple(const Args& a, int unit, LAS unsigned char* lds, int tid, int wave, int lane) {
    const bf16* PROJ = (const bf16*)(a.ws + WS_PROJ); bf16* BR = (bf16*)(a.ws + WS_BR);
    const float* rc = (const float*)(a.ws + WS_ROT); const float* rs = rc + LP * 64;
    LAS float* qs = (LAS float*)lds; LAS float* ks = qs + 128; LAS float* vs = ks + 128; LAS float* red = vs + 128; LAS float* stat = red + 512;
    const int bl = unit >> 2, h = unit & 3, e = tid & 127, dg = tid >> 7;
    const float gamma = 1.0f - exp2f(-5.0f - (float)h);
    float S[32];
#pragma unroll
    for (int i = 0; i < 32; ++i) S[i] = 0.f;
    if (tid < 128) for (int idx = 0; idx < PADF; ++idx) BR[(size_t)(bl * LP + idx) * BRW + 512 + h * 128 + tid] = 0;
    for (int idx = PADF; idx < LP; ++idx) {
        const int r = bl * LP + idx; const bf16* prow = PROJ + (size_t)r * PW;
        if (tid < 384) {
            const int which = tid >> 7, d = tid & 127;
            if (which == 2) vs[d] = bf2f(prow[C_RV + h * 128 + d]);
            else { const int base = (which == 0 ? C_RQ : C_RK) + h * 128, i = d & 63; const float c = rc[idx * 64 + i], s = rs[idx * 64 + i];
                const float t1 = bf2f(prow[base + i]), t2 = bf2f(prow[base + 64 + i]);
                float val = d < 64 ? t1 * c - t2 * s : t1 * s + t2 * c;
                if (which == 1) { val *= 0.08838834764831845f; ks[d] = val; } else qs[d] = val; }
        }
        __syncthreads();
        float part = 0.f; const float ve = vs[e];
#pragma unroll
        for (int i = 0; i < 32; ++i) { S[i] = gamma * S[i] + ks[dg * 32 + i] * ve; part += qs[dg * 32 + i] * S[i]; }
        red[dg * 128 + e] = part;
        __syncthreads();
        float o = 0.f, dv = 0.f;
        if (tid < 128) { o = (red[e] + red[128 + e]) + (red[256 + e] + red[384 + e]); const float ws_ = wave_sum(o); if (lane == 0) stat[wave] = ws_; }
        __syncthreads();
        if (tid < 128) { const float mu = (stat[0] + stat[1]) * (1.f / 128.f); dv = o - mu; const float wq = wave_sum(dv * dv); if (lane == 0) stat[2 + wave] = wq; }
        __syncthreads();
        if (tid < 128) { const float var = (stat[2] + stat[3]) * (1.f / 128.f); const float on = dv / sqrtf(var + GN_EPS);
            BR[(size_t)r * BRW + 512 + h * 128 + e] = (bf16)f2bf(on * silu(bf2f(prow[C_RG + h * 128 + e]))); }
    }
    __syncthreads();
}

#ifndef MK_PER_STEP
#define MK_PER_STEP 0
#endif
__device__ __forceinline__ void run_step(const Args& args, int s, LAS unsigned char* lds, int tid) {
    const int lane = tid & 63, wave = __builtin_amdgcn_readfirstlane(tid >> 6);
    const int G = gridDim.x, gw = blockIdx.x * NWAVES + wave, NGW = G * NWAVES;
    if (s == 0) {
        p0_prologue(args, lds, tid, wave, lane);
    } else {
        const int q = s - 1, hl = q / 5, ph = q - hl * 5, half = hl >> 1, layer = hl & 1;
        if (ph == 0) {
            pg8::Gemm g{(const pg8::bf16_t*)(args.ws + WS_XN), (const pg8::bf16_t*)(args.ws + WS_WIN + layer * WIN_BYTES), MH, PW, D};
            pg8::StaticOrder S; S.init(MH, PW, G, (int)blockIdx.x);
            pg8::EpiBf16 E{(pg8::bf16_t*)(args.ws + WS_PROJ), PW};
            pg8::gemm_phase<pg8::EpiBf16, pg8::StaticOrder, true, true>(lds + RING_OFF, g, S, E, tid);
        } else if (ph == 1) {
            attn_simple(args, layer, wave, lane);
            conv_simple(args, layer, tid);
            if ((int)blockIdx.x < HB * 4) ret_simple(args, (int)blockIdx.x, lds, tid, wave, lane);
        } else if (ph == 2) {
            pg8::Gemm g{(const pg8::bf16_t*)(args.ws + WS_BR), (const pg8::bf16_t*)(args.ws + WS_WBR + layer * WBR_BYTES), MH, D, BRW};
            pg8::StaticOrder S; S.init(MH, D, G, (int)blockIdx.x);
            pg8::EpiGate E{(pg8::bf16_t*)(args.ws + WS_XN), D, (const pg8::bf16_t*)(args.ws + WS_PROJ) + C_MG};
            pg8::gemm_phase<pg8::EpiGate, pg8::StaticOrder, true, true>(lds + RING_OFF, g, S, E, tid);
        } else if (ph == 3) {
            pg8::Gemm g{(const pg8::bf16_t*)(args.ws + WS_XN), (const pg8::bf16_t*)(args.ws + WS_WOUT + layer * WOUT_BYTES), MH, D, D};
            pg8::StaticOrder S; S.init(MH, D, G, (int)blockIdx.x);
            pg8::EpiF32 E{(float*)(args.ws + WS_PROJ), D};
            pg8::gemm_phase<pg8::EpiF32, pg8::StaticOrder, true, true>(lds + RING_OFF, g, S, E, tid);
        } else {
            p5_norm_residual(args, half, layer, gw, NGW, lane);
            if (half == 0 && layer == 1) xn_from_input(args, 1, gw, NGW, lane);
        }
    }
}
typedef const __attribute__((address_space(4))) Args* KArgsPtr;
#if defined(__HIP_DEVICE_COMPILE__)
#define LOAD_ARGS(a) KArgsPtr a##_p = (KArgsPtr)__builtin_amdgcn_kernarg_segment_ptr(); asm volatile("" : "+s"(a##_p)); Args a; __builtin_memcpy(&a, (const void*)a##_p, sizeof(Args))
#else
#define LOAD_ARGS(a) const Args a = args
#endif

__global__ void __launch_bounds__(NTHR, 2) fwd_kernel(Args args) {
    extern __shared__ __attribute__((aligned(16))) unsigned char lds_raw[];
    LAS unsigned char* lds = (LAS unsigned char*)lds_raw;
    for (int u = threadIdx.x; u < (LDS_BYTES - LDSCTL_OFF) / 4; u += NTHR) ((LAS unsigned*)(lds + LDSCTL_OFF))[u] = 0u;
    __syncthreads();
    const int lo = args.ph_lo, hi = args.ph_hi;
#if MK_PER_STEP
    run_step(args, lo, lds, (int)threadIdx.x);
#else
    (void)xcd_barrier_post((unsigned*)((gu32*)(args.ws + WS_CTL) + CW_BAR), (volatile LAS unsigned*)(lds + MISC_OFF) + 8);
#define GRID_BARRIER() do { LOAD_ARGS(b); XcdBarrier bar; bar.bar = (unsigned*)((gu32*)(b.ws + WS_CTL) + CW_BAR); bar.x = xb_xcc_id(); bar.st = (volatile LAS unsigned*)(lds + MISC_OFF) + 8; xcd_barrier(bar); } while (0)
    int s0 = lo;
    if (s0 == 0) {
        { LOAD_ARGS(a); run_step(a, 0, lds, (int)threadIdx.x); }
        if (hi > 1) GRID_BARRIER();
        s0 = 1;
    }
    for (int s = s0; s < hi; ++s) {
        int tid = threadIdx.x; asm volatile("" : "+v"(tid));
        int sq = s; asm volatile("" : "+s"(sq));
        if (sq == 0) continue;
        { LOAD_ARGS(a); run_step(a, sq, lds, tid); }
        if (s + 1 < hi) GRID_BARRIER();
    }
#endif
}

extern "C" void kernel_launch(void* const* d_in, const int* in_sizes, int n_in, void* d_out, int out_size, void* d_ws, size_t ws_size, hipStream_t stream) {
    static int grid = 0;
    if (grid == 0) {
        if (n_in != 10 || in_sizes[0] != BATCH * SEQ * D || out_size != BATCH * SEQ * D || ws_size < WS_END) { fprintf(stderr, "kernel_launch: unexpected shapes (n_in %d in0 %d out %d ws %zu)\n", n_in, n_in > 0 ? in_sizes[0] : -1, out_size, ws_size); grid = -1; return; }
        int dev = 0, cus = 0;
        if (hipGetDevice(&dev) != hipSuccess || hipDeviceGetAttribute(&cus, hipDeviceAttributeMultiprocessorCount, dev) != hipSuccess) { grid = -1; return; }
        if (hipFuncSetAttribute((const void*)fwd_kernel, hipFuncAttributeMaxDynamicSharedMemorySize, LDS_BYTES) != hipSuccess) { fprintf(stderr, "kernel_launch: hipFuncSetAttribute failed\n"); grid = -1; return; }
        (void)hipGetLastError();
        grid = cus;
    }
    if (grid < 0) return;
    if (hipMemsetAsync((char*)d_ws + WS_CTL, 0, CTL_ZERO_BYTES, stream) != hipSuccess) return;
    Args a{};
    for (int i = 0; i < 10; ++i) a.in[i] = (const float*)d_in[i];
    a.out = (float*)d_out; a.ws = (unsigned char*)d_ws;
#if MK_PER_STEP
    for (int s = 0; s < NSTEPS; ++s) { a.ph_lo = s; a.ph_hi = s + 1; hipLaunchKernelGGL(fwd_kernel, dim3(grid), dim3(NTHR), LDS_BYTES, stream, a); }
#else
    a.ph_lo = 0; a.ph_hi = NSTEPS; hipLaunchKernelGGL(fwd_kernel, dim3(grid), dim3(NTHR), LDS_BYTES, stream, a);
#endif
}
```

```cpp
#include <hip/hip_runtime.h>
#include <cstdio>
#include <cstdint>
#include <cmath>
namespace pg8 {
#define PG8_LAS __attribute__((address_space(3)))
typedef unsigned short bf16_t;
typedef short bf16x8 __attribute__((ext_vector_type(8)));
typedef float f32x4 __attribute__((ext_vector_type(4)));
typedef unsigned u32x4 __attribute__((ext_vector_type(4)));
constexpr int BM = 256, BK = 64, HALF = 128, HTB = HALF * BK * 2  , STAGE_BYTES = 8 * HTB, NXCD = 8, WGM = 8;

__host__ __device__ __forceinline__ int lds_byte(int r, int c) { const int st = (r >> 4) * 2 + (c >> 5), rr = r & 15, cc = c & 31, ob = rr * 64 + cc * 2; return st * 1024 + (ob ^ (((ob >> 9) & 1) << 5)); }
__host__ __device__ __forceinline__ void stage_rc(int b, int& R, int& C) { const int st = b / 1024, sb = b % 1024, swz = sb ^ (((sb >> 9) & 1) << 5); R = (st >> 1) * 16 + swz / 64; C = (st & 1) * 32 + (swz % 64) / 2; }
__host__ __device__ __forceinline__ int perm32(int rho) { const int n = rho >> 4, i = rho & 15; return 8 * (i >> 2) + 4 * n + (i & 3); }

struct Unit { int pm, pn; };
struct Gemm { const bf16_t* A; const bf16_t* Bt; int M, N, K; };

struct StaticOrder {
    int nM, nN, nwg, G, c;
    __host__ __device__ void init(int M, int N, int G_, int c_) { nM = M / BM; nN = N / BM; nwg = nM * nN; G = G_; c = c_; }
    __host__ __device__ bool next(int i, Unit& u) const {
        const long L = (long)i * G + c; if (L >= nwg) return false;
        int wgid = (int)L; { const int q = nwg / NXCD, r = nwg % NXCD, xcd = wgid % NXCD, off = wgid / NXCD; wgid = (xcd < r ? xcd * (q + 1) : r * (q + 1) + (xcd - r) * q) + off; }
        const int nig = WGM * nN, gid = wgid / nig, fm = gid * WGM, gsz = (nM - fm) < WGM ? (nM - fm) : WGM;
        u.pm = fm + ((wgid % nig) % gsz); u.pn = (wgid % nig) / gsz; return true;
    }
    __device__ __forceinline__ void a_ready(const Unit&) const {}
    __device__ __forceinline__ void done(const Unit&) const {}
};


__device__ __forceinline__ unsigned cvt_pk_bf16(float lo, float hi) { unsigned r; asm volatile("v_cvt_pk_bf16_f32 %0, %1, %2" : "=v"(r) : "v"(lo), "v"(hi)); return r; }
__device__ __forceinline__ float bflo(unsigned w) { return __uint_as_float(w << 16); }
__device__ __forceinline__ float bfhi(unsigned w) { return __uint_as_float(w & 0xffff0000u); }

struct EpiF32 {
    static constexpr bool PERM = false, AFTER_DRAIN = false, MID = false;
    float* C; int ldc;
    __device__ __forceinline__ void operator()(const f32x4 (&acc)[2][2][4][2], const Unit& u, int wr, int wc, int fr, int fq) const {
        const int row0 = u.pm * BM + wr * 64 + fr, col0 = u.pn * BM + wc * 32 + 4 * fq;
#pragma unroll
        for (int ai = 0; ai < 2; ++ai)
#pragma unroll
            for (int m = 0; m < 4; ++m) { float* rowp = C + (size_t)(row0 + ai * HALF + m * 16) * ldc + col0;
#pragma unroll
                for (int bj = 0; bj < 2; ++bj)
#pragma unroll
                    for (int n = 0; n < 2; ++n) *(f32x4*)(rowp + bj * HALF + n * 16) = acc[ai][bj][m][n]; }
    }
};
struct EpiBf16 {
    static constexpr bool PERM = true, AFTER_DRAIN = false, MID = false;
    bf16_t* O; int ldc;
    __device__ __forceinline__ void operator()(const f32x4 (&acc)[2][2][4][2], const Unit& u, int wr, int wc, int fr, int fq) const {
        const int row0 = u.pm * BM + wr * 64 + fr; const int col0 = u.pn * BM + wc * 32 + 8 * fq;
#pragma unroll
        for (int ai = 0; ai < 2; ++ai)
#pragma unroll
            for (int m = 0; m < 4; ++m) { bf16_t* rowp = O + (size_t)(row0 + ai * HALF + m * 16) * ldc + col0;
#pragma unroll
                for (int bj = 0; bj < 2; ++bj) { const f32x4 v0 = acc[ai][bj][m][0], v1 = acc[ai][bj][m][1];
                    u32x4 w; w.x = cvt_pk_bf16(v0[0], v0[1]); w.y = cvt_pk_bf16(v0[2], v0[3]); w.z = cvt_pk_bf16(v1[0], v1[1]); w.w = cvt_pk_bf16(v1[2], v1[3]);
                    *(u32x4*)(rowp + bj * HALF) = w; } }
    }
};
struct EpiGate {
    static constexpr bool PERM = true, AFTER_DRAIN = false, MID = true;
    static constexpr int LDG = 8448;
    bf16_t* O; int ldc; const bf16_t* G;
    __device__ __forceinline__ void scale(f32x4 (&acc)[2][2][4][2], const Unit& u, int which, int wr, int wc, int fr, int fq) const {
        unsigned off0 = ((unsigned)(u.pm * BM + wr * 64 + fr) * (unsigned)LDG + (unsigned)(u.pn * BM + wc * 32 + 8 * fq)) * 2u;
        asm volatile("" : "+v"(off0));
        const char* gb = (const char*)G + (size_t)((which == 3 ? 2 : which - 1) * 1024) * 2;
#pragma unroll
        for (int ai = 0; ai < 2; ++ai)
#pragma unroll
            for (int m = 0; m < 4; ++m) {
#pragma unroll
                for (int bj = 0; bj < 2; ++bj) {
                    const unsigned off = off0 + (unsigned)((ai * HALF + m * 16) * LDG * 2 + bj * HALF * 2);
                    const u32x4 wa = *(const u32x4*)(gb + off);
                    const u32x4 wb = *(const u32x4*)(gb + off + 2048);
                    float a[8] = {bflo(wa.x), bfhi(wa.x), bflo(wa.y), bfhi(wa.y), bflo(wa.z), bfhi(wa.z), bflo(wa.w), bfhi(wa.w)};
                    float b[8] = {bflo(wb.x), bfhi(wb.x), bflo(wb.y), bfhi(wb.y), bflo(wb.z), bfhi(wb.z), bflo(wb.w), bfhi(wb.w)};
                    float f[8];
#pragma unroll
                    for (int e = 0; e < 8; ++e) {
                        const float ea = __expf(-a[e]);
                        if (which == 3) f[e] = __builtin_amdgcn_rcpf(1.0f + ea);
                        else { const float eb = __expf(-b[e]); f[e] = (1.0f + eb) * __builtin_amdgcn_rcpf(1.0f + ea); }
                    }
                    f32x4 v0 = acc[ai][bj][m][0], v1 = acc[ai][bj][m][1];
                    v0[0] *= f[0]; v0[1] *= f[1]; v0[2] *= f[2]; v0[3] *= f[3]; v1[0] *= f[4]; v1[1] *= f[5]; v1[2] *= f[6]; v1[3] *= f[7];
                    acc[ai][bj][m][0] = v0; acc[ai][bj][m][1] = v1; }
                asm volatile("" ::: "memory"); }
    }
    __device__ __forceinline__ void mid(f32x4 (&acc)[2][2][4][2], const Unit& u, int which, int wr, int wc, int fr, int fq) const { scale(acc, u, which, wr, wc, fr, fq); }
    __device__ __forceinline__ void operator()(f32x4 (&acc)[2][2][4][2], const Unit& u, int wr, int wc, int fr, int fq) const {
        scale(acc, u, 3, wr, wc, fr, fq);
        const int row0 = u.pm * BM + wr * 64 + fr; const int col0 = u.pn * BM + wc * 32 + 8 * fq;
#pragma unroll
        for (int ai = 0; ai < 2; ++ai)
#pragma unroll
            for (int m = 0; m < 4; ++m) { bf16_t* rowp = O + (size_t)(row0 + ai * HALF + m * 16) * ldc + col0;
#pragma unroll
                for (int bj = 0; bj < 2; ++bj) { const f32x4 v0 = acc[ai][bj][m][0], v1 = acc[ai][bj][m][1];
                    u32x4 w; w.x = cvt_pk_bf16(v0[0], v0[1]); w.y = cvt_pk_bf16(v0[2], v0[3]); w.z = cvt_pk_bf16(v1[0], v1[1]); w.w = cvt_pk_bf16(v1[2], v1[3]);
                    *(u32x4*)(rowp + bj * HALF) = w; } }
    }
};
template <class Epi, class Sched, bool ALIGN_EPI = false, bool SP2 = false>
__device__ __forceinline__ void gemm_phase(PG8_LAS unsigned char* lds, const Gemm g, const Sched& S, const Epi& E, const int tid) {
    const int wid = __builtin_amdgcn_readfirstlane(tid >> 6), lane = tid & 63, wr = wid >> 2, wc = wid & 3, fr = lane & 15, fq = lane >> 4;
    const int K = g.K, nt = K / BK;
    unsigned voffA[2], voffB[2];
#pragma unroll
    for (int i = 0; i < 2; ++i) { int R, C; stage_rc(tid * 16 + i * 8192, R, C); const int Rb = Epi::PERM ? ((R & ~31) + perm32(R & 31)) : R;
        voffA[i] = (unsigned)(R * K + C) * 2u; voffB[i] = (unsigned)(Rb * K + C) * 2u; }
    const size_t kstep = (size_t)(BK * 2);
    const size_t hstep = (size_t)HALF * K * 2;
    const size_t tstep = 2 * hstep;
    const unsigned ldsw = (unsigned)wid * 1024u;
    const int aoff = lds_byte(wr * 64 + fr, fq * 8), boff = lds_byte(wc * 32 + fr, fq * 8);
#define PG8_SA(b, h) (((b) * 2 + (h)) * HTB)
#define PG8_SB(b, h) ((4 + (b) * 2 + (h)) * HTB)
#define PG8_STAGE(bufoff, gbase, voff) do { _Pragma("unroll") for (int _i = 0; _i < 2; ++_i) \
        __builtin_amdgcn_global_load_lds((const unsigned*)((const char*)(gbase) + (voff)[_i]), (PG8_LAS unsigned*)(lds + (bufoff) + ldsw + _i * 8192), 16, 0, 0); } while (0)
#define PG8_LDA(dst, b, h) do { _Pragma("unroll") for (int m = 0; m < 4; ++m) _Pragma("unroll") for (int k = 0; k < 2; ++k) dst[m][k] = *(const PG8_LAS bf16x8*)(lds + PG8_SA(b, h) + aoff + m * 2048 + k * 1024); } while (0)
#define PG8_LDB(dst, b, h) do { _Pragma("unroll") for (int n = 0; n < 2; ++n) _Pragma("unroll") for (int k = 0; k < 2; ++k) dst[n][k] = *(const PG8_LAS bf16x8*)(lds + PG8_SB(b, h) + boff + n * 2048 + k * 1024); } while (0)
#define PG8_MMA(ai, bj, At, Bt) do { __builtin_amdgcn_s_setprio(1); _Pragma("unroll") for (int m = 0; m < 4; ++m) _Pragma("unroll") for (int n = 0; n < 2; ++n) _Pragma("unroll") for (int k = 0; k < 2; ++k) \
        acc[ai][bj][m][n] = __builtin_amdgcn_mfma_f32_16x16x32_bf16(Bt[n][k], At[m][k], acc[ai][bj][m][n], 0, 0, 0); __builtin_amdgcn_s_setprio(0); } while (0)
#define PG8_WAIT_V(n) asm volatile("s_waitcnt vmcnt(" #n ")" ::: "memory")
#define PG8_WAIT_L(n) asm volatile("s_waitcnt lgkmcnt(" #n ")" ::: "memory")
#define PG8_BAR __builtin_amdgcn_s_barrier()
#define PG8_SCHED __builtin_amdgcn_sched_barrier(0)
    Unit cur, nxt; int ui = 0;
    if (!S.next(0, cur)) return;
    f32x4 acc[2][2][4][2];
#pragma unroll
    for (int a = 0; a < 2; ++a)
#pragma unroll
        for (int b = 0; b < 2; ++b)
#pragma unroll
            for (int m = 0; m < 4; ++m)
#pragma unroll
                for (int n = 0; n < 2; ++n) acc[a][b][m][n] = (f32x4){0.f, 0.f, 0.f, 0.f};
    bf16x8 At[4][2], B0[2][2], B1[2][2];
    const char* cA = (const char*)g.A + (size_t)cur.pm * tstep; const char* cB = (const char*)g.Bt + (size_t)cur.pn * tstep;
    S.a_ready(cur);
    if constexpr (SP2) {
        PG8_STAGE(PG8_SB(0, 0), cB, voffB); PG8_STAGE(PG8_SB(0, 1), cB + hstep, voffB); PG8_STAGE(PG8_SA(0, 0), cA, voffA); PG8_STAGE(PG8_SA(0, 1), cA + hstep, voffA);
        if (wr == 1) PG8_BAR;
        PG8_WAIT_V(2); PG8_BAR;
        PG8_STAGE(PG8_SB(1, 0), cB + kstep, voffB); PG8_STAGE(PG8_SA(1, 0), cA + kstep, voffA); PG8_STAGE(PG8_SB(1, 1), cB + hstep + kstep, voffB);
        PG8_WAIT_V(6); PG8_BAR;
    } else {
        PG8_STAGE(PG8_SB(0, 0), cB, voffB); PG8_STAGE(PG8_SA(0, 0), cA, voffA); PG8_STAGE(PG8_SB(0, 1), cB + hstep, voffB); PG8_STAGE(PG8_SA(0, 1), cA + hstep, voffA);
        if (wr == 1) PG8_BAR;
        PG8_WAIT_V(4); PG8_BAR;
        PG8_STAGE(PG8_SB(1, 0), cB + kstep, voffB); PG8_STAGE(PG8_SA(1, 0), cA + kstep, voffA); PG8_STAGE(PG8_SB(1, 1), cB + hstep + kstep, voffB);
        PG8_WAIT_V(6); PG8_BAR;
    }
    for (;;) {
        const bool has_next = S.next(ui + 1, nxt);
        const char* nA = has_next ? (const char*)g.A + (size_t)nxt.pm * tstep : cA; const char* nB = has_next ? (const char*)g.Bt + (size_t)nxt.pn * tstep : cB;
        const int seg = Epi::MID ? 8 : nt;
        for (int t0 = 0; t0 < nt; t0 += seg) {
        for (int t = t0; t < t0 + seg; t += 2) {
            const bool last = (t == nt - 2);
            const char* a1 = cA + (size_t)(t + 1) * kstep;
            const char* a2 = last ? nA : cA + (size_t)(t + 2) * kstep; const char* b2 = last ? nB : cB + (size_t)(t + 2) * kstep;
            const char* a3 = a2 + kstep; const char* b3 = b2 + kstep;
            if (last && has_next) S.a_ready(nxt);
            if constexpr (SP2) {
            PG8_LDB(B0, 0, 0); PG8_LDB(B1, 0, 1); PG8_SCHED; PG8_LDA(At, 0, 0); PG8_STAGE(PG8_SA(1, 1), a1 + hstep, voffA);
            PG8_WAIT_V(8); PG8_WAIT_L(0); PG8_BAR; PG8_MMA(0, 0, At, B0); PG8_MMA(0, 1, At, B1); PG8_BAR; PG8_SCHED;
            PG8_LDA(At, 0, 1); PG8_STAGE(PG8_SB(0, 0), b2, voffB); PG8_STAGE(PG8_SB(0, 1), b2 + hstep, voffB); PG8_STAGE(PG8_SA(0, 0), a2, voffA);
            PG8_WAIT_V(8); PG8_WAIT_L(0); PG8_BAR; PG8_MMA(1, 0, At, B0); PG8_MMA(1, 1, At, B1); PG8_BAR; PG8_SCHED;
            PG8_LDB(B0, 1, 0); PG8_LDB(B1, 1, 1); PG8_SCHED; PG8_LDA(At, 1, 0); PG8_STAGE(PG8_SA(0, 1), a2 + hstep, voffA);
            PG8_WAIT_V(8); PG8_WAIT_L(0); PG8_BAR; PG8_MMA(0, 0, At, B0); PG8_MMA(0, 1, At, B1); PG8_BAR; PG8_SCHED;
            PG8_LDA(At, 1, 1); PG8_STAGE(PG8_SB(1, 0), b3, voffB); PG8_STAGE(PG8_SB(1, 1), b3 + hstep, voffB); PG8_STAGE(PG8_SA(1, 0), a3, voffA);
            PG8_WAIT_V(8); PG8_WAIT_L(0); PG8_BAR; PG8_MMA(1, 0, At, B0); PG8_MMA(1, 1, At, B1); PG8_BAR; PG8_SCHED;
            } else {
            PG8_LDB(B0, 0, 0); PG8_SCHED; PG8_LDA(At, 0, 0); PG8_STAGE(PG8_SA(1, 1), a1 + hstep, voffA);
            PG8_WAIT_L(8); PG8_BAR; PG8_WAIT_L(0); PG8_MMA(0, 0, At, B0); PG8_BAR; PG8_SCHED;
            PG8_LDB(B1, 0, 1); PG8_STAGE(PG8_SB(0, 0), b2, voffB);
            PG8_BAR; PG8_WAIT_L(0); PG8_MMA(0, 1, At, B1); PG8_BAR;
            PG8_LDA(At, 0, 1); PG8_STAGE(PG8_SA(0, 0), a2, voffA);
            PG8_BAR; PG8_WAIT_L(0); PG8_MMA(1, 0, At, B0); PG8_BAR; PG8_SCHED;
            PG8_STAGE(PG8_SB(0, 1), b2 + hstep, voffB);
            PG8_WAIT_V(6); PG8_BAR; PG8_MMA(1, 1, At, B1); PG8_BAR;
            PG8_LDB(B0, 1, 0); PG8_SCHED; PG8_LDA(At, 1, 0); PG8_STAGE(PG8_SA(0, 1), a2 + hstep, voffA);
            PG8_WAIT_L(8); PG8_BAR; PG8_WAIT_L(0); PG8_MMA(0, 0, At, B0); PG8_BAR; PG8_SCHED;
            PG8_LDB(B1, 1, 1); PG8_STAGE(PG8_SB(1, 0), b3, voffB);
            PG8_BAR; PG8_WAIT_L(0); PG8_MMA(0, 1, At, B1); PG8_BAR;
            PG8_LDA(At, 1, 1); PG8_STAGE(PG8_SA(1, 0), a3, voffA);
            PG8_BAR; PG8_WAIT_L(0); PG8_MMA(1, 0, At, B0); PG8_BAR; PG8_SCHED;
            PG8_STAGE(PG8_SB(1, 1), b3 + hstep, voffB);
            PG8_WAIT_V(6); PG8_BAR; PG8_MMA(1, 1, At, B1); PG8_BAR;
            }
        }
        if constexpr (Epi::MID) { if (t0 + seg < nt) E.mid(acc, cur, t0 / seg + 1, wr, wc, fr, fq); }
        }
        if constexpr (ALIGN_EPI) { if (wr == 0) PG8_BAR; }
        if constexpr (!Epi::AFTER_DRAIN) { E(acc, cur, wr, wc, fr, fq); S.done(cur); }
        if (!has_next) break;
#pragma unroll
        for (int a = 0; a < 2; ++a)
#pragma unroll
            for (int b = 0; b < 2; ++b)
#pragma unroll
                for (int m = 0; m < 4; ++m)
#pragma unroll
                    for (int n = 0; n < 2; ++n) acc[a][b][m][n] = (f32x4){0.f, 0.f, 0.f, 0.f};
        cur = nxt; cA = nA; cB = nB; ++ui;
        if constexpr (ALIGN_EPI) { if (wr == 1) PG8_BAR; }
    }
    PG8_WAIT_V(0);
    if constexpr (!ALIGN_EPI) { if (wr == 0) PG8_BAR; }
    PG8_BAR;
    if constexpr (Epi::AFTER_DRAIN) { E.fused(acc, cur, wr, wc, fr, fq, lds, wid, lane); S.done(cur); }
#undef PG8_SA
#undef PG8_SB
#undef PG8_STAGE
#undef PG8_LDA
#undef PG8_LDB
#undef PG8_MMA
#undef PG8_WAIT_V
#undef PG8_WAIT_L
#undef PG8_BAR
#undef PG8_SCHED
}
}

constexpr int NWAVES = 8, NTHR = 512;
constexpr int D = 1024, BATCH = 16, SEQ = 2048, BLK = 128, NMETA = 16, PADF = 112, LP = 2176, NCH = 17;
constexpr int PW = 8448;
constexpr int HB = 8, MH = HB * LP;
constexpr int C_AQ = 0, C_AK = 512, C_AV = 640, C_AG = 768, C_RQ = 1280, C_RK = 1792, C_RV = 2304, C_RG = 2816, C_CB = 3328, C_CC = 3840, C_CX = 4352, C_CG = 4864, C_MG = 5376;
constexpr int BRW = 1536;
constexpr float RMS_EPS = 1e-6f, GN_EPS = 1e-6f;
constexpr int NSTEPS = 21;

constexpr size_t MiB = 1u << 20;
constexpr size_t WS_CTL = 0, CTL_ZERO_BYTES = 1 * MiB;
constexpr size_t WS_WIN = 1 * MiB, WIN_BYTES = (size_t)PW * D * 2;
constexpr size_t WS_WBR = 34 * MiB, WBR_BYTES = (size_t)D * BRW * 2;
constexpr size_t WS_WOUT = 40 * MiB, WOUT_BYTES = (size_t)D * D * 2;
constexpr size_t WS_ROT = 44 * MiB;
constexpr size_t WS_XN = 46 * MiB;
constexpr size_t WS_BR = 80 * MiB;
constexpr size_t WS_H = 131 * MiB;
constexpr size_t WS_PROJ = 199 * MiB;
constexpr size_t WS_END = 480 * MiB;
static_assert(WS_WIN + 2 * WIN_BYTES <= WS_WBR && WS_WBR + 2 * WBR_BYTES <= WS_WOUT && WS_WOUT + 2 * WOUT_BYTES <= WS_ROT && WS_ROT + (size_t)LP * 64 * 8 <= WS_XN, "ws map 1");
static_assert(WS_XN + (size_t)MH * D * 2 <= WS_BR && WS_BR + (size_t)MH * BRW * 2 <= WS_H && WS_H + (size_t)MH * D * 4 <= WS_PROJ && WS_PROJ + (size_t)MH * PW * 2 <= WS_END, "ws map 2");
constexpr int CW_TMO = 0, CW_CODE = 1, CW_BAR = 4096;

constexpr int RING_OFF = 0, RING_BYTES = 131072;
constexpr int LDS_BYTES = 147456;
constexpr int LDSCTL_OFF = LDS_BYTES - 1024, MISC_OFF = LDSCTL_OFF + 320;

#define GAS __attribute__((address_space(1)))
#define LAS __attribute__((address_space(3)))
typedef unsigned short bf16;
typedef unsigned v4u __attribute__((ext_vector_type(4)));
typedef unsigned v2u __attribute__((ext_vector_type(2)));
typedef float f32x4 __attribute__((ext_vector_type(4)));
typedef GAS unsigned gu32;
#define RLX_AGENT __ATOMIC_RELAXED, __HIP_MEMORY_SCOPE_AGENT
#define LDS_WAIT() asm volatile("s_waitcnt lgkmcnt(0)" ::: "memory")
#define VM_WAIT() asm volatile("s_waitcnt vmcnt(0)" ::: "memory")
__device__ __forceinline__ unsigned f2bf(float f) { unsigned u = __builtin_bit_cast(unsigned, f); return (u + 0x7fffu + ((u >> 16) & 1u)) >> 16; }
__device__ __forceinline__ unsigned pk2(float lo, float hi) { return f2bf(lo) | (f2bf(hi) << 16); }
__device__ __forceinline__ float bf2f(bf16 h) { return __uint_as_float((unsigned)h << 16); }
__device__ __forceinline__ float bflo(unsigned w) { return __uint_as_float(w << 16); }
__device__ __forceinline__ float bfhi(unsigned w) { return __uint_as_float(w & 0xffff0000u); }
__device__ __forceinline__ v4u zero4() { unsigned z = 0u; asm volatile("" : "+v"(z)); return (v4u){z, z, z, z}; }
__device__ __forceinline__ float silu(float g) { return g / (1.0f + __expf(-g)); }
__device__ __forceinline__ float wave_sum(float v) {
#pragma unroll
    for (int o = 1; o < 64; o <<= 1) v += __shfl_xor(v, o);
    return v;
}
__device__ __forceinline__ float wave_max(float v) {
#pragma unroll
    for (int o = 1; o < 64; o <<= 1) v = fmaxf(v, __shfl_xor(v, o));
    return v;
}
__device__ __forceinline__ int t5_bucket(int n) {
    return n < 16 ? n : 16 + (n >= 19) + (n >= 21) + (n >= 24) + (n >= 27) + (n >= 31) + (n >= 35) + (n >= 40) + (n >= 46) + (n >= 52) + (n >= 59) + (n >= 67) + (n >= 77) + (n >= 87) + (n >= 99) + (n >= 113);
}

#define XB_TMO      128
#define XB_XCNT(j)  (256  + 64 * (j))
#define XB_XSUB(j)  (1280 + 64 * (j))
#define XB_XGEN(j)  (2304 + 64 * (j))
#define XB_TOP      3328
#define XB_TOPGEN   3392
#define XCD_BAR_WORDS 3456
#define XB_SPIN_CAP (1u << 18)

__device__ __forceinline__ unsigned xb_ld(unsigned* p)              { return __hip_atomic_load(p, __ATOMIC_RELAXED, __HIP_MEMORY_SCOPE_AGENT); }
__device__ __forceinline__ unsigned xb_add(unsigned* p, unsigned v) { return __hip_atomic_fetch_add(p, v, __ATOMIC_RELAXED, __HIP_MEMORY_SCOPE_AGENT); }
__device__ __forceinline__ unsigned xb_xcc_id() { return (unsigned)__builtin_amdgcn_s_getreg((3 << 11) | 20) & 0xFu; }
#define XB_SPIN(cond, bar) do { unsigned _sp = 0; while (cond) { __builtin_amdgcn_s_sleep(1); \
    if ((++_sp & 255u) == 0u) { if (xb_ld(&(bar)[XB_TMO])) break; if (_sp > XB_SPIN_CAP) { atomicAdd(&(bar)[XB_TMO], 1u); break; } } } } while (0)

struct XcdBarrier {
    unsigned* bar; unsigned x;
    volatile LAS unsigned* st;
};

__device__ __forceinline__ XcdBarrier xcd_barrier_post(unsigned* bar, volatile LAS unsigned* st) {
    XcdBarrier b; b.bar = bar; b.x = xb_xcc_id(); b.st = st;
    if (threadIdx.x == 0) (void)xb_add(&bar[XB_XCNT(b.x)], 1u);
    return b;
}
__device__ __forceinline__ void xcd_barrier_complete(unsigned* bar, unsigned x, unsigned& nloc, unsigned& nx) {
    const unsigned G = gridDim.x * gridDim.y * gridDim.z;
    unsigned sum, cnt, mine, sp = 0u;
    for (;;) {
        sum = 0u; cnt = 0u; mine = 0u;
#pragma unroll
        for (unsigned j = 0; j < 16; ++j) { const unsigned c = xb_ld(&bar[XB_XCNT(j)]); sum += c; cnt += (c > 0u) ? 1u : 0u; mine = (j == x) ? c : mine; }
        if (sum == G) break;
        __builtin_amdgcn_s_sleep(1);
        if ((++sp & 255u) == 0u) { if (xb_ld(&bar[XB_TMO])) break; if (sp > XB_SPIN_CAP) { atomicAdd(&bar[XB_TMO], 1u); break; } }
    }
    nloc = mine > 0u ? mine : 1u; nx = cnt > 0u ? cnt : 1u;
}

__device__ __forceinline__ void xcd_barrier(const XcdBarrier& b) {
    asm volatile("s_waitcnt vmcnt(0)" ::: "memory");
    __syncthreads();
    if (threadIdx.x == 0) {
        unsigned* bar = b.bar;
        __builtin_amdgcn_s_waitcnt(0);
        unsigned nloc = b.st[0], nx = b.st[1];
        if (nloc == 0u) { xcd_barrier_complete(bar, b.x, nloc, nx); b.st[0] = nloc; b.st[1] = nx; }
        const unsigned old = xb_add(&bar[XB_XSUB(b.x)], 1u);
        const unsigned gen = old / nloc;
        if (old + 1u == (gen + 1u) * nloc) {
            __builtin_amdgcn_fence(__ATOMIC_RELEASE, "agent");
            asm volatile("s_waitcnt vmcnt(0)" ::: "memory");
            const unsigned og = xb_add(&bar[XB_TOP], 1u);
            const unsigned tg = og / nx;
            if (og + 1u == (tg + 1u) * nx) xb_add(&bar[XB_TOPGEN], 1u);
            else XB_SPIN(xb_ld(&bar[XB_TOPGEN]) == tg, bar);
            __builtin_amdgcn_fence(__ATOMIC_ACQUIRE, "agent");
            xb_add(&bar[XB_XGEN(b.x)], 1u);
            asm volatile("s_waitcnt vmcnt(0)" ::: "memory");
        } else {
            XB_SPIN(xb_ld(&bar[XB_XGEN(b.x)]) == gen, bar);
            __builtin_amdgcn_fence(__ATOMIC_ACQUIRE, "agent");
            asm volatile("s_waitcnt vmcnt(0)" ::: "memory");
        }
    }
    __syncthreads();
}


struct Args { const float* in[10]; float* out; unsigned char* ws; int ph_lo, ph_hi; };

__device__ __forceinline__ void p0_transpose_item(const float* W, int K, int N, bf16* WT, int ldt, int koff, LAS float* scr, int item, int lane) {
    const int nblk = N / 32, kb = item / nblk, nb = item % nblk, k0 = 64 * kb, n0 = 32 * nb;
#pragma unroll 8
    for (int i = 0; i < 32; ++i) { const int kk = 2 * i + (lane >> 5); scr[kk * 33 + (lane & 31)] = W[(size_t)(k0 + kk) * N + n0 + (lane & 31)]; }
    LDS_WAIT(); asm volatile("" ::: "memory");
    const int c = lane & 7;
#pragma unroll
    for (int j = 0; j < 4; ++j) { const int n = (lane >> 3) + 8 * j; const LAS float* s = scr + (8 * c) * 33 + n;
        v4u o; o.x = pk2(s[0 * 33], s[1 * 33]); o.y = pk2(s[2 * 33], s[3 * 33]); o.z = pk2(s[4 * 33], s[5 * 33]); o.w = pk2(s[6 * 33], s[7 * 33]);
        *(GAS v4u*)(WT + (size_t)(n0 + n) * ldt + koff + k0 + 8 * c) = o; }
    LDS_WAIT(); asm volatile("" ::: "memory");
}

__device__ __forceinline__ void rms_row_to_bf16(const f32x4 (&v)[4], const float* g, bf16* orow, int lane) {
    float s2 = 0.f;
#pragma unroll
    for (int j = 0; j < 4; ++j) s2 += (v[j].x * v[j].x + v[j].y * v[j].y) + (v[j].z * v[j].z + v[j].w * v[j].w);
    const float rstd = 1.0f / sqrtf(wave_sum(s2) * (1.f / D) + RMS_EPS);
    GAS v2u* o8 = (GAS v2u*)orow + lane;
#pragma unroll
    for (int j = 0; j < 4; ++j) { const f32x4 gg = ((const f32x4*)g)[lane + 64 * j]; v2u w; w.x = pk2(v[j].x * rstd * gg.x, v[j].y * rstd * gg.y); w.y = pk2(v[j].z * rstd * gg.z, v[j].w * rstd * gg.w); o8[64 * j] = w; }
}
__device__ __forceinline__ void zero_row_bf16(bf16* orow, int lane) {
    GAS v2u* o8 = (GAS v2u*)orow + lane;
#pragma unroll
    for (int j = 0; j < 4; ++j) o8[64 * j] = (v2u){0u, 0u};
}
__device__ __forceinline__ void xn_from_input(const Args& a, int half, int gw, int NGW, int lane) {
    bf16* XN = (bf16*)(a.ws + WS_XN);
    for (int r = gw; r < MH; r += NGW) {
        const int bl = r / LP, idx = r - bl * LP, b = half * HB + bl;
        bf16* orow = XN + (size_t)r * D;
        if (idx < PADF) { zero_row_bf16(orow, lane); continue; }
        const float* src = idx < BLK ? a.in[1] + (size_t)(idx - PADF) * D : a.in[0] + ((size_t)b * SEQ + (idx - BLK)) * D;
        f32x4 v[4];
#pragma unroll
        for (int j = 0; j < 4; ++j) v[j] = ((const f32x4*)src)[lane + 64 * j];
        rms_row_to_bf16(v, a.in[3], orow, lane);
    }
}

__device__ __forceinline__ void p0_prologue(const Args& a, LAS unsigned char* lds, int tid, int wave, int lane) {
    LAS float* scr = (LAS float*)(lds + RING_OFF + wave * 16384);
    const int gw = blockIdx.x * NWAVES + wave, NGW = gridDim.x * NWAVES;
    constexpr int I_IN = (D / 64) * (PW / 32), I_BR = (512 / 64) * (D / 32), I_OUT = (D / 64) * (D / 32);
    constexpr int PER_LAYER = I_IN + 3 * I_BR + I_OUT, NITEMS = 2 * PER_LAYER;
    for (int it = gw; it < NITEMS; it += NGW) {
        const int l = it / PER_LAYER; int r = it - l * PER_LAYER;
        if (r < I_IN) { p0_transpose_item(a.in[4] + (size_t)l * D * PW, D, PW, (bf16*)(a.ws + WS_WIN + l * WIN_BYTES), D, 0, scr, r, lane); continue; } r -= I_IN;
        if (r < 3 * I_BR) { const int g = r / I_BR; p0_transpose_item(a.in[7] + ((size_t)l * 3 + g) * 512 * D, 512, D, (bf16*)(a.ws + WS_WBR + l * WBR_BYTES), BRW, g * 512, scr, r - g * I_BR, lane); continue; } r -= 3 * I_BR;
        p0_transpose_item(a.in[8] + (size_t)l * D * D, D, D, (bf16*)(a.ws + WS_WOUT + l * WOUT_BYTES), D, 0, scr, r, lane);
    }
    float* rc = (float*)(a.ws + WS_ROT); float* rs = rc + LP * 64;
    for (int e = (blockIdx.x * NTHR + tid); e < LP * 64; e += gridDim.x * NTHR) {
        const int idx = e >> 6, i = e & 63;
        const float lin = (float)i / 63.0f;
        const float theta = (float)(1.0 / pow(10000.0, (double)lin));
        const float ang = (float)(idx - PADF) * theta;
        rc[e] = (float)cos((double)ang); rs[e] = (float)sin((double)ang);
    }
    xn_from_input(a, 0, gw, NGW, lane);
}

__device__ __forceinline__ void p5_norm_residual(const Args& a, int half, int layer, int gw, int NGW, int lane) {
    const float* Y = (const float*)(a.ws + WS_PROJ); float* H = (float*)(a.ws + WS_H); bf16* XN = (bf16*)(a.ws + WS_XN);
    const float* gpost = a.in[9] + layer * D;
    for (int r = gw; r < MH; r += NGW) {
        const int bl = r / LP, idx = r - bl * LP, b = half * HB + bl;
        if (idx < PADF) {
            if (layer == 0) { zero_row_bf16(XN + (size_t)r * D, lane);
#pragma unroll
                for (int j = 0; j < 4; ++j) ((v4u*)(H + (size_t)r * D))[lane + 64 * j] = zero4(); }
            continue;
        }
        if (layer == 1 && idx < BLK) continue;
        f32x4 y[4], h[4]; float s2 = 0.f;
        const float* hsrc = layer == 0 ? (idx < BLK ? a.in[1] + (size_t)(idx - PADF) * D : a.in[0] + ((size_t)b * SEQ + (idx - BLK)) * D) : H + (size_t)r * D;
#pragma unroll
        for (int j = 0; j < 4; ++j) { y[j] = ((const f32x4*)(Y + (size_t)r * D))[lane + 64 * j]; h[j] = ((const f32x4*)hsrc)[lane + 64 * j]; s2 += (y[j].x * y[j].x + y[j].y * y[j].y) + (y[j].z * y[j].z + y[j].w * y[j].w); }
        const float rstd = 1.0f / sqrtf(wave_sum(s2) * (1.f / D) + RMS_EPS);
#pragma unroll
        for (int j = 0; j < 4; ++j) { const f32x4 gg = ((const f32x4*)gpost)[lane + 64 * j];
            h[j].x += y[j].x * rstd * gg.x; h[j].y += y[j].y * rstd * gg.y; h[j].z += y[j].z * rstd * gg.z; h[j].w += y[j].w * rstd * gg.w; }
        if (layer == 0) {
#pragma unroll
            for (int j = 0; j < 4; ++j) ((f32x4*)(H + (size_t)r * D))[lane + 64 * j] = h[j];
            rms_row_to_bf16(h, a.in[3] + D, XN + (size_t)r * D, lane);
        } else {
            float* orow = a.out + ((size_t)b * SEQ + (idx - BLK)) * D;
#pragma unroll
            for (int j = 0; j < 4; ++j) ((f32x4*)orow)[lane + 64 * j] = h[j];
        }
    }
}

__device__ __forceinline__ void attn_simple(const Args& a, int layer, int wave, int lane) {
    const bf16* PROJ = (const bf16*)(a.ws + WS_PROJ); bf16* BR = (bf16*)(a.ws + WS_BR);
    const float* rel_bias = a.in[2]; const float* sinks = a.in[6] + layer * 8;
    const int gw = blockIdx.x * NWAVES + wave, NGW = gridDim.x * NWAVES;
    for (int task = gw; task < MH * 8; task += NGW) {
        const int r = task >> 3, hq = task & 7, hk = hq >> 2;
        const int idx = r % LP;
        bf16* op = BR + (size_t)r * BRW + hq * 64 + lane;
        if (idx < PADF) { *op = 0; continue; }
        const bf16* prow = PROJ + (size_t)r * PW;
        float q[64];
#pragma unroll
        for (int c = 0; c < 8; ++c) { const v4u w = ((const v4u*)(prow + C_AQ + hq * 64))[c];
            q[8 * c + 0] = bflo(w.x); q[8 * c + 1] = bfhi(w.x); q[8 * c + 2] = bflo(w.y); q[8 * c + 3] = bfhi(w.y); q[8 * c + 4] = bflo(w.z); q[8 * c + 5] = bfhi(w.z); q[8 * c + 6] = bflo(w.w); q[8 * c + 7] = bfhi(w.w); }
        float s[2];
#pragma unroll
        for (int t = 0; t < 2; ++t) {
            const int dist = t * 64 + lane; float acc = 0.f;
            if (idx - dist >= PADF) {
                const v4u* kp = (const v4u*)(PROJ + (size_t)(r - dist) * PW + C_AK + hk * 64);
#pragma unroll
                for (int c = 0; c < 8; ++c) { const v4u w = kp[c];
                    acc += q[8 * c + 0] * bflo(w.x) + q[8 * c + 1] * bfhi(w.x) + q[8 * c + 2] * bflo(w.y) + q[8 * c + 3] * bfhi(w.y) + q[8 * c + 4] * bflo(w.z) + q[8 * c + 5] * bfhi(w.z) + q[8 * c + 6] * bflo(w.w) + q[8 * c + 7] * bfhi(w.w); }
                s[t] = acc * 0.125f + rel_bias[t5_bucket(dist) * 8 + hq];
            } else s[t] = -1e30f;
        }
        const float sink = sinks[hq];
        const float m = fmaxf(wave_max(fmaxf(s[0], s[1])), sink);
        const float e0 = __expf(s[0] - m), e1 = __expf(s[1] - m);
        const float denom = wave_sum(e0 + e1) + __expf(sink - m);
        const float p0 = e0 / denom, p1 = e1 / denom;
        float o = 0.f;
        for (int dist = 0; dist < 128; ++dist) {
            const float pj = __shfl(dist < 64 ? p0 : p1, dist & 63);
            if (idx - dist >= PADF) o += pj * bf2f(PROJ[(size_t)(r - dist) * PW + C_AV + hk * 64 + lane]);
        }
        const float g = bf2f(prow[C_AG + hq * 64 + lane]);
        *op = (bf16)f2bf(o * silu(g));
    }
}
__device__ __forceinline__ void conv_simple(const Args& a, int layer, int tid) {
    const bf16* PROJ = (const bf16*)(a.ws + WS_PROJ); bf16* BR = (bf16*)(a.ws + WS_BR);
    const float* cw = a.in[5] + layer * 3 * 512;
    for (int i = blockIdx.x * NTHR + tid; i < MH * 512; i += gridDim.x * NTHR) {
        const int r = i >> 9, c = i & 511, idx = r % LP;
        bf16* op = BR + (size_t)r * BRW + 1024 + c;
        if (idx < PADF) { *op = 0; continue; }
        const bf16* p = PROJ + (size_t)r * PW + c;
        const float u0 = bf2f(p[C_CC]) * bf2f(p[C_CX]);
        const float u1 = idx - 1 >= PADF ? bf2f(p[C_CC - PW]) * bf2f(p[C_CX - PW]) : 0.f;
        const float u2 = idx - 2 >= PADF ? bf2f(p[C_CC - 2 * PW]) * bf2f(p[C_CX - 2 * PW]) : 0.f;
        const float y = cw[2 * 512 + c] * u0 + cw[512 + c] * u1 + cw[c] * u2;
        *op = (bf16)f2bf(bf2f(p[C_CB]) * y * silu(bf2f(p[C_CG])));
    }
}
__device__ __forceinline__ void ret_simple(const Args& a, int unit, LAS unsigned char* lds, int tid, int wave, int lane) {
    const bf16* PROJ = (const bf16*)(a.ws + WS_PROJ); bf16* BR = (bf16*)(a.ws + WS_BR);
    const float* rc = (const float*)(a.ws + WS_ROT); const float* rs = rc + LP * 64;
    LAS float* qs = (LAS float*)lds; LAS float* ks = qs + 128; LAS float* vs = ks + 128; LAS float* red = vs + 128; LAS float* stat = red + 512;
    const int bl = unit >> 2, h = unit & 3, e = tid & 127, dg = tid >> 7;
    const float gamma = 1.0f - exp2f(-5.0f - (float)h);
    float S[32];
#pragma unroll
    for (int i = 0; i < 32; ++i) S[i] = 0.f;
    if (tid < 128) for (int idx = 0; idx < PADF; ++idx) BR[(size_t)(bl * LP + idx) * BRW + 512 + h * 128 + tid] = 0;
    for (int idx = PADF; idx < LP; ++idx) {
        const int r = bl * LP + idx; const bf16* prow = PROJ + (size_t)r * PW;
        if (tid < 384) {
            const int which = tid >> 7, d = tid & 127;
            if (which == 2) vs[d] = bf2f(prow[C_RV + h * 128 + d]);
            else { const int base = (which == 0 ? C_RQ : C_RK) + h * 128, i = d & 63; const float c = rc[idx * 64 + i], s = rs[idx * 64 + i];
                const float t1 = bf2f(prow[base + i]), t2 = bf2f(prow[base + 64 + i]);
                float val = d < 64 ? t1 * c - t2 * s : t1 * s + t2 * c;
                if (which == 1) { val *= 0.08838834764831845f; ks[d] = val; } else qs[d] = val; }
        }
        __syncthreads();
        float part = 0.f; const float ve = vs[e];
#pragma unroll
        for (int i = 0; i < 32; ++i) { S[i] = gamma * S[i] + ks[dg * 32 + i] * ve; part += qs[dg * 32 + i] * S[i]; }
        red[dg * 128 + e] = part;
        __syncthreads();
        float o = 0.f, dv = 0.f;
        if (tid < 128) { o = (red[e] + red[128 + e]) + (red[256 + e] + red[384 + e]); const float ws_ = wave_sum(o); if (lane == 0) stat[wave] = ws_; }
        __syncthreads();
        if (tid < 128) { const float mu = (stat[0] + stat[1]) * (1.f / 128.f); dv = o - mu; const float wq = wave_sum(dv * dv); if (lane == 0) stat[2 + wave] = wq; }
        __syncthreads();
        if (tid < 128) { const float var = (stat[2] + stat[3]) * (1.f / 128.f); const float on = dv / sqrtf(var + GN_EPS);
            BR[(size_t)r * BRW + 512 + h * 128 + e] = (bf16)f2bf(on * silu(bf2f(prow[C_RG + h * 128 + e]))); }
    }
    __syncthreads();
}


typedef float f32x16 __attribute__((ext_vector_type(16)));
typedef short bf16x8 __attribute__((ext_vector_type(8)));
#define MFMA32(a, b, c) __builtin_amdgcn_mfma_f32_32x32x16_bf16((a), (b), (c), 0, 0, 0)
__device__ __forceinline__ unsigned cvtpk(float lo, float hi) { unsigned r; asm volatile("v_cvt_pk_bf16_f32 %0, %1, %2" : "=v"(r) : "v"(lo), "v"(hi)); return r; }
__device__ __forceinline__ bf16x8 pack8(float a0, float a1, float a2, float a3, float a4, float a5, float a6, float a7) {
    v4u w; w.x = cvtpk(a0, a1); w.y = cvtpk(a2, a3); w.z = cvtpk(a4, a5); w.w = cvtpk(a6, a7); return __builtin_bit_cast(bf16x8, w);
}
__device__ __forceinline__ bf16x8 join2(v2u lo, v2u hi) { v4u w; w.x = lo.x; w.y = lo.y; w.z = hi.x; w.w = hi.y; return __builtin_bit_cast(bf16x8, w); }

constexpr int AT_KP = 144, AT_VP = 520;
constexpr int AT_K_OFF = 0, AT_VT_OFF = 256 * AT_KP, AT_BIAS_OFF = AT_VT_OFF + 64 * AT_VP, AT_END = AT_BIAS_OFF + 4 * 128 * 4;
__device__ __forceinline__ void attn_unit(const Args& a, int layer, int unit, LAS unsigned char* lds, int tid) {
    const bf16* PROJ = (const bf16*)(a.ws + WS_PROJ); bf16* BR = (bf16*)(a.ws + WS_BR);
    const int lane = tid & 63, wave = __builtin_amdgcn_readfirstlane(tid >> 6);
    const int bl = unit / (NCH * 2), rem = unit - bl * (NCH * 2), n = rem >> 1, hk = rem & 1;
    const int row_c0 = bl * LP + n * BLK;
#pragma unroll
    for (int k4 = 0; k4 < 4; ++k4) {
        const int it = tid + k4 * NTHR, c = it >> 3, ch = it & 7; v4u v = zero4();
        if (n > 0 || c >= BLK) v = *(const v4u*)(PROJ + (size_t)(row_c0 - BLK + c) * PW + C_AK + hk * 64 + ch * 8);
        *(LAS v4u*)(lds + AT_K_OFF + c * AT_KP + ch * 16) = v;
    }
#pragma unroll
    for (int k2 = 0; k2 < 2; ++k2) {
        const int it = tid + k2 * NTHR, ch = it >> 7, i = it & 127, c0 = 2 * i; v4u v0 = zero4(), v1 = v0;
        if (n > 0 || c0 >= BLK) { const bf16* p = PROJ + (size_t)(row_c0 - BLK + c0) * PW + C_AV + hk * 64 + ch * 8; v0 = *(const v4u*)p; v1 = *(const v4u*)(p + PW); }
        const unsigned e0[4] = {v0.x, v0.y, v0.z, v0.w}, e1[4] = {v1.x, v1.y, v1.z, v1.w};
#pragma unroll
        for (int k = 0; k < 4; ++k) {
            const unsigned lo = (e0[k] & 0xffffu) | (e1[k] << 16), hi = (e0[k] >> 16) | (e1[k] & 0xffff0000u);
            *(LAS unsigned*)(lds + AT_VT_OFF + (ch * 8 + 2 * k) * AT_VP + c0 * 2) = lo;
            *(LAS unsigned*)(lds + AT_VT_OFF + (ch * 8 + 2 * k + 1) * AT_VP + c0 * 2) = hi;
        }
    }
    { const int g = tid >> 7, dist = tid & 127; ((LAS float*)(lds + AT_BIAS_OFF))[tid] = a.in[2][t5_bucket(dist) * 8 + hk * 4 + g]; }
    __syncthreads();
    const int g = wave & 3, qh = wave >> 2, hq = hk * 4 + g, q = lane & 31, h = lane >> 5;
    const float sink = a.in[6][layer * 8 + hq];
    const LAS float* biasd = (const LAS float*)(lds + AT_BIAS_OFF) + g * 128;
    for (int qb2 = 0; qb2 < 2; ++qb2) {
        const int r0 = 64 * qh + 32 * qb2;
        const size_t grow = (size_t)(row_c0 + r0 + q);
        bf16x8 qf[4];
#pragma unroll
        for (int ks = 0; ks < 4; ++ks) qf[ks] = *(const bf16x8*)(PROJ + grow * PW + C_AQ + hq * 64 + 16 * ks + 8 * h);
        f32x16 sc[5];
#pragma unroll
        for (int t = 0; t < 5; ++t) {
            f32x16 acc;
#pragma unroll
            for (int i = 0; i < 16; ++i) acc[i] = 0.f;
#pragma unroll
            for (int ks = 0; ks < 4; ++ks) { const bf16x8 kf = *(const LAS bf16x8*)(lds + AT_K_OFF + (r0 + 32 * t + q) * AT_KP + (16 * ks + 8 * h) * 2); acc = MFMA32(kf, qf[ks], acc); }
            sc[t] = acc;
        }
        float mloc = -1e30f;
#pragma unroll
        for (int t = 0; t < 5; ++t)
#pragma unroll
            for (int reg = 0; reg < 16; ++reg) {
                const int kk = (reg & 3) + 8 * (reg >> 2) + 4 * h, dist = 128 + q - 32 * t - kk, kidx = (n - 1) * BLK + r0 + 32 * t + kk;
                const bool ok = (dist >= 0) && (dist < 128) && (kidx >= PADF);
                const float s = ok ? sc[t][reg] * 0.125f + biasd[dist & 127] : -1e30f;
                sc[t][reg] = s; mloc = fmaxf(mloc, s);
            }
        const float m = fmaxf(fmaxf(mloc, __shfl_xor(mloc, 32)), sink);
        float lloc = 0.f;
#pragma unroll
        for (int t = 0; t < 5; ++t)
#pragma unroll
            for (int reg = 0; reg < 16; ++reg) { const float p = __expf(sc[t][reg] - m); sc[t][reg] = p; lloc += p; }
        const float inv = 1.0f / (lloc + __shfl_xor(lloc, 32) + __expf(sink - m));
        f32x16 o[2];
#pragma unroll
        for (int db = 0; db < 2; ++db)
#pragma unroll
            for (int i = 0; i < 16; ++i) o[db][i] = 0.f;
#pragma unroll
        for (int t = 0; t < 5; ++t)
#pragma unroll
            for (int s2 = 0; s2 < 2; ++s2) {
                const bf16x8 pf = pack8(sc[t][8 * s2 + 0], sc[t][8 * s2 + 1], sc[t][8 * s2 + 2], sc[t][8 * s2 + 3], sc[t][8 * s2 + 4], sc[t][8 * s2 + 5], sc[t][8 * s2 + 6], sc[t][8 * s2 + 7]);
                const int keyb = r0 + 32 * t + 16 * s2 + 4 * h;
#pragma unroll
                for (int db = 0; db < 2; ++db) {
                    const LAS unsigned char* vp = lds + AT_VT_OFF + (32 * db + q) * AT_VP + keyb * 2;
                    const bf16x8 vf = join2(*(const LAS v2u*)vp, *(const LAS v2u*)(vp + 16));
                    o[db] = MFMA32(vf, pf, o[db]);
                }
            }
        const bf16* grp = PROJ + grow * PW + C_AG + hq * 64; bf16* orp = BR + grow * BRW + hq * 64;
#pragma unroll
        for (int db = 0; db < 2; ++db)
#pragma unroll
            for (int g4 = 0; g4 < 4; ++g4) {
                const int d0 = 32 * db + 8 * g4 + 4 * h;
                const v2u gw = *(const v2u*)(grp + d0);
                v2u w; w.x = cvtpk(o[db][4 * g4 + 0] * inv * silu(bflo(gw.x)), o[db][4 * g4 + 1] * inv * silu(bfhi(gw.x)));
                w.y = cvtpk(o[db][4 * g4 + 2] * inv * silu(bflo(gw.y)), o[db][4 * g4 + 3] * inv * silu(bfhi(gw.y)));
                *(v2u*)(orp + d0) = w;
            }
    }
    __syncthreads();
}

constexpr int CV_RUN = 8;
__device__ __forceinline__ void conv_item(const Args& a, int layer, int item, int lane) {
    const bf16* PROJ = (const bf16*)(a.ws + WS_PROJ); bf16* BR = (bf16*)(a.ws + WS_BR);
    const float* cw = a.in[5] + layer * 3 * 512 + lane * 8;
    float w0[8], w1[8], w2[8];
#pragma unroll
    for (int e = 0; e < 8; ++e) { w0[e] = cw[e]; w1[e] = cw[512 + e]; w2[e] = cw[1024 + e]; }
    const int rbeg = item * CV_RUN;
    const int idx0 = rbeg % LP;
    float u1[8], u2[8];
#pragma unroll
    for (int e = 0; e < 8; ++e) { u1[e] = 0.f; u2[e] = 0.f; }
    if (idx0 - 1 >= PADF) {
#pragma unroll
        for (int k = 2; k >= 1; --k) {
            const bf16* p = PROJ + (size_t)(rbeg - k) * PW + lane * 8;
            const v4u c = *(const v4u*)(p + C_CC), x = *(const v4u*)(p + C_CX);
            const unsigned cc[4] = {c.x, c.y, c.z, c.w}, xx[4] = {x.x, x.y, x.z, x.w};
#pragma unroll
            for (int e = 0; e < 4; ++e) { const float ua = bflo(cc[e]) * bflo(xx[e]), ub = bfhi(cc[e]) * bfhi(xx[e]); if (k == 2) { u2[2 * e] = ua; u2[2 * e + 1] = ub; } else { u1[2 * e] = ua; u1[2 * e + 1] = ub; } }
        }
    }
    for (int k = 0; k < CV_RUN; ++k) {
        const int r = rbeg + k, idx = idx0 + k;
        v4u outw = zero4();
        if (idx >= PADF) {
            const bf16* p = PROJ + (size_t)r * PW + lane * 8;
            const v4u c = *(const v4u*)(p + C_CC), x = *(const v4u*)(p + C_CX), b = *(const v4u*)(p + C_CB), gt = *(const v4u*)(p + C_CG);
            const unsigned cc[4] = {c.x, c.y, c.z, c.w}, xx[4] = {x.x, x.y, x.z, x.w}, bb[4] = {b.x, b.y, b.z, b.w}, gg[4] = {gt.x, gt.y, gt.z, gt.w};
            unsigned ow[4];
#pragma unroll
            for (int e = 0; e < 4; ++e) {
                const float ua = bflo(cc[e]) * bflo(xx[e]), ub = bfhi(cc[e]) * bfhi(xx[e]);
                const float ya = w2[2 * e] * ua + w1[2 * e] * u1[2 * e] + w0[2 * e] * u2[2 * e], yb = w2[2 * e + 1] * ub + w1[2 * e + 1] * u1[2 * e + 1] + w0[2 * e + 1] * u2[2 * e + 1];
                u2[2 * e] = u1[2 * e]; u2[2 * e + 1] = u1[2 * e + 1]; u1[2 * e] = ua; u1[2 * e + 1] = ub;
                ow[e] = cvtpk(bflo(bb[e]) * ya * silu(bflo(gg[e])), bfhi(bb[e]) * yb * silu(bfhi(gg[e])));
            }
            outw = (v4u){ow[0], ow[1], ow[2], ow[3]};
        }
        *(v4u*)(BR + (size_t)r * BRW + 1024 + lane * 8) = outw;
    }
}

constexpr int RT_P = 272;
constexpr int RT_KP = 0, RT_VT = 128 * RT_P, RT_KZT = 2 * 128 * RT_P, RT_ST = 3 * 128 * RT_P, RT_STAT = 4 * 128 * RT_P, RT_END = RT_STAT + 2 * 128 * 8;
__device__ __forceinline__ void ret_unit(const Args& a, int unit, LAS unsigned char* lds, int tid) {
    const bf16* PROJ = (const bf16*)(a.ws + WS_PROJ); bf16* BR = (bf16*)(a.ws + WS_BR);
    const float* rc = (const float*)(a.ws + WS_ROT); const float* rs = rc + LP * 64;
    const int lane = tid & 63, wave = __builtin_amdgcn_readfirstlane(tid >> 6);
    const int bl = unit >> 2, hd = unit & 3;
    const float l2g = log2f(1.0f - exp2f(-5.0f - (float)hd));
    const float g128 = exp2f(128.0f * l2g);
    const int it = wave & 3, eh = wave >> 2, q = lane & 31, h = lane >> 5;
    { const v4u z4 = zero4(); for (int i = tid; i < 128 * RT_P / 16; i += NTHR) *(LAS v4u*)(lds + RT_ST + i * 16) = z4; }
    f32x16 Sacc[2];
#pragma unroll
    for (int b = 0; b < 2; ++b)
#pragma unroll
        for (int i = 0; i < 16; ++i) Sacc[b][i] = 0.f;
    for (int n = 0; n < NCH; ++n) {
        const int row0 = bl * LP + n * BLK;
        {
            const int c = wave, jp = lane, j0 = 2 * jp;
            const bf16* p = PROJ + (size_t)(row0 + j0) * PW + C_RK + hd * 128 + c * 8;
            const v4u a0 = *(const v4u*)p, a1 = *(const v4u*)(p + 64), b0 = *(const v4u*)(p + PW), b1 = *(const v4u*)(p + PW + 64);
            const int idx0 = n * BLK + j0;
            const f32x4 ca0 = *(const f32x4*)(rc + idx0 * 64 + c * 8), ca1 = *(const f32x4*)(rc + idx0 * 64 + c * 8 + 4), sa0 = *(const f32x4*)(rs + idx0 * 64 + c * 8), sa1 = *(const f32x4*)(rs + idx0 * 64 + c * 8 + 4);
            const f32x4 cb0 = *(const f32x4*)(rc + (idx0 + 1) * 64 + c * 8), cb1 = *(const f32x4*)(rc + (idx0 + 1) * 64 + c * 8 + 4), sb0 = *(const f32x4*)(rs + (idx0 + 1) * 64 + c * 8), sb1 = *(const f32x4*)(rs + (idx0 + 1) * 64 + c * 8 + 4);
            const unsigned A0[4] = {a0.x, a0.y, a0.z, a0.w}, A1[4] = {a1.x, a1.y, a1.z, a1.w}, B0[4] = {b0.x, b0.y, b0.z, b0.w}, B1[4] = {b1.x, b1.y, b1.z, b1.w};
            const float CA[8] = {ca0.x, ca0.y, ca0.z, ca0.w, ca1.x, ca1.y, ca1.z, ca1.w}, SA[8] = {sa0.x, sa0.y, sa0.z, sa0.w, sa1.x, sa1.y, sa1.z, sa1.w};
            const float CB[8] = {cb0.x, cb0.y, cb0.z, cb0.w, cb1.x, cb1.y, cb1.z, cb1.w}, SB[8] = {sb0.x, sb0.y, sb0.z, sb0.w, sb1.x, sb1.y, sb1.z, sb1.w};
            const float ksc = 0.08838834764831845f;
            const float za = exp2f((float)(127 - j0) * l2g), zb = exp2f((float)(126 - j0) * l2g);
            float ra1[8], ra2[8], rb1[8], rb2[8];
#pragma unroll
            for (int e = 0; e < 8; ++e) {
                const float t1a = (e & 1) ? bfhi(A0[e >> 1]) : bflo(A0[e >> 1]), t2a = (e & 1) ? bfhi(A1[e >> 1]) : bflo(A1[e >> 1]);
                const float t1b = (e & 1) ? bfhi(B0[e >> 1]) : bflo(B0[e >> 1]), t2b = (e & 1) ? bfhi(B1[e >> 1]) : bflo(B1[e >> 1]);
                ra1[e] = (t1a * CA[e] - t2a * SA[e]) * ksc; ra2[e] = (t1a * SA[e] + t2a * CA[e]) * ksc;
                rb1[e] = (t1b * CB[e] - t2b * SB[e]) * ksc; rb2[e] = (t1b * SB[e] + t2b * CB[e]) * ksc;
            }
            v4u w;
            w.x = cvtpk(ra1[0], ra1[1]); w.y = cvtpk(ra1[2], ra1[3]); w.z = cvtpk(ra1[4], ra1[5]); w.w = cvtpk(ra1[6], ra1[7]); *(LAS v4u*)(lds + RT_KP + j0 * RT_P + (c * 8) * 2) = w;
            w.x = cvtpk(ra2[0], ra2[1]); w.y = cvtpk(ra2[2], ra2[3]); w.z = cvtpk(ra2[4], ra2[5]); w.w = cvtpk(ra2[6], ra2[7]); *(LAS v4u*)(lds + RT_KP + j0 * RT_P + (64 + c * 8) * 2) = w;
            w.x = cvtpk(rb1[0], rb1[1]); w.y = cvtpk(rb1[2], rb1[3]); w.z = cvtpk(rb1[4], rb1[5]); w.w = cvtpk(rb1[6], rb1[7]); *(LAS v4u*)(lds + RT_KP + (j0 + 1) * RT_P + (c * 8) * 2) = w;
            w.x = cvtpk(rb2[0], rb2[1]); w.y = cvtpk(rb2[2], rb2[3]); w.z = cvtpk(rb2[4], rb2[5]); w.w = cvtpk(rb2[6], rb2[7]); *(LAS v4u*)(lds + RT_KP + (j0 + 1) * RT_P + (64 + c * 8) * 2) = w;
#pragma unroll
            for (int e = 0; e < 8; ++e) {
                *(LAS unsigned*)(lds + RT_KZT + (c * 8 + e) * RT_P + j0 * 2) = cvtpk(ra1[e] * za, rb1[e] * zb);
                *(LAS unsigned*)(lds + RT_KZT + (64 + c * 8 + e) * RT_P + j0 * 2) = cvtpk(ra2[e] * za, rb2[e] * zb);
            }
        }
#pragma unroll
        for (int cc = 0; cc < 2; ++cc) {
            const int c = wave + 8 * cc, j0 = 2 * lane;
            const bf16* p = PROJ + (size_t)(row0 + j0) * PW + C_RV + hd * 128 + c * 8;
            const v4u v0 = *(const v4u*)p, v1 = *(const v4u*)(p + PW);
            const unsigned e0[4] = {v0.x, v0.y, v0.z, v0.w}, e1[4] = {v1.x, v1.y, v1.z, v1.w};
#pragma unroll
            for (int k = 0; k < 4; ++k) {
                *(LAS unsigned*)(lds + RT_VT + (c * 8 + 2 * k) * RT_P + j0 * 2) = (e0[k] & 0xffffu) | (e1[k] << 16);
                *(LAS unsigned*)(lds + RT_VT + (c * 8 + 2 * k + 1) * RT_P + j0 * 2) = (e0[k] >> 16) | (e1[k] & 0xffff0000u);
            }
        }
        bf16x8 qf[8];
        {
            const int il = 32 * it + q, idx = n * BLK + il;
            const bf16* p = PROJ + (size_t)(row0 + il) * PW + C_RQ + hd * 128;
#pragma unroll
            for (int ks = 0; ks < 4; ++ks) {
                const int d0 = 16 * ks + 8 * h;
                const v4u x1 = *(const v4u*)(p + d0), x2 = *(const v4u*)(p + 64 + d0);
                const f32x4 c0 = *(const f32x4*)(rc + idx * 64 + d0), c1 = *(const f32x4*)(rc + idx * 64 + d0 + 4), s0 = *(const f32x4*)(rs + idx * 64 + d0), s1 = *(const f32x4*)(rs + idx * 64 + d0 + 4);
                const unsigned X1[4] = {x1.x, x1.y, x1.z, x1.w}, X2[4] = {x2.x, x2.y, x2.z, x2.w};
                const float C[8] = {c0.x, c0.y, c0.z, c0.w, c1.x, c1.y, c1.z, c1.w}, S[8] = {s0.x, s0.y, s0.z, s0.w, s1.x, s1.y, s1.z, s1.w};
                float r1[8], r2[8];
#pragma unroll
                for (int e = 0; e < 8; ++e) { const float t1 = (e & 1) ? bfhi(X1[e >> 1]) : bflo(X1[e >> 1]), t2 = (e & 1) ? bfhi(X2[e >> 1]) : bflo(X2[e >> 1]); r1[e] = t1 * C[e] - t2 * S[e]; r2[e] = t1 * S[e] + t2 * C[e]; }
                qf[ks] = pack8(r1[0], r1[1], r1[2], r1[3], r1[4], r1[5], r1[6], r1[7]);
                qf[ks + 4] = pack8(r2[0], r2[1], r2[2], r2[3], r2[4], r2[5], r2[6], r2[7]);
            }
        }
        __syncthreads();
        bf16x8 tf[4][2];
#pragma unroll
        for (int jt = 0; jt < 4; ++jt) {
            if (jt <= it) {
                f32x16 acc;
#pragma unroll
                for (int i = 0; i < 16; ++i) acc[i] = 0.f;
#pragma unroll
                for (int ks = 0; ks < 8; ++ks) { const bf16x8 kf = *(const LAS bf16x8*)(lds + RT_KP + (32 * jt + q) * RT_P + (16 * ks + 8 * h) * 2); acc = MFMA32(kf, qf[ks], acc); }
#pragma unroll
                for (int reg = 0; reg < 16; ++reg) {
                    const int diff = (32 * it + q) - (32 * jt + (reg & 3) + 8 * (reg >> 2) + 4 * h);
                    acc[reg] = diff >= 0 ? acc[reg] * exp2f((float)diff * l2g) : 0.f;
                }
                tf[jt][0] = pack8(acc[0], acc[1], acc[2], acc[3], acc[4], acc[5], acc[6], acc[7]);
                tf[jt][1] = pack8(acc[8], acc[9], acc[10], acc[11], acc[12], acc[13], acc[14], acc[15]);
            }
        }
        const float xi = exp2f((float)(32 * it + q + 1) * l2g);
        f32x16 o[2];
#pragma unroll
        for (int eb = 0; eb < 2; ++eb) {
            const int et = 2 * eh + eb;
            f32x16 ain, ac;
#pragma unroll
            for (int i = 0; i < 16; ++i) { ain[i] = 0.f; ac[i] = 0.f; }
#pragma unroll
            for (int jt = 0; jt < 4; ++jt) {
                if (jt <= it) {
#pragma unroll
                    for (int s2 = 0; s2 < 2; ++s2) {
                        const LAS unsigned char* vp = lds + RT_VT + (32 * et + q) * RT_P + (32 * jt + 16 * s2 + 4 * h) * 2;
                        ain = MFMA32(join2(*(const LAS v2u*)vp, *(const LAS v2u*)(vp + 16)), tf[jt][s2], ain);
                    }
                }
            }
#pragma unroll
            for (int ks = 0; ks < 8; ++ks) { const bf16x8 sf = *(const LAS bf16x8*)(lds + RT_ST + (32 * et + q) * RT_P + (16 * ks + 8 * h) * 2); ac = MFMA32(sf, qf[ks], ac); }
#pragma unroll
            for (int i = 0; i < 16; ++i) o[eb][i] = ain[i] + xi * ac[i];
        }
        float sm = 0.f;
#pragma unroll
        for (int eb = 0; eb < 2; ++eb)
#pragma unroll
            for (int i = 0; i < 16; ++i) sm += o[eb][i];
        sm += __shfl_xor(sm, 32);
        const float mw = sm * (1.0f / 64.0f);
        float m2 = 0.f;
#pragma unroll
        for (int eb = 0; eb < 2; ++eb)
#pragma unroll
            for (int i = 0; i < 16; ++i) { const float dlt = o[eb][i] - mw; m2 += dlt * dlt; }
        m2 += __shfl_xor(m2, 32);
        if (h == 0) { LAS float* st = (LAS float*)(lds + RT_STAT) + (eh * 128 + 32 * it + q) * 2; st[0] = mw; st[1] = m2; }
#pragma unroll
        for (int eb = 0; eb < 2; ++eb) {
            const int et = 2 * eh + eb;
#pragma unroll
            for (int i = 0; i < 16; ++i) Sacc[eb][i] *= g128;
#pragma unroll
            for (int s8 = 0; s8 < 8; ++s8) {
                const bf16x8 kz = *(const LAS bf16x8*)(lds + RT_KZT + (32 * it + q) * RT_P + (16 * s8 + 8 * h) * 2);
                const bf16x8 vf = *(const LAS bf16x8*)(lds + RT_VT + (32 * et + q) * RT_P + (16 * s8 + 8 * h) * 2);
                Sacc[eb] = MFMA32(kz, vf, Sacc[eb]);
            }
        }
        __syncthreads();
        {
            const LAS float* s0 = (const LAS float*)(lds + RT_STAT) + (0 * 128 + 32 * it + q) * 2; const LAS float* s1 = (const LAS float*)(lds + RT_STAT) + (1 * 128 + 32 * it + q) * 2;
            const float m0 = s0[0], q0 = s0[1], m1 = s1[0], q1 = s1[1];
            const float mean = 0.5f * (m0 + m1), dm = m0 - m1;
            const float var = (q0 + q1 + 32.0f * dm * dm) * (1.0f / 128.0f);
            const float rstd = 1.0f / sqrtf(var + GN_EPS);
            const size_t grow = (size_t)(row0 + 32 * it + q);
            const bf16* grp = PROJ + grow * PW + C_RG + hd * 128; bf16* orp = BR + grow * BRW + 512 + hd * 128;
#pragma unroll
            for (int eb = 0; eb < 2; ++eb)
#pragma unroll
                for (int g4 = 0; g4 < 4; ++g4) {
                    const int e0 = 32 * (2 * eh + eb) + 8 * g4 + 4 * h;
                    const v2u gw = *(const v2u*)(grp + e0);
                    v2u w; w.x = cvtpk((o[eb][4 * g4 + 0] - mean) * rstd * silu(bflo(gw.x)), (o[eb][4 * g4 + 1] - mean) * rstd * silu(bfhi(gw.x)));
                    w.y = cvtpk((o[eb][4 * g4 + 2] - mean) * rstd * silu(bflo(gw.y)), (o[eb][4 * g4 + 3] - mean) * rstd * silu(bfhi(gw.y)));
                    *(v2u*)(orp + e0) = w;
                }
#pragma unroll
            for (int eb = 0; eb < 2; ++eb)
#pragma unroll
                for (int g4 = 0; g4 < 4; ++g4) {
                    v2u w; w.x = cvtpk(Sacc[eb][4 * g4 + 0], Sacc[eb][4 * g4 + 1]); w.y = cvtpk(Sacc[eb][4 * g4 + 2], Sacc[eb][4 * g4 + 3]);
                    *(LAS v2u*)(lds + RT_ST + (32 * (2 * eh + eb) + q) * RT_P + (32 * it + 8 * g4 + 4 * h) * 2) = w;
                }
        }
    }
    __syncthreads();
}
static_assert(AT_END <= LDSCTL_OFF && RT_END <= LDSCTL_OFF, "mixer LDS images fit below the control words");

#ifndef MIX_SIMPLE
#define MIX_SIMPLE 0
#endif
#ifndef MK_PER_STEP
#define MK_PER_STEP 0
#endif
__device__ __forceinline__ void run_step(const Args& args, int s, LAS unsigned char* lds, int tid, int bid, int G) {
    const int lane = tid & 63, wave = __builtin_amdgcn_readfirstlane(tid >> 6);
    const int gw = bid * NWAVES + wave, NGW = G * NWAVES;
    if (s == 0) {
        p0_prologue(args, lds, tid, wave, lane);
    } else {
        const int q = s - 1, hl = q / 5, ph = q - hl * 5, half = hl >> 1, layer = hl & 1;
        if (ph == 0) {
            pg8::Gemm g{(const pg8::bf16_t*)(args.ws + WS_XN), (const pg8::bf16_t*)(args.ws + WS_WIN + layer * WIN_BYTES), MH, PW, D};
            pg8::StaticOrder S; S.init(MH, PW, G, bid);
            pg8::EpiBf16 E{(pg8::bf16_t*)(args.ws + WS_PROJ), PW};
            pg8::gemm_phase<pg8::EpiBf16, pg8::StaticOrder, true, true>(lds + RING_OFF, g, S, E, tid);
        } else if (ph == 1) {
#if MIX_SIMPLE
            attn_simple(args, layer, wave, lane);
            conv_simple(args, layer, tid);
            if (bid < HB * 4) ret_simple(args, bid, lds, tid, wave, lane);
#else
            const int NRET = HB * 4, b = bid;
            if (b < NRET) ret_unit(args, b, lds, tid);
            else {
                for (int u = b - NRET; u < HB * NCH * 2; u += G - NRET) attn_unit(args, layer, u, lds, tid);
                for (int it = (b - NRET) * NWAVES + wave; it < MH / CV_RUN; it += (G - NRET) * NWAVES) conv_item(args, layer, it, lane);
            }
#endif
        } else if (ph == 2) {
            pg8::Gemm g{(const pg8::bf16_t*)(args.ws + WS_BR), (const pg8::bf16_t*)(args.ws + WS_WBR + layer * WBR_BYTES), MH, D, BRW};
            pg8::StaticOrder S; S.init(MH, D, G, bid);
            pg8::EpiGate E{(pg8::bf16_t*)(args.ws + WS_XN), D, (const pg8::bf16_t*)(args.ws + WS_PROJ) + C_MG};
            pg8::gemm_phase<pg8::EpiGate, pg8::StaticOrder, true, true>(lds + RING_OFF, g, S, E, tid);
        } else if (ph == 3) {
            pg8::Gemm g{(const pg8::bf16_t*)(args.ws + WS_XN), (const pg8::bf16_t*)(args.ws + WS_WOUT + layer * WOUT_BYTES), MH, D, D};
            pg8::StaticOrder S; S.init(MH, D, G, bid);
            pg8::EpiF32 E{(float*)(args.ws + WS_PROJ), D};
            pg8::gemm_phase<pg8::EpiF32, pg8::StaticOrder, true, true>(lds + RING_OFF, g, S, E, tid);
        } else {
            p5_norm_residual(args, half, layer, gw, NGW, lane);
            if (half == 0 && layer == 1) xn_from_input(args, 1, gw, NGW, lane);
        }
    }
}
typedef const __attribute__((address_space(4))) Args* KArgsPtr;
#if defined(__HIP_DEVICE_COMPILE__)
#define LOAD_ARGS(a) KArgsPtr a##_p = (KArgsPtr)__builtin_amdgcn_kernarg_segment_ptr(); asm volatile("" : "+s"(a##_p)); Args a; \
    _Pragma("unroll") for (int _i = 0; _i < 10; ++_i) a.in[_i] = a##_p->in[_i]; a.out = a##_p->out; a.ws = a##_p->ws; a.ph_lo = a##_p->ph_lo; a.ph_hi = a##_p->ph_hi
#else
#define LOAD_ARGS(a) const Args a = args
#endif

__global__ void __launch_bounds__(NTHR, 2) fwd_kernel(Args args) {
    extern __shared__ __attribute__((aligned(16))) unsigned char lds_raw[];
    LAS unsigned char* lds = (LAS unsigned char*)lds_raw;
    for (int u = threadIdx.x; u < (LDS_BYTES - LDSCTL_OFF) / 4; u += NTHR) ((LAS unsigned*)(lds + LDSCTL_OFF))[u] = 0u;
    __syncthreads();
    const int lo = args.ph_lo, hi = args.ph_hi;
#if MK_PER_STEP
    run_step(args, lo, lds, (int)threadIdx.x, (int)blockIdx.x, (int)gridDim.x);
#else
    (void)xcd_barrier_post((unsigned*)((gu32*)(args.ws + WS_CTL) + CW_BAR), (volatile LAS unsigned*)(lds + MISC_OFF) + 8);
#define GRID_BARRIER() do { LOAD_ARGS(b); XcdBarrier bar; bar.bar = (unsigned*)((gu32*)(b.ws + WS_CTL) + CW_BAR); bar.x = xb_xcc_id(); bar.st = (volatile LAS unsigned*)(lds + MISC_OFF) + 8; xcd_barrier(bar); } while (0)
    int s0 = lo;
    const int wave_s = __builtin_amdgcn_readfirstlane((int)threadIdx.x >> 6);
    if (s0 == 0) {
        { LOAD_ARGS(a); run_step(a, 0, lds, (int)threadIdx.x, (int)blockIdx.x, (int)gridDim.x); }
        if (hi > 1) GRID_BARRIER();
        s0 = 1;
    }
    for (int s = s0; s < hi; ++s) {
        LAS unsigned char* ldsq = lds; asm volatile("" : "+s"(ldsq));
        int bid = blockIdx.x, gsz = gridDim.x; asm volatile("" : "+s"(bid), "+s"(gsz));
        int tid; asm volatile("v_mbcnt_lo_u32_b32 %0, -1, 0\n\tv_mbcnt_hi_u32_b32 %0, -1, %0\n\tv_lshl_add_u32 %0, %1, 6, %0" : "=&v"(tid) : "s"(wave_s));
        int sq = s; asm volatile("" : "+s"(sq));
        if (sq == 0) continue;
        { LOAD_ARGS(a); run_step(a, sq, ldsq, tid, bid, gsz); }
        if (s + 1 < hi) GRID_BARRIER();
    }
#endif
}

extern "C" void kernel_launch(void* const* d_in, const int* in_sizes, int n_in, void* d_out, int out_size, void* d_ws, size_t ws_size, hipStream_t stream) {
    static int grid = 0;
    if (grid == 0) {
        if (n_in != 10 || in_sizes[0] != BATCH * SEQ * D || out_size != BATCH * SEQ * D || ws_size < WS_END) { fprintf(stderr, "kernel_launch: unexpected shapes (n_in %d in0 %d out %d ws %zu)\n", n_in, n_in > 0 ? in_sizes[0] : -1, out_size, ws_size); grid = -1; return; }
        int dev = 0, cus = 0;
        if (hipGetDevice(&dev) != hipSuccess || hipDeviceGetAttribute(&cus, hipDeviceAttributeMultiprocessorCount, dev) != hipSuccess) { grid = -1; return; }
        if (hipFuncSetAttribute((const void*)fwd_kernel, hipFuncAttributeMaxDynamicSharedMemorySize, LDS_BYTES) != hipSuccess) { fprintf(stderr, "kernel_launch: hipFuncSetAttribute failed\n"); grid = -1; return; }
        (void)hipGetLastError();
        grid = cus;
    }
    if (grid < 0) return;
    if (hipMemsetAsync((char*)d_ws + WS_CTL, 0, CTL_ZERO_BYTES, stream) != hipSuccess) return;
    Args a{};
    for (int i = 0; i < 10; ++i) a.in[i] = (const float*)d_in[i];
    a.out = (float*)d_out; a.ws = (unsigned char*)d_ws;
#if MK_PER_STEP
    for (int s = 0; s < NSTEPS; ++s) { a.ph_lo = s; a.ph_hi = s + 1; hipLaunchKernelGGL(fwd_kernel, dim3(grid), dim3(NTHR), LDS_BYTES, stream, a); }
#else
    a.ph_lo = 0; a.ph_hi = NSTEPS; hipLaunchKernelGGL(fwd_kernel, dim3(grid), dim3(NTHR), LDS_BYTES, stream, a);
#endif
}
```

```cpp
#include <hip/hip_runtime.h>
#include <cstdio>
#include <cstdint>
#include <cmath>
namespace pg8 {
#define PG8_LAS __attribute__((address_space(3)))
typedef unsigned short bf16_t;
typedef short bf16x8 __attribute__((ext_vector_type(8)));
typedef float f32x4 __attribute__((ext_vector_type(4)));
typedef unsigned u32x4 __attribute__((ext_vector_type(4)));
constexpr int BM = 256, BK = 64, HALF = 128, HTB = HALF * BK * 2  , STAGE_BYTES = 8 * HTB, NXCD = 8, WGM = 8;

__host__ __device__ __forceinline__ int lds_byte(int r, int c) { const int st = (r >> 4) * 2 + (c >> 5), rr = r & 15, cc = c & 31, ob = rr * 64 + cc * 2; return st * 1024 + (ob ^ (((ob >> 9) & 1) << 5)); }
__host__ __device__ __forceinline__ void stage_rc(int b, int& R, int& C) { const int st = b / 1024, sb = b % 1024, swz = sb ^ (((sb >> 9) & 1) << 5); R = (st >> 1) * 16 + swz / 64; C = (st & 1) * 32 + (swz % 64) / 2; }
__host__ __device__ __forceinline__ int perm32(int rho) { const int n = rho >> 4, i = rho & 15; return 8 * (i >> 2) + 4 * n + (i & 3); }

struct Unit { int pm, pn; };
struct Gemm { const bf16_t* A; const bf16_t* Bt; int M, N, K; };

struct StaticOrder {
    int nM, nN, nwg, G, c;
    __host__ __device__ void init(int M, int N, int G_, int c_) { nM = M / BM; nN = N / BM; nwg = nM * nN; G = G_; c = c_; }
    __host__ __device__ bool next(int i, Unit& u) const {
        const long L = (long)i * G + c; if (L >= nwg) return false;
        int wgid = (int)L; { const int q = nwg / NXCD, r = nwg % NXCD, xcd = wgid % NXCD, off = wgid / NXCD; wgid = (xcd < r ? xcd * (q + 1) : r * (q + 1) + (xcd - r) * q) + off; }
        const int nig = WGM * nN, gid = wgid / nig, fm = gid * WGM, gsz = (nM - fm) < WGM ? (nM - fm) : WGM;
        u.pm = fm + ((wgid % nig) % gsz); u.pn = (wgid % nig) / gsz; return true;
    }
    __device__ __forceinline__ void a_ready(const Unit&) const {}
    __device__ __forceinline__ void done(const Unit&) const {}
};


typedef __bf16 bf16x2n __attribute__((ext_vector_type(2))); typedef float f32x2n __attribute__((ext_vector_type(2)));
__device__ __forceinline__ unsigned cvt_pk_bf16(float lo, float hi) { const f32x2n v = {lo, hi}; return __builtin_bit_cast(unsigned, __builtin_convertvector(v, bf16x2n)); }
__device__ __forceinline__ float bflo(unsigned w) { return __uint_as_float(w << 16); }
__device__ __forceinline__ float bfhi(unsigned w) { return __uint_as_float(w & 0xffff0000u); }

struct EpiF32 {
    static constexpr bool PERM = false, AFTER_DRAIN = false, MID = false;
    float* C; int ldc;
    __device__ __forceinline__ void operator()(const f32x4 (&acc)[2][2][4][2], const Unit& u, int wr, int wc, int fr, int fq) const {
        const int row0 = u.pm * BM + wr * 64 + fr, col0 = u.pn * BM + wc * 32 + 4 * fq;
#pragma unroll
        for (int ai = 0; ai < 2; ++ai)
#pragma unroll
            for (int m = 0; m < 4; ++m) { float* rowp = C + (size_t)(row0 + ai * HALF + m * 16) * ldc + col0;
#pragma unroll
                for (int bj = 0; bj < 2; ++bj)
#pragma unroll
                    for (int n = 0; n < 2; ++n) *(f32x4*)(rowp + bj * HALF + n * 16) = acc[ai][bj][m][n]; }
    }
};
struct EpiBf16 {
    static constexpr bool PERM = true, AFTER_DRAIN = false, MID = false;
    bf16_t* O; int ldc;
    __device__ __forceinline__ void operator()(const f32x4 (&acc)[2][2][4][2], const Unit& u, int wr, int wc, int fr, int fq) const {
        const int row0 = u.pm * BM + wr * 64 + fr; const int col0 = u.pn * BM + wc * 32 + 8 * fq;
#pragma unroll
        for (int ai = 0; ai < 2; ++ai)
#pragma unroll
            for (int m = 0; m < 4; ++m) { bf16_t* rowp = O + (size_t)(row0 + ai * HALF + m * 16) * ldc + col0;
#pragma unroll
                for (int bj = 0; bj < 2; ++bj) { const f32x4 v0 = acc[ai][bj][m][0], v1 = acc[ai][bj][m][1];
                    u32x4 w; w.x = cvt_pk_bf16(v0[0], v0[1]); w.y = cvt_pk_bf16(v0[2], v0[3]); w.z = cvt_pk_bf16(v1[0], v1[1]); w.w = cvt_pk_bf16(v1[2], v1[3]);
                    *(u32x4*)(rowp + bj * HALF) = w; } }
    }
};
struct EpiGate {
    static constexpr bool PERM = true, AFTER_DRAIN = false, MID = true;
    static constexpr int LDG = 8448;
    bf16_t* O; int ldc; const bf16_t* G;
    __device__ __forceinline__ void scale(f32x4 (&acc)[2][2][4][2], const Unit& u, int which, int wr, int wc, int fr, int fq) const {
        unsigned off0 = ((unsigned)(u.pm * BM + wr * 64 + fr) * (unsigned)LDG + (unsigned)(u.pn * BM + wc * 32 + 8 * fq)) * 2u;
        asm volatile("" : "+v"(off0));
        const char* gb = (const char*)G + (size_t)((which == 3 ? 2 : which - 1) * 1024) * 2;
#pragma unroll
        for (int ai = 0; ai < 2; ++ai)
#pragma unroll
            for (int m = 0; m < 4; ++m) {
#pragma unroll
                for (int bj = 0; bj < 2; ++bj) {
                    const unsigned off = off0 + (unsigned)((ai * HALF + m * 16) * LDG * 2 + bj * HALF * 2);
                    const u32x4 wa = *(const u32x4*)(gb + off);
                    const u32x4 wb = *(const u32x4*)(gb + off + 2048);
                    float a[8] = {bflo(wa.x), bfhi(wa.x), bflo(wa.y), bfhi(wa.y), bflo(wa.z), bfhi(wa.z), bflo(wa.w), bfhi(wa.w)};
                    float b[8] = {bflo(wb.x), bfhi(wb.x), bflo(wb.y), bfhi(wb.y), bflo(wb.z), bfhi(wb.z), bflo(wb.w), bfhi(wb.w)};
                    float f[8];
#pragma unroll
                    for (int e = 0; e < 8; ++e) {
                        const float ea = __expf(-a[e]);
                        if (which == 3) f[e] = __builtin_amdgcn_rcpf(1.0f + ea);
                        else { const float eb = __expf(-b[e]); f[e] = (1.0f + eb) * __builtin_amdgcn_rcpf(1.0f + ea); }
                    }
                    f32x4 v0 = acc[ai][bj][m][0], v1 = acc[ai][bj][m][1];
                    v0[0] *= f[0]; v0[1] *= f[1]; v0[2] *= f[2]; v0[3] *= f[3]; v1[0] *= f[4]; v1[1] *= f[5]; v1[2] *= f[6]; v1[3] *= f[7];
                    acc[ai][bj][m][0] = v0; acc[ai][bj][m][1] = v1; }
                asm volatile("" ::: "memory"); }
    }
    __device__ __forceinline__ void mid(f32x4 (&acc)[2][2][4][2], const Unit& u, int which, int wr, int wc, int fr, int fq) const { scale(acc, u, which, wr, wc, fr, fq); }
    __device__ __forceinline__ void operator()(f32x4 (&acc)[2][2][4][2], const Unit& u, int wr, int wc, int fr, int fq) const {
        scale(acc, u, 3, wr, wc, fr, fq);
        const int row0 = u.pm * BM + wr * 64 + fr; const int col0 = u.pn * BM + wc * 32 + 8 * fq;
#pragma unroll
        for (int ai = 0; ai < 2; ++ai)
#pragma unroll
            for (int m = 0; m < 4; ++m) { bf16_t* rowp = O + (size_t)(row0 + ai * HALF + m * 16) * ldc + col0;
#pragma unroll
                for (int bj = 0; bj < 2; ++bj) { const f32x4 v0 = acc[ai][bj][m][0], v1 = acc[ai][bj][m][1];
                    u32x4 w; w.x = cvt_pk_bf16(v0[0], v0[1]); w.y = cvt_pk_bf16(v0[2], v0[3]); w.z = cvt_pk_bf16(v1[0], v1[1]); w.w = cvt_pk_bf16(v1[2], v1[3]);
                    *(u32x4*)(rowp + bj * HALF) = w; } }
    }
};
template <class Epi, class Sched, bool ALIGN_EPI = false, bool SP2 = false>
__device__ __forceinline__ void gemm_phase(PG8_LAS unsigned char* lds, const Gemm g, const Sched& S, const Epi& E, const int tid) {
    const int wid = __builtin_amdgcn_readfirstlane(tid >> 6), lane = tid & 63, wr = wid >> 2, wc = wid & 3, fr = lane & 15, fq = lane >> 4;
    const int K = g.K, nt = K / BK;
    unsigned voffA[2], voffB[2];
#pragma unroll
    for (int i = 0; i < 2; ++i) { int R, C; stage_rc(tid * 16 + i * 8192, R, C); const int Rb = Epi::PERM ? ((R & ~31) + perm32(R & 31)) : R;
        voffA[i] = (unsigned)(R * K + C) * 2u; voffB[i] = (unsigned)(Rb * K + C) * 2u; }
    const size_t kstep = (size_t)(BK * 2);
    const size_t hstep = (size_t)HALF * K * 2;
    const size_t tstep = 2 * hstep;
    const unsigned ldsw = (unsigned)wid * 1024u;
    const int aoff = lds_byte(wr * 64 + fr, fq * 8), boff = lds_byte(wc * 32 + fr, fq * 8);
#define PG8_SA(b, h) (((b) * 2 + (h)) * HTB)
#define PG8_SB(b, h) ((4 + (b) * 2 + (h)) * HTB)
#define PG8_STAGE(bufoff, gbase, voff) do { _Pragma("unroll") for (int _i = 0; _i < 2; ++_i) \
        __builtin_amdgcn_global_load_lds((const unsigned*)((const char*)(gbase) + (voff)[_i]), (PG8_LAS unsigned*)(lds + (bufoff) + ldsw + _i * 8192), 16, 0, 0); } while (0)
#define PG8_LDA(dst, b, h) do { _Pragma("unroll") for (int m = 0; m < 4; ++m) _Pragma("unroll") for (int k = 0; k < 2; ++k) dst[m][k] = *(const PG8_LAS bf16x8*)(lds + PG8_SA(b, h) + aoff + m * 2048 + k * 1024); } while (0)
#define PG8_LDB(dst, b, h) do { _Pragma("unroll") for (int n = 0; n < 2; ++n) _Pragma("unroll") for (int k = 0; k < 2; ++k) dst[n][k] = *(const PG8_LAS bf16x8*)(lds + PG8_SB(b, h) + boff + n * 2048 + k * 1024); } while (0)
#define PG8_MMA(ai, bj, At, Bt) do { __builtin_amdgcn_s_setprio(1); _Pragma("unroll") for (int m = 0; m < 4; ++m) _Pragma("unroll") for (int n = 0; n < 2; ++n) _Pragma("unroll") for (int k = 0; k < 2; ++k) \
        acc[ai][bj][m][n] = __builtin_amdgcn_mfma_f32_16x16x32_bf16(Bt[n][k], At[m][k], acc[ai][bj][m][n], 0, 0, 0); __builtin_amdgcn_s_setprio(0); } while (0)
#define PG8_WAIT_V(n) asm volatile("s_waitcnt vmcnt(" #n ")" ::: "memory")
#define PG8_WAIT_L(n) asm volatile("s_waitcnt lgkmcnt(" #n ")" ::: "memory")
#define PG8_BAR __builtin_amdgcn_s_barrier()
#define PG8_SCHED __builtin_amdgcn_sched_barrier(0)
    Unit cur, nxt; int ui = 0;
    if (!S.next(0, cur)) return;
    f32x4 acc[2][2][4][2];
#pragma unroll
    for (int a = 0; a < 2; ++a)
#pragma unroll
        for (int b = 0; b < 2; ++b)
#pragma unroll
            for (int m = 0; m < 4; ++m)
#pragma unroll
                for (int n = 0; n < 2; ++n) acc[a][b][m][n] = (f32x4){0.f, 0.f, 0.f, 0.f};
    bf16x8 At[4][2], B0[2][2], B1[2][2];
    const char* cA = (const char*)g.A + (size_t)cur.pm * tstep; const char* cB = (const char*)g.Bt + (size_t)cur.pn * tstep;
    S.a_ready(cur);
    if constexpr (SP2) {
        PG8_STAGE(PG8_SB(0, 0), cB, voffB); PG8_STAGE(PG8_SB(0, 1), cB + hstep, voffB); PG8_STAGE(PG8_SA(0, 0), cA, voffA); PG8_STAGE(PG8_SA(0, 1), cA + hstep, voffA);
        if (wr == 1) PG8_BAR;
        PG8_WAIT_V(2); PG8_BAR;
        PG8_STAGE(PG8_SB(1, 0), cB + kstep, voffB); PG8_STAGE(PG8_SA(1, 0), cA + kstep, voffA); PG8_STAGE(PG8_SB(1, 1), cB + hstep + kstep, voffB);
        PG8_WAIT_V(6); PG8_BAR;
    } else {
        PG8_STAGE(PG8_SB(0, 0), cB, voffB); PG8_STAGE(PG8_SA(0, 0), cA, voffA); PG8_STAGE(PG8_SB(0, 1), cB + hstep, voffB); PG8_STAGE(PG8_SA(0, 1), cA + hstep, voffA);
        if (wr == 1) PG8_BAR;
        PG8_WAIT_V(4); PG8_BAR;
        PG8_STAGE(PG8_SB(1, 0), cB + kstep, voffB); PG8_STAGE(PG8_SA(1, 0), cA + kstep, voffA); PG8_STAGE(PG8_SB(1, 1), cB + hstep + kstep, voffB);
        PG8_WAIT_V(6); PG8_BAR;
    }
    for (;;) {
        const bool has_next = S.next(ui + 1, nxt);
        const char* nA = has_next ? (const char*)g.A + (size_t)nxt.pm * tstep : cA; const char* nB = has_next ? (const char*)g.Bt + (size_t)nxt.pn * tstep : cB;
        const int seg = Epi::MID ? 8 : nt;
        for (int t0 = 0; t0 < nt; t0 += seg) {
        for (int t = t0; t < t0 + seg; t += 2) {
            const bool last = (t == nt - 2);
            const char* a1 = cA + (size_t)(t + 1) * kstep;
            const char* a2 = last ? nA : cA + (size_t)(t + 2) * kstep; const char* b2 = last ? nB : cB + (size_t)(t + 2) * kstep;
            const char* a3 = a2 + kstep; const char* b3 = b2 + kstep;
            if (last && has_next) S.a_ready(nxt);
            if constexpr (SP2) {
            PG8_LDB(B0, 0, 0); PG8_LDB(B1, 0, 1); PG8_SCHED; PG8_LDA(At, 0, 0); PG8_STAGE(PG8_SA(1, 1), a1 + hstep, voffA);
            PG8_WAIT_V(8); PG8_WAIT_L(0); PG8_BAR; PG8_MMA(0, 0, At, B0); PG8_MMA(0, 1, At, B1); PG8_BAR; PG8_SCHED;
            PG8_LDA(At, 0, 1); PG8_STAGE(PG8_SB(0, 0), b2, voffB); PG8_STAGE(PG8_SB(0, 1), b2 + hstep, voffB); PG8_STAGE(PG8_SA(0, 0), a2, voffA);
            PG8_WAIT_V(8); PG8_WAIT_L(0); PG8_BAR; PG8_MMA(1, 0, At, B0); PG8_MMA(1, 1, At, B1); PG8_BAR; PG8_SCHED;
            PG8_LDB(B0, 1, 0); PG8_LDB(B1, 1, 1); PG8_SCHED; PG8_LDA(At, 1, 0); PG8_STAGE(PG8_SA(0, 1), a2 + hstep, voffA);
            PG8_WAIT_V(8); PG8_WAIT_L(0); PG8_BAR; PG8_MMA(0, 0, At, B0); PG8_MMA(0, 1, At, B1); PG8_BAR; PG8_SCHED;
            PG8_LDA(At, 1, 1); PG8_STAGE(PG8_SB(1, 0), b3, voffB); PG8_STAGE(PG8_SB(1, 1), b3 + hstep, voffB); PG8_STAGE(PG8_SA(1, 0), a3, voffA);
            PG8_WAIT_V(8); PG8_WAIT_L(0); PG8_BAR; PG8_MMA(1, 0, At, B0); PG8_MMA(1, 1, At, B1); PG8_BAR; PG8_SCHED;
            } else {
            PG8_LDB(B0, 0, 0); PG8_SCHED; PG8_LDA(At, 0, 0); PG8_STAGE(PG8_SA(1, 1), a1 + hstep, voffA);
            PG8_WAIT_L(8); PG8_BAR; PG8_WAIT_L(0); PG8_MMA(0, 0, At, B0); PG8_BAR; PG8_SCHED;
            PG8_LDB(B1, 0, 1); PG8_STAGE(PG8_SB(0, 0), b2, voffB);
            PG8_BAR; PG8_WAIT_L(0); PG8_MMA(0, 1, At, B1); PG8_BAR;
            PG8_LDA(At, 0, 1); PG8_STAGE(PG8_SA(0, 0), a2, voffA);
            PG8_BAR; PG8_WAIT_L(0); PG8_MMA(1, 0, At, B0); PG8_BAR; PG8_SCHED;
            PG8_STAGE(PG8_SB(0, 1), b2 + hstep, voffB);
            PG8_WAIT_V(6); PG8_BAR; PG8_MMA(1, 1, At, B1); PG8_BAR;
            PG8_LDB(B0, 1, 0); PG8_SCHED; PG8_LDA(At, 1, 0); PG8_STAGE(PG8_SA(0, 1), a2 + hstep, voffA);
            PG8_WAIT_L(8); PG8_BAR; PG8_WAIT_L(0); PG8_MMA(0, 0, At, B0); PG8_BAR; PG8_SCHED;
            PG8_LDB(B1, 1, 1); PG8_STAGE(PG8_SB(1, 0), b3, voffB);
            PG8_BAR; PG8_WAIT_L(0); PG8_MMA(0, 1, At, B1); PG8_BAR;
            PG8_LDA(At, 1, 1); PG8_STAGE(PG8_SA(1, 0), a3, voffA);
            PG8_BAR; PG8_WAIT_L(0); PG8_MMA(1, 0, At, B0); PG8_BAR; PG8_SCHED;
            PG8_STAGE(PG8_SB(1, 1), b3 + hstep, voffB);
            PG8_WAIT_V(6); PG8_BAR; PG8_MMA(1, 1, At, B1); PG8_BAR;
            }
        }
        if constexpr (Epi::MID) { if (t0 + seg < nt) E.mid(acc, cur, t0 / seg + 1, wr, wc, fr, fq); }
        }
        if constexpr (ALIGN_EPI) { if (wr == 0) PG8_BAR; }
        if constexpr (!Epi::AFTER_DRAIN) { E(acc, cur, wr, wc, fr, fq); S.done(cur); }
        if (!has_next) break;
#pragma unroll
        for (int a = 0; a < 2; ++a)
#pragma unroll
            for (int b = 0; b < 2; ++b)
#pragma unroll
                for (int m = 0; m < 4; ++m)
#pragma unroll
                    for (int n = 0; n < 2; ++n) acc[a][b][m][n] = (f32x4){0.f, 0.f, 0.f, 0.f};
        cur = nxt; cA = nA; cB = nB; ++ui;
        if constexpr (ALIGN_EPI) { if (wr == 1) PG8_BAR; }
    }
    PG8_WAIT_V(0);
    if constexpr (!ALIGN_EPI) { if (wr == 0) PG8_BAR; }
    PG8_BAR;
    if constexpr (Epi::AFTER_DRAIN) { E.fused(acc, cur, wr, wc, fr, fq, lds, wid, lane); S.done(cur); }
#undef PG8_SA
#undef PG8_SB
#undef PG8_STAGE
#undef PG8_LDA
#undef PG8_LDB
#undef PG8_MMA
#undef PG8_WAIT_V
#undef PG8_WAIT_L
#undef PG8_BAR
#undef PG8_SCHED
}
}

constexpr int NWAVES = 8, NTHR = 512;
constexpr int D = 1024, BATCH = 16, SEQ = 2048, BLK = 128, NMETA = 16, PADF = 112, LP = 2176, NCH = 17;
constexpr int PW = 8448;
constexpr int HB = 8, MH = HB * LP;
constexpr int C_AQ = 0, C_AK = 512, C_AV = 640, C_AG = 768, C_RQ = 1280, C_RK = 1792, C_RV = 2304, C_RG = 2816, C_CB = 3328, C_CC = 3840, C_CX = 4352, C_CG = 4864, C_MG = 5376;
constexpr int BRW = 1536;
constexpr float RMS_EPS = 1e-6f, GN_EPS = 1e-6f;
constexpr int NPH = 6, NSTEPS = 1 + 4 * NPH;

constexpr size_t MiB = 1u << 20;
constexpr size_t WS_CTL = 0, CTL_ZERO_BYTES = 1 * MiB;
constexpr size_t WS_WIN = 1 * MiB, WIN_BYTES = (size_t)PW * D * 2;
constexpr size_t WS_WBR = 34 * MiB, WBR_BYTES = (size_t)D * BRW * 2;
constexpr size_t WS_WOUT = 40 * MiB, WOUT_BYTES = (size_t)D * D * 2;
constexpr size_t WS_ROT = 44 * MiB;
constexpr size_t WS_XN = 46 * MiB;
constexpr size_t WS_BR = 80 * MiB;
constexpr size_t WS_H = 131 * MiB;
constexpr size_t WS_PROJ = 199 * MiB;
constexpr size_t WS_KV = 480 * MiB;
constexpr size_t WS_END = 498 * MiB;
static_assert(WS_WIN + 2 * WIN_BYTES <= WS_WBR && WS_WBR + 2 * WBR_BYTES <= WS_WOUT && WS_WOUT + 2 * WOUT_BYTES <= WS_ROT && WS_ROT + (size_t)LP * 64 * 8 <= WS_XN, "ws map 1");
static_assert(WS_XN + (size_t)MH * D * 2 <= WS_BR && WS_BR + (size_t)MH * BRW * 2 <= WS_H && WS_H + (size_t)MH * D * 4 <= WS_PROJ && WS_PROJ + (size_t)MH * PW * 2 <= WS_KV && WS_KV + (size_t)HB * 4 * NCH * 128 * 128 * 2 <= WS_END, "ws map 2");
constexpr int CW_TMO = 0, CW_CODE = 1, CW_BAR = 4096;

constexpr int RING_OFF = 0, RING_BYTES = 131072;
constexpr int LDS_BYTES = 147456;
constexpr int LDSCTL_OFF = LDS_BYTES - 1024, MISC_OFF = LDSCTL_OFF + 320;

#define GAS __attribute__((address_space(1)))
#define LAS __attribute__((address_space(3)))
typedef unsigned short bf16;
typedef unsigned v4u __attribute__((ext_vector_type(4)));
typedef unsigned v2u __attribute__((ext_vector_type(2)));
typedef float f32x4 __attribute__((ext_vector_type(4)));
typedef GAS unsigned gu32;
#define RLX_AGENT __ATOMIC_RELAXED, __HIP_MEMORY_SCOPE_AGENT
#define LDS_WAIT() asm volatile("s_waitcnt lgkmcnt(0)" ::: "memory")
#define VM_WAIT() asm volatile("s_waitcnt vmcnt(0)" ::: "memory")
__device__ __forceinline__ unsigned f2bf(float f) { unsigned u = __builtin_bit_cast(unsigned, f); return (u + 0x7fffu + ((u >> 16) & 1u)) >> 16; }
__device__ __forceinline__ unsigned pk2(float lo, float hi) { return f2bf(lo) | (f2bf(hi) << 16); }
__device__ __forceinline__ float bf2f(bf16 h) { return __uint_as_float((unsigned)h << 16); }
__device__ __forceinline__ float bflo(unsigned w) { return __uint_as_float(w << 16); }
__device__ __forceinline__ float bfhi(unsigned w) { return __uint_as_float(w & 0xffff0000u); }
__device__ __forceinline__ v4u zero4() { unsigned z = 0u; asm volatile("" : "+v"(z)); return (v4u){z, z, z, z}; }
__device__ __forceinline__ float silu(float g) { return g / (1.0f + __expf(-g)); }
__device__ __forceinline__ float wave_sum(float v) {
#pragma unroll
    for (int o = 1; o < 64; o <<= 1) v += __shfl_xor(v, o);
    return v;
}
__device__ __forceinline__ float wave_max(float v) {
#pragma unroll
    for (int o = 1; o < 64; o <<= 1) v = fmaxf(v, __shfl_xor(v, o));
    return v;
}
__device__ __forceinline__ int t5_bucket(int n) {
    return n < 16 ? n : 16 + (n >= 19) + (n >= 21) + (n >= 24) + (n >= 27) + (n >= 31) + (n >= 35) + (n >= 40) + (n >= 46) + (n >= 52) + (n >= 59) + (n >= 67) + (n >= 77) + (n >= 87) + (n >= 99) + (n >= 113);
}

#define XB_TMO      128
#define XB_XCNT(j)  (256  + 64 * (j))
#define XB_XSUB(j)  (1280 + 64 * (j))
#define XB_XGEN(j)  (2304 + 64 * (j))
#define XB_TOP      3328
#define XB_TOPGEN   3392
#define XCD_BAR_WORDS 3456
#define XB_SPIN_CAP (1u << 18)

__device__ __forceinline__ unsigned xb_ld(unsigned* p)              { return __hip_atomic_load(p, __ATOMIC_RELAXED, __HIP_MEMORY_SCOPE_AGENT); }
__device__ __forceinline__ unsigned xb_add(unsigned* p, unsigned v) { return __hip_atomic_fetch_add(p, v, __ATOMIC_RELAXED, __HIP_MEMORY_SCOPE_AGENT); }
__device__ __forceinline__ unsigned xb_xcc_id() { return (unsigned)__builtin_amdgcn_s_getreg((3 << 11) | 20) & 0xFu; }
#define XB_SPIN(cond, bar) do { unsigned _sp = 0; while (cond) { __builtin_amdgcn_s_sleep(1); \
    if ((++_sp & 255u) == 0u) { if (xb_ld(&(bar)[XB_TMO])) break; if (_sp > XB_SPIN_CAP) { atomicAdd(&(bar)[XB_TMO], 1u); break; } } } } while (0)

struct XcdBarrier {
    unsigned* bar; unsigned x;
    volatile LAS unsigned* st;
};

__device__ __forceinline__ XcdBarrier xcd_barrier_post(unsigned* bar, volatile LAS unsigned* st) {
    XcdBarrier b; b.bar = bar; b.x = xb_xcc_id(); b.st = st;
    if (threadIdx.x == 0) (void)xb_add(&bar[XB_XCNT(b.x)], 1u);
    return b;
}
__device__ __forceinline__ void xcd_barrier_complete(unsigned* bar, unsigned x, unsigned& nloc, unsigned& nx) {
    const unsigned G = gridDim.x * gridDim.y * gridDim.z;
    unsigned sum, cnt, mine, sp = 0u;
    for (;;) {
        sum = 0u; cnt = 0u; mine = 0u;
#pragma unroll
        for (unsigned j = 0; j < 16; ++j) { const unsigned c = xb_ld(&bar[XB_XCNT(j)]); sum += c; cnt += (c > 0u) ? 1u : 0u; mine = (j == x) ? c : mine; }
        if (sum == G) break;
        __builtin_amdgcn_s_sleep(1);
        if ((++sp & 255u) == 0u) { if (xb_ld(&bar[XB_TMO])) break; if (sp > XB_SPIN_CAP) { atomicAdd(&bar[XB_TMO], 1u); break; } }
    }
    nloc = mine > 0u ? mine : 1u; nx = cnt > 0u ? cnt : 1u;
}

__device__ __forceinline__ void xcd_barrier(const XcdBarrier& b) {
    asm volatile("s_waitcnt vmcnt(0)" ::: "memory");
    __syncthreads();
    if (threadIdx.x == 0) {
        unsigned* bar = b.bar;
        __builtin_amdgcn_s_waitcnt(0);
        unsigned nloc = b.st[0], nx = b.st[1];
        if (nloc == 0u) { xcd_barrier_complete(bar, b.x, nloc, nx); b.st[0] = nloc; b.st[1] = nx; }
        const unsigned old = xb_add(&bar[XB_XSUB(b.x)], 1u);
        const unsigned gen = old / nloc;
        if (old + 1u == (gen + 1u) * nloc) {
            __builtin_amdgcn_fence(__ATOMIC_RELEASE, "agent");
            asm volatile("s_waitcnt vmcnt(0)" ::: "memory");
            const unsigned og = xb_add(&bar[XB_TOP], 1u);
            const unsigned tg = og / nx;
            if (og + 1u == (tg + 1u) * nx) xb_add(&bar[XB_TOPGEN], 1u);
            else XB_SPIN(xb_ld(&bar[XB_TOPGEN]) == tg, bar);
            __builtin_amdgcn_fence(__ATOMIC_ACQUIRE, "agent");
            xb_add(&bar[XB_XGEN(b.x)], 1u);
            asm volatile("s_waitcnt vmcnt(0)" ::: "memory");
        } else {
            XB_SPIN(xb_ld(&bar[XB_XGEN(b.x)]) == gen, bar);
            __builtin_amdgcn_fence(__ATOMIC_ACQUIRE, "agent");
            asm volatile("s_waitcnt vmcnt(0)" ::: "memory");
        }
    }
    __syncthreads();
}


struct Args { const float* in[10]; float* out; unsigned char* ws; int ph_lo, ph_hi; };

__device__ __forceinline__ void p0_transpose_item(const float* W, int K, int N, bf16* WT, int ldt, int koff, LAS float* scr, int item, int lane) {
    const int nblk = N / 32, kb = item / nblk, nb = item % nblk, k0 = 64 * kb, n0 = 32 * nb;
#pragma unroll 8
    for (int i = 0; i < 32; ++i) { const int kk = 2 * i + (lane >> 5); scr[kk * 33 + (lane & 31)] = W[(size_t)(k0 + kk) * N + n0 + (lane & 31)]; }
    LDS_WAIT(); asm volatile("" ::: "memory");
    const int c = lane & 7;
#pragma unroll
    for (int j = 0; j < 4; ++j) { const int n = (lane >> 3) + 8 * j; const LAS float* s = scr + (8 * c) * 33 + n;
        v4u o; o.x = pk2(s[0 * 33], s[1 * 33]); o.y = pk2(s[2 * 33], s[3 * 33]); o.z = pk2(s[4 * 33], s[5 * 33]); o.w = pk2(s[6 * 33], s[7 * 33]);
        *(GAS v4u*)(WT + (size_t)(n0 + n) * ldt + koff + k0 + 8 * c) = o; }
    LDS_WAIT(); asm volatile("" ::: "memory");
}

__device__ __forceinline__ void rms_row_to_bf16(const f32x4 (&v)[4], const float* g, bf16* orow, int lane) {
    float s2 = 0.f;
#pragma unroll
    for (int j = 0; j < 4; ++j) s2 += (v[j].x * v[j].x + v[j].y * v[j].y) + (v[j].z * v[j].z + v[j].w * v[j].w);
    const float rstd = 1.0f / sqrtf(wave_sum(s2) * (1.f / D) + RMS_EPS);
    GAS v2u* o8 = (GAS v2u*)orow + lane;
#pragma unroll
    for (int j = 0; j < 4; ++j) { const f32x4 gg = ((const f32x4*)g)[lane + 64 * j]; v2u w; w.x = pk2(v[j].x * rstd * gg.x, v[j].y * rstd * gg.y); w.y = pk2(v[j].z * rstd * gg.z, v[j].w * rstd * gg.w); o8[64 * j] = w; }
}
__device__ __forceinline__ void zero_row_bf16(bf16* orow, int lane) {
    GAS v2u* o8 = (GAS v2u*)orow + lane;
#pragma unroll
    for (int j = 0; j < 4; ++j) o8[64 * j] = (v2u){0u, 0u};
}
__device__ __forceinline__ void xn_from_input(const Args& a, int half, int gw, int NGW, int lane) {
    bf16* XN = (bf16*)(a.ws + WS_XN);
    for (int r = gw; r < MH; r += NGW) {
        const int bl = r / LP, idx = r - bl * LP, b = half * HB + bl;
        bf16* orow = XN + (size_t)r * D;
        if (idx < PADF) { zero_row_bf16(orow, lane); continue; }
        const float* src = idx < BLK ? a.in[1] + (size_t)(idx - PADF) * D : a.in[0] + ((size_t)b * SEQ + (idx - BLK)) * D;
        f32x4 v[4];
#pragma unroll
        for (int j = 0; j < 4; ++j) v[j] = ((const f32x4*)src)[lane + 64 * j];
        rms_row_to_bf16(v, a.in[3], orow, lane);
    }
}

__device__ __forceinline__ void p0_prologue(const Args& a, LAS unsigned char* lds, int tid, int wave, int lane) {
    LAS float* scr = (LAS float*)(lds + RING_OFF + wave * 16384);
    const int gw = blockIdx.x * NWAVES + wave, NGW = gridDim.x * NWAVES;
    constexpr int I_IN = (D / 64) * (PW / 32), I_BR = (512 / 64) * (D / 32), I_OUT = (D / 64) * (D / 32);
    constexpr int PER_LAYER = I_IN + 3 * I_BR + I_OUT, NITEMS = 2 * PER_LAYER;
    for (int it = gw; it < NITEMS; it += NGW) {
        const int l = it / PER_LAYER; int r = it - l * PER_LAYER;
        if (r < I_IN) { p0_transpose_item(a.in[4] + (size_t)l * D * PW, D, PW, (bf16*)(a.ws + WS_WIN + l * WIN_BYTES), D, 0, scr, r, lane); continue; } r -= I_IN;
        if (r < 3 * I_BR) { const int g = r / I_BR; p0_transpose_item(a.in[7] + ((size_t)l * 3 + g) * 512 * D, 512, D, (bf16*)(a.ws + WS_WBR + l * WBR_BYTES), BRW, g * 512, scr, r - g * I_BR, lane); continue; } r -= 3 * I_BR;
        p0_transpose_item(a.in[8] + (size_t)l * D * D, D, D, (bf16*)(a.ws + WS_WOUT + l * WOUT_BYTES), D, 0, scr, r, lane);
    }
    float* rc = (float*)(a.ws + WS_ROT); float* rs = rc + LP * 64;
    for (int e = (blockIdx.x * NTHR + tid); e < LP * 64; e += gridDim.x * NTHR) {
        const int idx = e >> 6, i = e & 63;
        const float lin = (float)i / 63.0f;
        const float theta = (float)(1.0 / pow(10000.0, (double)lin));
        const float ang = (float)(idx - PADF) * theta;
        rc[e] = (float)cos((double)ang); rs[e] = (float)sin((double)ang);
    }
    xn_from_input(a, 0, gw, NGW, lane);
}

__device__ __forceinline__ void p5_norm_residual(const Args& a, int half, int layer, int gw, int NGW, int lane) {
    const float* Y = (const float*)(a.ws + WS_PROJ); float* H = (float*)(a.ws + WS_H); bf16* XN = (bf16*)(a.ws + WS_XN);
    const float* gpost = a.in[9] + layer * D;
    for (int r = gw; r < MH; r += NGW) {
        const int bl = r / LP, idx = r - bl * LP, b = half * HB + bl;
        if (idx < PADF) {
            if (layer == 0) { zero_row_bf16(XN + (size_t)r * D, lane);
#pragma unroll
                for (int j = 0; j < 4; ++j) ((v4u*)(H + (size_t)r * D))[lane + 64 * j] = zero4(); }
            continue;
        }
        if (layer == 1 && idx < BLK) continue;
        f32x4 y[4], h[4]; float s2 = 0.f;
        const float* hsrc = layer == 0 ? (idx < BLK ? a.in[1] + (size_t)(idx - PADF) * D : a.in[0] + ((size_t)b * SEQ + (idx - BLK)) * D) : H + (size_t)r * D;
#pragma unroll
        for (int j = 0; j < 4; ++j) { y[j] = ((const f32x4*)(Y + (size_t)r * D))[lane + 64 * j]; h[j] = ((const f32x4*)hsrc)[lane + 64 * j]; s2 += (y[j].x * y[j].x + y[j].y * y[j].y) + (y[j].z * y[j].z + y[j].w * y[j].w); }
        const float rstd = 1.0f / sqrtf(wave_sum(s2) * (1.f / D) + RMS_EPS);
#pragma unroll
        for (int j = 0; j < 4; ++j) { const f32x4 gg = ((const f32x4*)gpost)[lane + 64 * j];
            h[j].x += y[j].x * rstd * gg.x; h[j].y += y[j].y * rstd * gg.y; h[j].z += y[j].z * rstd * gg.z; h[j].w += y[j].w * rstd * gg.w; }
        if (layer == 0) {
#pragma unroll
            for (int j = 0; j < 4; ++j) ((f32x4*)(H + (size_t)r * D))[lane + 64 * j] = h[j];
            rms_row_to_bf16(h, a.in[3] + D, XN + (size_t)r * D, lane);
        } else {
            float* orow = a.out + ((size_t)b * SEQ + (idx - BLK)) * D;
#pragma unroll
            for (int j = 0; j < 4; ++j) ((f32x4*)orow)[lane + 64 * j] = h[j];
        }
    }
}

__device__ __forceinline__ void attn_simple(const Args& a, int layer, int wave, int lane) {
    const bf16* PROJ = (const bf16*)(a.ws + WS_PROJ); bf16* BR = (bf16*)(a.ws + WS_BR);
    const float* rel_bias = a.in[2]; const float* sinks = a.in[6] + layer * 8;
    const int gw = blockIdx.x * NWAVES + wave, NGW = gridDim.x * NWAVES;
    for (int task = gw; task < MH * 8; task += NGW) {
        const int r = task >> 3, hq = task & 7, hk = hq >> 2;
        const int idx = r % LP;
        bf16* op = BR + (size_t)r * BRW + hq * 64 + lane;
        if (idx < PADF) { *op = 0; continue; }
        const bf16* prow = PROJ + (size_t)r * PW;
        float q[64];
#pragma unroll
        for (int c = 0; c < 8; ++c) { const v4u w = ((const v4u*)(prow + C_AQ + hq * 64))[c];
            q[8 * c + 0] = bflo(w.x); q[8 * c + 1] = bfhi(w.x); q[8 * c + 2] = bflo(w.y); q[8 * c + 3] = bfhi(w.y); q[8 * c + 4] = bflo(w.z); q[8 * c + 5] = bfhi(w.z); q[8 * c + 6] = bflo(w.w); q[8 * c + 7] = bfhi(w.w); }
        float s[2];
#pragma unroll
        for (int t = 0; t < 2; ++t) {
            const int dist = t * 64 + lane; float acc = 0.f;
            if (idx - dist >= PADF) {
                const v4u* kp = (const v4u*)(PROJ + (size_t)(r - dist) * PW + C_AK + hk * 64);
#pragma unroll
                for (int c = 0; c < 8; ++c) { const v4u w = kp[c];
                    acc += q[8 * c + 0] * bflo(w.x) + q[8 * c + 1] * bfhi(w.x) + q[8 * c + 2] * bflo(w.y) + q[8 * c + 3] * bfhi(w.y) + q[8 * c + 4] * bflo(w.z) + q[8 * c + 5] * bfhi(w.z) + q[8 * c + 6] * bflo(w.w) + q[8 * c + 7] * bfhi(w.w); }
                s[t] = acc * 0.125f + rel_bias[t5_bucket(dist) * 8 + hq];
            } else s[t] = -1e30f;
        }
        const float sink = sinks[hq];
        const float m = fmaxf(wave_max(fmaxf(s[0], s[1])), sink);
        const float e0 = __expf(s[0] - m), e1 = __expf(s[1] - m);
        const float denom = wave_sum(e0 + e1) + __expf(sink - m);
        const float p0 = e0 / denom, p1 = e1 / denom;
        float o = 0.f;
        for (int dist = 0; dist < 128; ++dist) {
            const float pj = __shfl(dist < 64 ? p0 : p1, dist & 63);
            if (idx - dist >= PADF) o += pj * bf2f(PROJ[(size_t)(r - dist) * PW + C_AV + hk * 64 + lane]);
        }
        const float g = bf2f(prow[C_AG + hq * 64 + lane]);
        *op = (bf16)f2bf(o * silu(g));
    }
}
__device__ __forceinline__ void conv_simple(const Args& a, int layer, int tid) {
    const bf16* PROJ = (const bf16*)(a.ws + WS_PROJ); bf16* BR = (bf16*)(a.ws + WS_BR);
    const float* cw = a.in[5] + layer * 3 * 512;
    for (int i = blockIdx.x * NTHR + tid; i < MH * 512; i += gridDim.x * NTHR) {
        const int r = i >> 9, c = i & 511, idx = r % LP;
        bf16* op = BR + (size_t)r * BRW + 1024 + c;
        if (idx < PADF) { *op = 0; continue; }
        const bf16* p = PROJ + (size_t)r * PW + c;
        const float u0 = bf2f(p[C_CC]) * bf2f(p[C_CX]);
        const float u1 = idx - 1 >= PADF ? bf2f(p[C_CC - PW]) * bf2f(p[C_CX - PW]) : 0.f;
        const float u2 = idx - 2 >= PADF ? bf2f(p[C_CC - 2 * PW]) * bf2f(p[C_CX - 2 * PW]) : 0.f;
        const float y = cw[2 * 512 + c] * u0 + cw[512 + c] * u1 + cw[c] * u2;
        *op = (bf16)f2bf(bf2f(p[C_CB]) * y * silu(bf2f(p[C_CG])));
    }
}
__device__ __forceinline__ void ret_simple(const Args& a, int unit, LAS unsigned char* lds, int tid, int wave, int lane) {
    const bf16* PROJ = (const bf16*)(a.ws + WS_PROJ); bf16* BR = (bf16*)(a.ws + WS_BR);
    const float* rc = (const float*)(a.ws + WS_ROT); const float* rs = rc + LP * 64;
    LAS float* qs = (LAS float*)lds; LAS float* ks = qs + 128; LAS float* vs = ks + 128; LAS float* red = vs + 128; LAS float* stat = red + 512;
    const int bl = unit >> 2, h = unit & 3, e = tid & 127, dg = tid >> 7;
    const float gamma = 1.0f - exp2f(-5.0f - (float)h);
    float S[32];
#pragma unroll
    for (int i = 0; i < 32; ++i) S[i] = 0.f;
    if (tid < 128) for (int idx = 0; idx < PADF; ++idx) BR[(size_t)(bl * LP + idx) * BRW + 512 + h * 128 + tid] = 0;
    for (int idx = PADF; idx < LP; ++idx) {
        const int r = bl * LP + idx; const bf16* prow = PROJ + (size_t)r * PW;
        if (tid < 384) {
            const int which = tid >> 7, d = tid & 127;
            if (which == 2) vs[d] = bf2f(prow[C_RV + h * 128 + d]);
            else { const int base = (which == 0 ? C_RQ : C_RK) + h * 128, i = d & 63; const float c = rc[idx * 64 + i], s = rs[idx * 64 + i];
                const float t1 = bf2f(prow[base + i]), t2 = bf2f(prow[base + 64 + i]);
                float val = d < 64 ? t1 * c - t2 * s : t1 * s + t2 * c;
                if (which == 1) { val *= 0.08838834764831845f; ks[d] = val; } else qs[d] = val; }
        }
        __syncthreads();
        float part = 0.f; const float ve = vs[e];
#pragma unroll
        for (int i = 0; i < 32; ++i) { S[i] = gamma * S[i] + ks[dg * 32 + i] * ve; part += qs[dg * 32 + i] * S[i]; }
        red[dg * 128 + e] = part;
        __syncthreads();
        float o = 0.f, dv = 0.f;
        if (tid < 128) { o = (red[e] + red[128 + e]) + (red[256 + e] + red[384 + e]); const float ws_ = wave_sum(o); if (lane == 0) stat[wave] = ws_; }
        __syncthreads();
        if (tid < 128) { const float mu = (stat[0] + stat[1]) * (1.f / 128.f); dv = o - mu; const float wq = wave_sum(dv * dv); if (lane == 0) stat[2 + wave] = wq; }
        __syncthreads();
        if (tid < 128) { const float var = (stat[2] + stat[3]) * (1.f / 128.f); const float on = dv / sqrtf(var + GN_EPS);
            BR[(size_t)r * BRW + 512 + h * 128 + e] = (bf16)f2bf(on * silu(bf2f(prow[C_RG + h * 128 + e]))); }
    }
    __syncthreads();
}


typedef float f32x16 __attribute__((ext_vector_type(16)));
typedef short bf16x8 __attribute__((ext_vector_type(8)));
#define MFMA32(a, b, c) __builtin_amdgcn_mfma_f32_32x32x16_bf16((a), (b), (c), 0, 0, 0)
__device__ __forceinline__ unsigned cvtpk(float lo, float hi) { return pg8::cvt_pk_bf16(lo, hi); }
__device__ __forceinline__ bf16x8 pack8(float a0, float a1, float a2, float a3, float a4, float a5, float a6, float a7) {
    v4u w; w.x = cvtpk(a0, a1); w.y = cvtpk(a2, a3); w.z = cvtpk(a4, a5); w.w = cvtpk(a6, a7); return __builtin_bit_cast(bf16x8, w);
}
__device__ __forceinline__ bf16x8 join2(v2u lo, v2u hi) { v4u w; w.x = lo.x; w.y = lo.y; w.z = hi.x; w.w = hi.y; return __builtin_bit_cast(bf16x8, w); }

constexpr int AT_KP = 144, AT_VP = 520;
constexpr int AT_K_OFF = 0, AT_VT_OFF = 256 * AT_KP, AT_BIAS_OFF = AT_VT_OFF + 64 * AT_VP, AT_END = AT_BIAS_OFF + 4 * 128 * 4;
__device__ __forceinline__ void attn_unit(const Args& a, int layer, int unit, LAS unsigned char* lds, int tid) {
    const bf16* PROJ = (const bf16*)(a.ws + WS_PROJ); bf16* BR = (bf16*)(a.ws + WS_BR);
    const int lane = tid & 63, wave = __builtin_amdgcn_readfirstlane(tid >> 6);
    const int bl = unit / (NCH * 2), rem = unit - bl * (NCH * 2), n = rem >> 1, hk = rem & 1;
    const int row_c0 = bl * LP + n * BLK;
#pragma unroll
    for (int k4 = 0; k4 < 4; ++k4) {
        const int it = tid + k4 * NTHR, c = it >> 3, ch = it & 7; v4u v = zero4();
        if (n > 0 || c >= BLK) v = *(const v4u*)(PROJ + (size_t)(row_c0 - BLK + c) * PW + C_AK + hk * 64 + ch * 8);
        *(LAS v4u*)(lds + AT_K_OFF + c * AT_KP + ch * 16) = v;
    }
#pragma unroll
    for (int k2 = 0; k2 < 2; ++k2) {
        const int it = tid + k2 * NTHR, ch = it >> 7, i = it & 127, c0 = 2 * i; v4u v0 = zero4(), v1 = v0;
        if (n > 0 || c0 >= BLK) { const bf16* p = PROJ + (size_t)(row_c0 - BLK + c0) * PW + C_AV + hk * 64 + ch * 8; v0 = *(const v4u*)p; v1 = *(const v4u*)(p + PW); }
        const unsigned e0[4] = {v0.x, v0.y, v0.z, v0.w}, e1[4] = {v1.x, v1.y, v1.z, v1.w};
#pragma unroll
        for (int k = 0; k < 4; ++k) {
            const unsigned lo = (e0[k] & 0xffffu) | (e1[k] << 16), hi = (e0[k] >> 16) | (e1[k] & 0xffff0000u);
            *(LAS unsigned*)(lds + AT_VT_OFF + (ch * 8 + 2 * k) * AT_VP + c0 * 2) = lo;
            *(LAS unsigned*)(lds + AT_VT_OFF + (ch * 8 + 2 * k + 1) * AT_VP + c0 * 2) = hi;
        }
    }
    { const int g = tid >> 7, dist = tid & 127; ((LAS float*)(lds + AT_BIAS_OFF))[tid] = a.in[2][t5_bucket(dist) * 8 + hk * 4 + g]; }
    __syncthreads();
    const int g = wave & 3, qh = wave >> 2, hq = hk * 4 + g, q = lane & 31, h = lane >> 5;
    const float sink = a.in[6][layer * 8 + hq];
    const LAS float* biasd = (const LAS float*)(lds + AT_BIAS_OFF) + g * 128;
    for (int qb2 = 0; qb2 < 2; ++qb2) {
        const int r0 = 64 * qh + 32 * qb2;
        const size_t grow = (size_t)(row_c0 + r0 + q);
        bf16x8 qf[4];
#pragma unroll
        for (int ks = 0; ks < 4; ++ks) qf[ks] = *(const bf16x8*)(PROJ + grow * PW + C_AQ + hq * 64 + 16 * ks + 8 * h);
        f32x16 sc[5];
#pragma unroll
        for (int t = 0; t < 5; ++t) {
            f32x16 acc;
#pragma unroll
            for (int i = 0; i < 16; ++i) acc[i] = 0.f;
#pragma unroll
            for (int ks = 0; ks < 4; ++ks) { const bf16x8 kf = *(const LAS bf16x8*)(lds + AT_K_OFF + (r0 + 32 * t + q) * AT_KP + (16 * ks + 8 * h) * 2); acc = MFMA32(kf, qf[ks], acc); }
            sc[t] = acc;
        }
        float mloc = -1e30f;
#pragma unroll
        for (int t = 0; t < 5; ++t)
#pragma unroll
            for (int reg = 0; reg < 16; ++reg) {
                const int kk = (reg & 3) + 8 * (reg >> 2) + 4 * h, dist = 128 + q - 32 * t - kk, kidx = (n - 1) * BLK + r0 + 32 * t + kk;
                const bool ok = (dist >= 0) && (dist < 128) && (kidx >= PADF);
                const float s = ok ? sc[t][reg] * 0.125f + biasd[dist & 127] : -1e30f;
                sc[t][reg] = s; mloc = fmaxf(mloc, s);
            }
        const float m = fmaxf(fmaxf(mloc, __shfl_xor(mloc, 32)), sink);
        float lloc = 0.f;
#pragma unroll
        for (int t = 0; t < 5; ++t)
#pragma unroll
            for (int reg = 0; reg < 16; ++reg) { const float p = __expf(sc[t][reg] - m); sc[t][reg] = p; lloc += p; }
        const float inv = 1.0f / (lloc + __shfl_xor(lloc, 32) + __expf(sink - m));
        f32x16 o[2];
#pragma unroll
        for (int db = 0; db < 2; ++db)
#pragma unroll
            for (int i = 0; i < 16; ++i) o[db][i] = 0.f;
#pragma unroll
        for (int t = 0; t < 5; ++t)
#pragma unroll
            for (int s2 = 0; s2 < 2; ++s2) {
                const bf16x8 pf = pack8(sc[t][8 * s2 + 0], sc[t][8 * s2 + 1], sc[t][8 * s2 + 2], sc[t][8 * s2 + 3], sc[t][8 * s2 + 4], sc[t][8 * s2 + 5], sc[t][8 * s2 + 6], sc[t][8 * s2 + 7]);
                const int keyb = r0 + 32 * t + 16 * s2 + 4 * h;
#pragma unroll
                for (int db = 0; db < 2; ++db) {
                    const LAS unsigned char* vp = lds + AT_VT_OFF + (32 * db + q) * AT_VP + keyb * 2;
                    const bf16x8 vf = join2(*(const LAS v2u*)vp, *(const LAS v2u*)(vp + 16));
                    o[db] = MFMA32(vf, pf, o[db]);
                }
            }
        const bf16* grp = PROJ + grow * PW + C_AG + hq * 64; bf16* orp = BR + grow * BRW + hq * 64;
#pragma unroll
        for (int db = 0; db < 2; ++db)
#pragma unroll
            for (int g4 = 0; g4 < 4; ++g4) {
                const int d0 = 32 * db + 8 * g4 + 4 * h;
                const v2u gw = *(const v2u*)(grp + d0);
                v2u w; w.x = cvtpk(o[db][4 * g4 + 0] * inv * silu(bflo(gw.x)), o[db][4 * g4 + 1] * inv * silu(bfhi(gw.x)));
                w.y = cvtpk(o[db][4 * g4 + 2] * inv * silu(bflo(gw.y)), o[db][4 * g4 + 3] * inv * silu(bfhi(gw.y)));
                *(v2u*)(orp + d0) = w;
            }
    }
    __syncthreads();
}

constexpr int CV_RUN = 8;
__device__ __forceinline__ void conv_item(const Args& a, int layer, int item, int lane) {
    const bf16* PROJ = (const bf16*)(a.ws + WS_PROJ); bf16* BR = (bf16*)(a.ws + WS_BR);
    const float* cw = a.in[5] + layer * 3 * 512 + lane * 8;
    float w0[8], w1[8], w2[8];
#pragma unroll
    for (int e = 0; e < 8; ++e) { w0[e] = cw[e]; w1[e] = cw[512 + e]; w2[e] = cw[1024 + e]; }
    const int rbeg = item * CV_RUN;
    const int idx0 = rbeg % LP;
    float u1[8], u2[8];
#pragma unroll
    for (int e = 0; e < 8; ++e) { u1[e] = 0.f; u2[e] = 0.f; }
    if (idx0 - 1 >= PADF) {
#pragma unroll
        for (int k = 2; k >= 1; --k) {
            const bf16* p = PROJ + (size_t)(rbeg - k) * PW + lane * 8;
            const v4u c = *(const v4u*)(p + C_CC), x = *(const v4u*)(p + C_CX);
            const unsigned cc[4] = {c.x, c.y, c.z, c.w}, xx[4] = {x.x, x.y, x.z, x.w};
#pragma unroll
            for (int e = 0; e < 4; ++e) { const float ua = bflo(cc[e]) * bflo(xx[e]), ub = bfhi(cc[e]) * bfhi(xx[e]); if (k == 2) { u2[2 * e] = ua; u2[2 * e + 1] = ub; } else { u1[2 * e] = ua; u1[2 * e + 1] = ub; } }
        }
    }
    for (int k = 0; k < CV_RUN; ++k) {
        const int r = rbeg + k, idx = idx0 + k;
        v4u outw = zero4();
        if (idx >= PADF) {
            const bf16* p = PROJ + (size_t)r * PW + lane * 8;
            const v4u c = *(const v4u*)(p + C_CC), x = *(const v4u*)(p + C_CX), b = *(const v4u*)(p + C_CB), gt = *(const v4u*)(p + C_CG);
            const unsigned cc[4] = {c.x, c.y, c.z, c.w}, xx[4] = {x.x, x.y, x.z, x.w}, bb[4] = {b.x, b.y, b.z, b.w}, gg[4] = {gt.x, gt.y, gt.z, gt.w};
            unsigned ow[4];
#pragma unroll
            for (int e = 0; e < 4; ++e) {
                const float ua = bflo(cc[e]) * bflo(xx[e]), ub = bfhi(cc[e]) * bfhi(xx[e]);
                const float ya = w2[2 * e] * ua + w1[2 * e] * u1[2 * e] + w0[2 * e] * u2[2 * e], yb = w2[2 * e + 1] * ub + w1[2 * e + 1] * u1[2 * e + 1] + w0[2 * e + 1] * u2[2 * e + 1];
                u2[2 * e] = u1[2 * e]; u2[2 * e + 1] = u1[2 * e + 1]; u1[2 * e] = ua; u1[2 * e + 1] = ub;
                ow[e] = cvtpk(bflo(bb[e]) * ya * silu(bflo(gg[e])), bfhi(bb[e]) * yb * silu(bfhi(gg[e])));
            }
            outw = (v4u){ow[0], ow[1], ow[2], ow[3]};
        }
        *(v4u*)(BR + (size_t)r * BRW + 1024 + lane * 8) = outw;
    }
}

constexpr int RT_P = 272;
constexpr int RT_KP = 0, RT_VT = 128 * RT_P, RT_KZT = 2 * 128 * RT_P, RT_ST = 2 * 128 * RT_P, RT_STAT = 3 * 128 * RT_P, RT_END = RT_STAT + 2 * 128 * 8;
constexpr int KV_IMG = 128 * 128;

template <bool W_KP, bool W_KZT>
__device__ __forceinline__ void ret_stage_k(const bf16* PROJ, const float* rc, const float* rs, LAS unsigned char* lds, int row0, int n, int hd, float l2g, int wave, int lane) {
    const int c = wave, jp = lane, j0 = 2 * jp;
    const bf16* p = PROJ + (size_t)(row0 + j0) * PW + C_RK + hd * 128 + c * 8;
    const v4u a0 = *(const v4u*)p, a1 = *(const v4u*)(p + 64), b0 = *(const v4u*)(p + PW), b1 = *(const v4u*)(p + PW + 64);
    const int idx0 = n * BLK + j0;
    const f32x4 ca0 = *(const f32x4*)(rc + idx0 * 64 + c * 8), ca1 = *(const f32x4*)(rc + idx0 * 64 + c * 8 + 4), sa0 = *(const f32x4*)(rs + idx0 * 64 + c * 8), sa1 = *(const f32x4*)(rs + idx0 * 64 + c * 8 + 4);
    const f32x4 cb0 = *(const f32x4*)(rc + (idx0 + 1) * 64 + c * 8), cb1 = *(const f32x4*)(rc + (idx0 + 1) * 64 + c * 8 + 4), sb0 = *(const f32x4*)(rs + (idx0 + 1) * 64 + c * 8), sb1 = *(const f32x4*)(rs + (idx0 + 1) * 64 + c * 8 + 4);
    const unsigned A0[4] = {a0.x, a0.y, a0.z, a0.w}, A1[4] = {a1.x, a1.y, a1.z, a1.w}, B0[4] = {b0.x, b0.y, b0.z, b0.w}, B1[4] = {b1.x, b1.y, b1.z, b1.w};
    const float CA[8] = {ca0.x, ca0.y, ca0.z, ca0.w, ca1.x, ca1.y, ca1.z, ca1.w}, SA[8] = {sa0.x, sa0.y, sa0.z, sa0.w, sa1.x, sa1.y, sa1.z, sa1.w};
    const float CB[8] = {cb0.x, cb0.y, cb0.z, cb0.w, cb1.x, cb1.y, cb1.z, cb1.w}, SB[8] = {sb0.x, sb0.y, sb0.z, sb0.w, sb1.x, sb1.y, sb1.z, sb1.w};
    const float ksc = 0.08838834764831845f;
    float ra1[8], ra2[8], rb1[8], rb2[8];
#pragma unroll
    for (int e = 0; e < 8; ++e) {
        const float t1a = (e & 1) ? bfhi(A0[e >> 1]) : bflo(A0[e >> 1]), t2a = (e & 1) ? bfhi(A1[e >> 1]) : bflo(A1[e >> 1]);
        const float t1b = (e & 1) ? bfhi(B0[e >> 1]) : bflo(B0[e >> 1]), t2b = (e & 1) ? bfhi(B1[e >> 1]) : bflo(B1[e >> 1]);
        ra1[e] = (t1a * CA[e] - t2a * SA[e]) * ksc; ra2[e] = (t1a * SA[e] + t2a * CA[e]) * ksc;
        rb1[e] = (t1b * CB[e] - t2b * SB[e]) * ksc; rb2[e] = (t1b * SB[e] + t2b * CB[e]) * ksc;
    }
    if (W_KP) {
        v4u w;
        w.x = cvtpk(ra1[0], ra1[1]); w.y = cvtpk(ra1[2], ra1[3]); w.z = cvtpk(ra1[4], ra1[5]); w.w = cvtpk(ra1[6], ra1[7]); *(LAS v4u*)(lds + RT_KP + j0 * RT_P + (c * 8) * 2) = w;
        w.x = cvtpk(ra2[0], ra2[1]); w.y = cvtpk(ra2[2], ra2[3]); w.z = cvtpk(ra2[4], ra2[5]); w.w = cvtpk(ra2[6], ra2[7]); *(LAS v4u*)(lds + RT_KP + j0 * RT_P + (64 + c * 8) * 2) = w;
        w.x = cvtpk(rb1[0], rb1[1]); w.y = cvtpk(rb1[2], rb1[3]); w.z = cvtpk(rb1[4], rb1[5]); w.w = cvtpk(rb1[6], rb1[7]); *(LAS v4u*)(lds + RT_KP + (j0 + 1) * RT_P + (c * 8) * 2) = w;
        w.x = cvtpk(rb2[0], rb2[1]); w.y = cvtpk(rb2[2], rb2[3]); w.z = cvtpk(rb2[4], rb2[5]); w.w = cvtpk(rb2[6], rb2[7]); *(LAS v4u*)(lds + RT_KP + (j0 + 1) * RT_P + (64 + c * 8) * 2) = w;
    }
    if (W_KZT) {
        const float za = exp2f((float)(127 - j0) * l2g), zb = exp2f((float)(126 - j0) * l2g);
#pragma unroll
        for (int e = 0; e < 8; ++e) {
            *(LAS unsigned*)(lds + RT_KZT + (c * 8 + e) * RT_P + j0 * 2) = cvtpk(ra1[e] * za, rb1[e] * zb);
            *(LAS unsigned*)(lds + RT_KZT + (64 + c * 8 + e) * RT_P + j0 * 2) = cvtpk(ra2[e] * za, rb2[e] * zb);
        }
    }
}
__device__ __forceinline__ void ret_stage_vt(const bf16* PROJ, LAS unsigned char* lds, int row0, int hd, int wave, int lane) {
#pragma unroll
    for (int cc = 0; cc < 2; ++cc) {
        const int c = wave + 8 * cc, j0 = 2 * lane;
        const bf16* p = PROJ + (size_t)(row0 + j0) * PW + C_RV + hd * 128 + c * 8;
        const v4u v0 = *(const v4u*)p, v1 = *(const v4u*)(p + PW);
        const unsigned e0[4] = {v0.x, v0.y, v0.z, v0.w}, e1[4] = {v1.x, v1.y, v1.z, v1.w};
#pragma unroll
        for (int k = 0; k < 4; ++k) {
            *(LAS unsigned*)(lds + RT_VT + (c * 8 + 2 * k) * RT_P + j0 * 2) = (e0[k] & 0xffffu) | (e1[k] << 16);
            *(LAS unsigned*)(lds + RT_VT + (c * 8 + 2 * k + 1) * RT_P + j0 * 2) = (e0[k] >> 16) | (e1[k] & 0xffff0000u);
        }
    }
}
__device__ __forceinline__ void ret_kv_unit(const Args& a, bf16* kvbase, int unit, LAS unsigned char* lds, int tid) {
    const bf16* PROJ = (const bf16*)(a.ws + WS_PROJ);
    const float* rc = (const float*)(a.ws + WS_ROT); const float* rs = rc + LP * 64;
    const int lane = tid & 63, wave = __builtin_amdgcn_readfirstlane(tid >> 6);
    const int bh = unit / NCH, n = unit - bh * NCH, bl = bh >> 2, hd = bh & 3;
    const float l2g = log2f(1.0f - exp2f(-5.0f - (float)hd));
    const int it = wave & 3, eh = wave >> 2, q = lane & 31, h = lane >> 5;
    const int row0 = bl * LP + n * BLK;
    ret_stage_k<false, true>(PROJ, rc, rs, lds, row0, n, hd, l2g, wave, lane);
    ret_stage_vt(PROJ, lds, row0, hd, wave, lane);
    __syncthreads();
    bf16* img = kvbase + (size_t)unit * KV_IMG;
#pragma unroll
    for (int eb = 0; eb < 2; ++eb) {
        const int et = 2 * eh + eb;
        f32x16 acc;
#pragma unroll
        for (int i = 0; i < 16; ++i) acc[i] = 0.f;
#pragma unroll
        for (int s8 = 0; s8 < 8; ++s8) {
            const bf16x8 kz = *(const LAS bf16x8*)(lds + RT_KZT + (32 * it + q) * RT_P + (16 * s8 + 8 * h) * 2);
            const bf16x8 vf = *(const LAS bf16x8*)(lds + RT_VT + (32 * et + q) * RT_P + (16 * s8 + 8 * h) * 2);
            acc = MFMA32(kz, vf, acc);
        }
        v4u w0, w1;
        w0.x = cvtpk(acc[0], acc[1]); w0.y = cvtpk(acc[2], acc[3]); w0.z = cvtpk(acc[4], acc[5]); w0.w = cvtpk(acc[6], acc[7]);
        w1.x = cvtpk(acc[8], acc[9]); w1.y = cvtpk(acc[10], acc[11]); w1.z = cvtpk(acc[12], acc[13]); w1.w = cvtpk(acc[14], acc[15]);
        v4u* op = (v4u*)(img + ((wave * 2 + eb) * 64 + lane) * 16);
        op[0] = w0; op[1] = w1;
    }
    __syncthreads();
}
__device__ __forceinline__ void ret_out_unit(const Args& a, const bf16* kvbase, int unit, LAS unsigned char* lds, int tid) {
    const bf16* PROJ = (const bf16*)(a.ws + WS_PROJ); bf16* BR = (bf16*)(a.ws + WS_BR);
    const float* rc = (const float*)(a.ws + WS_ROT); const float* rs = rc + LP * 64;
    const int lane = tid & 63, wave = __builtin_amdgcn_readfirstlane(tid >> 6);
    const int bh = unit / NCH, n = unit - bh * NCH, bl = bh >> 2, hd = bh & 3;
    const float l2g = log2f(1.0f - exp2f(-5.0f - (float)hd));
    const int it = wave & 3, eh = wave >> 2, q = lane & 31, h = lane >> 5;
    const int row0 = bl * LP + n * BLK;
    {
        f32x16 Sacc[2];
#pragma unroll
        for (int b = 0; b < 2; ++b)
#pragma unroll
            for (int i = 0; i < 16; ++i) Sacc[b][i] = 0.f;
        const bf16* img0 = kvbase + (size_t)(bh * NCH) * KV_IMG + (wave * 2 * 64 + lane) * 16;
        for (int m = 0; m < n; ++m) {
            const float w = exp2f(128.0f * (float)(n - 1 - m) * l2g);
            const v4u* ip = (const v4u*)(img0 + (size_t)m * KV_IMG);
            const v4u x0 = ip[0], x1 = ip[1], y0 = ip[64 * 2], y1 = ip[64 * 2 + 1];
            const unsigned X[8] = {x0.x, x0.y, x0.z, x0.w, x1.x, x1.y, x1.z, x1.w}, Y[8] = {y0.x, y0.y, y0.z, y0.w, y1.x, y1.y, y1.z, y1.w};
#pragma unroll
            for (int k = 0; k < 8; ++k) { Sacc[0][2 * k] += w * bflo(X[k]); Sacc[0][2 * k + 1] += w * bfhi(X[k]); Sacc[1][2 * k] += w * bflo(Y[k]); Sacc[1][2 * k + 1] += w * bfhi(Y[k]); }
        }
#pragma unroll
        for (int eb = 0; eb < 2; ++eb)
#pragma unroll
            for (int g4 = 0; g4 < 4; ++g4) {
                v2u w; w.x = cvtpk(Sacc[eb][4 * g4 + 0], Sacc[eb][4 * g4 + 1]); w.y = cvtpk(Sacc[eb][4 * g4 + 2], Sacc[eb][4 * g4 + 3]);
                *(LAS v2u*)(lds + RT_ST + (32 * (2 * eh + eb) + q) * RT_P + (32 * it + 8 * g4 + 4 * h) * 2) = w;
            }
    }
    ret_stage_k<true, false>(PROJ, rc, rs, lds, row0, n, hd, l2g, wave, lane);
    ret_stage_vt(PROJ, lds, row0, hd, wave, lane);
    bf16x8 qf[8];
    {
        const int il = 32 * it + q, idx = n * BLK + il;
        const bf16* p = PROJ + (size_t)(row0 + il) * PW + C_RQ + hd * 128;
#pragma unroll
        for (int ks = 0; ks < 4; ++ks) {
            const int d0 = 16 * ks + 8 * h;
            const v4u x1 = *(const v4u*)(p + d0), x2 = *(const v4u*)(p + 64 + d0);
            const f32x4 c0 = *(const f32x4*)(rc + idx * 64 + d0), c1 = *(const f32x4*)(rc + idx * 64 + d0 + 4), s0 = *(const f32x4*)(rs + idx * 64 + d0), s1 = *(const f32x4*)(rs + idx * 64 + d0 + 4);
            const unsigned X1[4] = {x1.x, x1.y, x1.z, x1.w}, X2[4] = {x2.x, x2.y, x2.z, x2.w};
            const float C[8] = {c0.x, c0.y, c0.z, c0.w, c1.x, c1.y, c1.z, c1.w}, S[8] = {s0.x, s0.y, s0.z, s0.w, s1.x, s1.y, s1.z, s1.w};
            float r1[8], r2[8];
#pragma unroll
            for (int e = 0; e < 8; ++e) { const float t1 = (e & 1) ? bfhi(X1[e >> 1]) : bflo(X1[e >> 1]), t2 = (e & 1) ? bfhi(X2[e >> 1]) : bflo(X2[e >> 1]); r1[e] = t1 * C[e] - t2 * S[e]; r2[e] = t1 * S[e] + t2 * C[e]; }
            qf[ks] = pack8(r1[0], r1[1], r1[2], r1[3], r1[4], r1[5], r1[6], r1[7]);
            qf[ks + 4] = pack8(r2[0], r2[1], r2[2], r2[3], r2[4], r2[5], r2[6], r2[7]);
        }
    }
    __syncthreads();
    bf16x8 tf[4][2];
#pragma unroll
    for (int jt = 0; jt < 4; ++jt) {
        if (jt <= it) {
            f32x16 acc;
#pragma unroll
            for (int i = 0; i < 16; ++i) acc[i] = 0.f;
#pragma unroll
            for (int ks = 0; ks < 8; ++ks) { const bf16x8 kf = *(const LAS bf16x8*)(lds + RT_KP + (32 * jt + q) * RT_P + (16 * ks + 8 * h) * 2); acc = MFMA32(kf, qf[ks], acc); }
#pragma unroll
            for (int reg = 0; reg < 16; ++reg) {
                const int diff = (32 * it + q) - (32 * jt + (reg & 3) + 8 * (reg >> 2) + 4 * h);
                acc[reg] = diff >= 0 ? acc[reg] * exp2f((float)diff * l2g) : 0.f;
            }
            tf[jt][0] = pack8(acc[0], acc[1], acc[2], acc[3], acc[4], acc[5], acc[6], acc[7]);
            tf[jt][1] = pack8(acc[8], acc[9], acc[10], acc[11], acc[12], acc[13], acc[14], acc[15]);
        }
    }
    const float xi = exp2f((float)(32 * it + q + 1) * l2g);
    f32x16 o[2];
#pragma unroll
    for (int eb = 0; eb < 2; ++eb) {
        const int et = 2 * eh + eb;
        f32x16 ain, ac;
#pragma unroll
        for (int i = 0; i < 16; ++i) { ain[i] = 0.f; ac[i] = 0.f; }
#pragma unroll
        for (int jt = 0; jt < 4; ++jt) {
            if (jt <= it) {
#pragma unroll
                for (int s2 = 0; s2 < 2; ++s2) {
                    const LAS unsigned char* vp = lds + RT_VT + (32 * et + q) * RT_P + (32 * jt + 16 * s2 + 4 * h) * 2;
                    ain = MFMA32(join2(*(const LAS v2u*)vp, *(const LAS v2u*)(vp + 16)), tf[jt][s2], ain);
                }
            }
        }
#pragma unroll
        for (int ks = 0; ks < 8; ++ks) { const bf16x8 sf = *(const LAS bf16x8*)(lds + RT_ST + (32 * et + q) * RT_P + (16 * ks + 8 * h) * 2); ac = MFMA32(sf, qf[ks], ac); }
#pragma unroll
        for (int i = 0; i < 16; ++i) o[eb][i] = ain[i] + xi * ac[i];
    }
    float sm = 0.f;
#pragma unroll
    for (int eb = 0; eb < 2; ++eb)
#pragma unroll
        for (int i = 0; i < 16; ++i) sm += o[eb][i];
    sm += __shfl_xor(sm, 32);
    const float mw = sm * (1.0f / 64.0f);
    float m2 = 0.f;
#pragma unroll
    for (int eb = 0; eb < 2; ++eb)
#pragma unroll
        for (int i = 0; i < 16; ++i) { const float dlt = o[eb][i] - mw; m2 += dlt * dlt; }
    m2 += __shfl_xor(m2, 32);
    if (h == 0) { LAS float* st = (LAS float*)(lds + RT_STAT) + (eh * 128 + 32 * it + q) * 2; st[0] = mw; st[1] = m2; }
    __syncthreads();
    {
        const LAS float* s0 = (const LAS float*)(lds + RT_STAT) + (0 * 128 + 32 * it + q) * 2; const LAS float* s1 = (const LAS float*)(lds + RT_STAT) + (1 * 128 + 32 * it + q) * 2;
        const float m0 = s0[0], q0 = s0[1], m1 = s1[0], q1 = s1[1];
        const float mean = 0.5f * (m0 + m1), dm = m0 - m1;
        const float var = (q0 + q1 + 32.0f * dm * dm) * (1.0f / 128.0f);
        const float rstd = 1.0f / sqrtf(var + GN_EPS);
        const size_t grow = (size_t)(row0 + 32 * it + q);
        const bf16* grp = PROJ + grow * PW + C_RG + hd * 128; bf16* orp = BR + grow * BRW + 512 + hd * 128;
#pragma unroll
        for (int eb = 0; eb < 2; ++eb)
#pragma unroll
            for (int g4 = 0; g4 < 4; ++g4) {
                const int e0 = 32 * (2 * eh + eb) + 8 * g4 + 4 * h;
                const v2u gw = *(const v2u*)(grp + e0);
                v2u w; w.x = cvtpk((o[eb][4 * g4 + 0] - mean) * rstd * silu(bflo(gw.x)), (o[eb][4 * g4 + 1] - mean) * rstd * silu(bfhi(gw.x)));
                w.y = cvtpk((o[eb][4 * g4 + 2] - mean) * rstd * silu(bflo(gw.y)), (o[eb][4 * g4 + 3] - mean) * rstd * silu(bfhi(gw.y)));
                *(v2u*)(orp + e0) = w;
            }
    }
    __syncthreads();
}
static_assert(AT_END <= LDSCTL_OFF && RT_END <= LDSCTL_OFF, "mixer LDS images fit below the control words");

#ifndef PROBE_RET
#define PROBE_RET 1
#endif
#ifndef PROBE_ATT
#define PROBE_ATT 1
#endif
#ifndef PROBE_CONV
#define PROBE_CONV 1
#endif
#ifndef PROBE_REP
#define PROBE_REP -1
#endif
#ifndef MIX_SIMPLE
#define MIX_SIMPLE 0
#endif
#ifndef MK_PER_STEP
#define MK_PER_STEP 0
#endif
__device__ __forceinline__ void run_step(const Args& args, int s, LAS unsigned char* lds, int tid, int bid, int G) {
    const int lane = tid & 63, wave = __builtin_amdgcn_readfirstlane(tid >> 6);
    const int gw = bid * NWAVES + wave, NGW = G * NWAVES;
    if (s == 0) {
        p0_prologue(args, lds, tid, wave, lane);
    } else {
        const int q = s - 1, hl = q / NPH, ph = q - hl * NPH, half = hl >> 1, layer = hl & 1;
        bf16* kvb = (bf16*)(args.ws + WS_KV);
        if (ph == 0) {
            pg8::Gemm g{(const pg8::bf16_t*)(args.ws + WS_XN), (const pg8::bf16_t*)(args.ws + WS_WIN + layer * WIN_BYTES), MH, PW, D};
            pg8::StaticOrder S; S.init(MH, PW, G, bid);
            pg8::EpiBf16 E{(pg8::bf16_t*)(args.ws + WS_PROJ), PW};
            pg8::gemm_phase<pg8::EpiBf16, pg8::StaticOrder, true, true>(lds + RING_OFF, g, S, E, tid);
        } else if (ph == 1) {
            const int NATT = HB * NCH * 2, NKV = HB * 4 * NCH;
            for (int rep = 0; rep < PROBE_ATT; ++rep) for (int u = bid; u < NATT; u += G) attn_unit(args, layer, u, lds, tid);
            for (int rep = 0; rep < PROBE_RET; ++rep) for (int u = G - 1 - bid; u < NKV; u += G) ret_kv_unit(args, kvb, u, lds, tid);
            for (int rep = 0; rep < PROBE_CONV; ++rep) for (int it = gw; it < MH / CV_RUN; it += NGW) conv_item(args, layer, it, lane);
        } else if (ph == 2) {
            const int NKV = HB * 4 * NCH;
            for (int rep = 0; rep < PROBE_RET; ++rep) for (int j = bid; j < NKV; j += G) { const int n = NCH - 1 - j / (HB * 4), bh = j % (HB * 4); ret_out_unit(args, kvb, bh * NCH + n, lds, tid); }
        } else if (ph == 3) {
            pg8::Gemm g{(const pg8::bf16_t*)(args.ws + WS_BR), (const pg8::bf16_t*)(args.ws + WS_WBR + layer * WBR_BYTES), MH, D, BRW};
            pg8::StaticOrder S; S.init(MH, D, G, bid);
            pg8::EpiGate E{(pg8::bf16_t*)(args.ws + WS_XN), D, (const pg8::bf16_t*)(args.ws + WS_PROJ) + C_MG};
            pg8::gemm_phase<pg8::EpiGate, pg8::StaticOrder, true, true>(lds + RING_OFF, g, S, E, tid);
        } else if (ph == 4) {
            pg8::Gemm g{(const pg8::bf16_t*)(args.ws + WS_XN), (const pg8::bf16_t*)(args.ws + WS_WOUT + layer * WOUT_BYTES), MH, D, D};
            pg8::StaticOrder S; S.init(MH, D, G, bid);
            pg8::EpiF32 E{(float*)(args.ws + WS_PROJ), D};
            pg8::gemm_phase<pg8::EpiF32, pg8::StaticOrder, true, true>(lds + RING_OFF, g, S, E, tid);
        } else {
            p5_norm_residual(args, half, layer, gw, NGW, lane);
            if (half == 0 && layer == 1) xn_from_input(args, 1, gw, NGW, lane);
        }
    }
}
typedef const __attribute__((address_space(4))) Args* KArgsPtr;
#if defined(__HIP_DEVICE_COMPILE__)
#define LOAD_ARGS(a) KArgsPtr a##_p = (KArgsPtr)__builtin_amdgcn_kernarg_segment_ptr(); asm volatile("" : "+s"(a##_p)); Args a; \
    _Pragma("unroll") for (int _i = 0; _i < 10; ++_i) a.in[_i] = a##_p->in[_i]; a.out = a##_p->out; a.ws = a##_p->ws; a.ph_lo = a##_p->ph_lo; a.ph_hi = a##_p->ph_hi
#else
#define LOAD_ARGS(a) const Args a = args
#endif

__global__ void __launch_bounds__(NTHR, 2) fwd_kernel(Args args) {
    extern __shared__ __attribute__((aligned(16))) unsigned char lds_raw[];
    LAS unsigned char* lds = (LAS unsigned char*)lds_raw;
    for (int u = threadIdx.x; u < (LDS_BYTES - LDSCTL_OFF) / 4; u += NTHR) ((LAS unsigned*)(lds + LDSCTL_OFF))[u] = 0u;
    __syncthreads();
    const int lo = args.ph_lo, hi = args.ph_hi;
#if MK_PER_STEP
    run_step(args, lo, lds, (int)threadIdx.x, (int)blockIdx.x, (int)gridDim.x);
#else
    (void)xcd_barrier_post((unsigned*)((gu32*)(args.ws + WS_CTL) + CW_BAR), (volatile LAS unsigned*)(lds + MISC_OFF) + 8);
#define GRID_BARRIER() do { LOAD_ARGS(b); XcdBarrier bar; bar.bar = (unsigned*)((gu32*)(b.ws + WS_CTL) + CW_BAR); bar.x = xb_xcc_id(); bar.st = (volatile LAS unsigned*)(lds + MISC_OFF) + 8; xcd_barrier(bar); } while (0)
    int s0 = lo;
    const int wave_s = __builtin_amdgcn_readfirstlane((int)threadIdx.x >> 6);
    if (s0 == 0) {
        { LOAD_ARGS(a); run_step(a, 0, lds, (int)threadIdx.x, (int)blockIdx.x, (int)gridDim.x); }
        if (hi > 1) GRID_BARRIER();
        s0 = 1;
    }
    for (int s = s0; s < hi; ++s) {
        LAS unsigned char* ldsq = lds; asm volatile("" : "+s"(ldsq));
        int bid = blockIdx.x, gsz = gridDim.x; asm volatile("" : "+s"(bid), "+s"(gsz));
        int tid; asm volatile("v_mbcnt_lo_u32_b32 %0, -1, 0\n\tv_mbcnt_hi_u32_b32 %0, -1, %0\n\tv_lshl_add_u32 %0, %1, 6, %0" : "=&v"(tid) : "s"(wave_s));
        int sq = s; asm volatile("" : "+s"(sq));
        if (sq == 0) continue;
        { LOAD_ARGS(a); run_step(a, sq, ldsq, tid, bid, gsz); }
#if PROBE_REP >= 0
        if ((sq - 1) % NPH == PROBE_REP) { GRID_BARRIER(); LOAD_ARGS(a); run_step(a, sq, ldsq, tid, bid, gsz); }
#endif
        if (s + 1 < hi) GRID_BARRIER();
    }
#endif
}

extern "C" void kernel_launch(void* const* d_in, const int* in_sizes, int n_in, void* d_out, int out_size, void* d_ws, size_t ws_size, hipStream_t stream) {
    static int grid = 0;
    if (grid == 0) {
        if (n_in != 10 || in_sizes[0] != BATCH * SEQ * D || out_size != BATCH * SEQ * D || ws_size < WS_END) { fprintf(stderr, "kernel_launch: unexpected shapes (n_in %d in0 %d out %d ws %zu)\n", n_in, n_in > 0 ? in_sizes[0] : -1, out_size, ws_size); grid = -1; return; }
        int dev = 0, cus = 0;
        if (hipGetDevice(&dev) != hipSuccess || hipDeviceGetAttribute(&cus, hipDeviceAttributeMultiprocessorCount, dev) != hipSuccess) { grid = -1; return; }
        if (hipFuncSetAttribute((const void*)fwd_kernel, hipFuncAttributeMaxDynamicSharedMemorySize, LDS_BYTES) != hipSuccess) { fprintf(stderr, "kernel_launch: hipFuncSetAttribute failed\n"); grid = -1; return; }
        (void)hipGetLastError();
        grid = cus;
    }
    if (grid < 0) return;
    if (hipMemsetAsync((char*)d_ws + WS_CTL, 0, CTL_ZERO_BYTES, stream) != hipSuccess) return;
    Args a{};
    for (int i = 0; i < 10; ++i) a.in[i] = (const float*)d_in[i];
    a.out = (float*)d_out; a.ws = (unsigned char*)d_ws;
#if MK_PER_STEP
    for (int s = 0; s < NSTEPS; ++s) { a.ph_lo = s; a.ph_hi = s + 1; hipLaunchKernelGGL(fwd_kernel, dim3(grid), dim3(NTHR), LDS_BYTES, stream, a); }
#else
    a.ph_lo = 0; a.ph_hi = NSTEPS; hipLaunchKernelGGL(fwd_kernel, dim3(grid), dim3(NTHR), LDS_BYTES, stream, a);
#endif
}
```

```cpp
#include <hip/hip_runtime.h>
#include <cstdio>
#include <cstdint>
#include <cmath>
namespace pg8 {
#define PG8_LAS __attribute__((address_space(3)))
typedef unsigned short bf16_t;
typedef short bf16x8 __attribute__((ext_vector_type(8)));
typedef float f32x4 __attribute__((ext_vector_type(4)));
typedef unsigned u32x4 __attribute__((ext_vector_type(4)));
constexpr int BM = 256, BK = 64, HALF = 128, HTB = HALF * BK * 2  , STAGE_BYTES = 8 * HTB, NXCD = 8, WGM = 8;

__host__ __device__ __forceinline__ int lds_byte(int r, int c) { const int st = (r >> 4) * 2 + (c >> 5), rr = r & 15, cc = c & 31, ob = rr * 64 + cc * 2; return st * 1024 + (ob ^ (((ob >> 9) & 1) << 5)); }
__host__ __device__ __forceinline__ void stage_rc(int b, int& R, int& C) { const int st = b / 1024, sb = b % 1024, swz = sb ^ (((sb >> 9) & 1) << 5); R = (st >> 1) * 16 + swz / 64; C = (st & 1) * 32 + (swz % 64) / 2; }
__host__ __device__ __forceinline__ int perm32(int rho) { const int n = rho >> 4, i = rho & 15; return 8 * (i >> 2) + 4 * n + (i & 3); }

struct Unit { int pm, pn; };
struct Gemm { const bf16_t* A; const bf16_t* Bt; int M, N, K; };

struct StaticOrder {
    int nM, nN, nwg, G, c;
    __host__ __device__ void init(int M, int N, int G_, int c_) { nM = M / BM; nN = N / BM; nwg = nM * nN; G = G_; c = c_; }
    __host__ __device__ bool next(int i, Unit& u) const {
        const long L = (long)i * G + c; if (L >= nwg) return false;
        int wgid = (int)L; { const int q = nwg / NXCD, r = nwg % NXCD, xcd = wgid % NXCD, off = wgid / NXCD; wgid = (xcd < r ? xcd * (q + 1) : r * (q + 1) + (xcd - r) * q) + off; }
        const int nig = WGM * nN, gid = wgid / nig, fm = gid * WGM, gsz = (nM - fm) < WGM ? (nM - fm) : WGM;
        u.pm = fm + ((wgid % nig) % gsz); u.pn = (wgid % nig) / gsz; return true;
    }
    __device__ __forceinline__ void a_ready(const Unit&) const {}
    __device__ __forceinline__ void done(const Unit&) const {}
};


typedef __bf16 bf16x2n __attribute__((ext_vector_type(2))); typedef float f32x2n __attribute__((ext_vector_type(2)));
__device__ __forceinline__ unsigned cvt_pk_bf16(float lo, float hi) { const f32x2n v = {lo, hi}; return __builtin_bit_cast(unsigned, __builtin_convertvector(v, bf16x2n)); }
__device__ __forceinline__ float bflo(unsigned w) { return __uint_as_float(w << 16); }
__device__ __forceinline__ float bfhi(unsigned w) { return __uint_as_float(w & 0xffff0000u); }

struct EpiF32 {
    static constexpr bool PERM = false, AFTER_DRAIN = false, MID = false;
    float* C; int ldc;
    __device__ __forceinline__ void operator()(const f32x4 (&acc)[2][2][4][2], const Unit& u, int wr, int wc, int fr, int fq) const {
        const int row0 = u.pm * BM + wr * 64 + fr, col0 = u.pn * BM + wc * 32 + 4 * fq;
#pragma unroll
        for (int ai = 0; ai < 2; ++ai)
#pragma unroll
            for (int m = 0; m < 4; ++m) { float* rowp = C + (size_t)(row0 + ai * HALF + m * 16) * ldc + col0;
#pragma unroll
                for (int bj = 0; bj < 2; ++bj)
#pragma unroll
                    for (int n = 0; n < 2; ++n) *(f32x4*)(rowp + bj * HALF + n * 16) = acc[ai][bj][m][n]; }
    }
};
struct EpiBf16 {
    static constexpr bool PERM = true, AFTER_DRAIN = false, MID = false;
    bf16_t* O; int ldc;
    __device__ __forceinline__ void operator()(const f32x4 (&acc)[2][2][4][2], const Unit& u, int wr, int wc, int fr, int fq) const {
        const int row0 = u.pm * BM + wr * 64 + fr; const int col0 = u.pn * BM + wc * 32 + 8 * fq;
#pragma unroll
        for (int ai = 0; ai < 2; ++ai)
#pragma unroll
            for (int m = 0; m < 4; ++m) { bf16_t* rowp = O + (size_t)(row0 + ai * HALF + m * 16) * ldc + col0;
#pragma unroll
                for (int bj = 0; bj < 2; ++bj) { const f32x4 v0 = acc[ai][bj][m][0], v1 = acc[ai][bj][m][1];
                    u32x4 w; w.x = cvt_pk_bf16(v0[0], v0[1]); w.y = cvt_pk_bf16(v0[2], v0[3]); w.z = cvt_pk_bf16(v1[0], v1[1]); w.w = cvt_pk_bf16(v1[2], v1[3]);
                    *(u32x4*)(rowp + bj * HALF) = w; } }
    }
};
struct EpiGate {
    static constexpr bool PERM = true, AFTER_DRAIN = false, MID = true;
    static constexpr int LDG = 8448;
    bf16_t* O; int ldc; const bf16_t* G;
    __device__ __forceinline__ void scale(f32x4 (&acc)[2][2][4][2], const Unit& u, int which, int wr, int wc, int fr, int fq) const {
        unsigned off0 = ((unsigned)(u.pm * BM + wr * 64 + fr) * (unsigned)LDG + (unsigned)(u.pn * BM + wc * 32 + 8 * fq)) * 2u;
        asm volatile("" : "+v"(off0));
        const char* gb = (const char*)G + (size_t)((which == 3 ? 2 : which - 1) * 1024) * 2;
#pragma unroll
        for (int ai = 0; ai < 2; ++ai)
#pragma unroll
            for (int m = 0; m < 4; ++m) {
#pragma unroll
                for (int bj = 0; bj < 2; ++bj) {
                    const unsigned off = off0 + (unsigned)((ai * HALF + m * 16) * LDG * 2 + bj * HALF * 2);
                    const u32x4 wa = *(const u32x4*)(gb + off);
                    const u32x4 wb = *(const u32x4*)(gb + off + 2048);
                    float a[8] = {bflo(wa.x), bfhi(wa.x), bflo(wa.y), bfhi(wa.y), bflo(wa.z), bfhi(wa.z), bflo(wa.w), bfhi(wa.w)};
                    float b[8] = {bflo(wb.x), bfhi(wb.x), bflo(wb.y), bfhi(wb.y), bflo(wb.z), bfhi(wb.z), bflo(wb.w), bfhi(wb.w)};
                    float f[8];
#pragma unroll
                    for (int e = 0; e < 8; ++e) {
                        const float ea = __expf(-a[e]);
                        if (which == 3) f[e] = __builtin_amdgcn_rcpf(1.0f + ea);
                        else { const float eb = __expf(-b[e]); f[e] = (1.0f + eb) * __builtin_amdgcn_rcpf(1.0f + ea); }
                    }
                    f32x4 v0 = acc[ai][bj][m][0], v1 = acc[ai][bj][m][1];
                    v0[0] *= f[0]; v0[1] *= f[1]; v0[2] *= f[2]; v0[3] *= f[3]; v1[0] *= f[4]; v1[1] *= f[5]; v1[2] *= f[6]; v1[3] *= f[7];
                    acc[ai][bj][m][0] = v0; acc[ai][bj][m][1] = v1; }
                asm volatile("" ::: "memory"); }
    }
    __device__ __forceinline__ void mid(f32x4 (&acc)[2][2][4][2], const Unit& u, int which, int wr, int wc, int fr, int fq) const { scale(acc, u, which, wr, wc, fr, fq); }
    __device__ __forceinline__ void operator()(f32x4 (&acc)[2][2][4][2], const Unit& u, int wr, int wc, int fr, int fq) const {
        scale(acc, u, 3, wr, wc, fr, fq);
        const int row0 = u.pm * BM + wr * 64 + fr; const int col0 = u.pn * BM + wc * 32 + 8 * fq;
#pragma unroll
        for (int ai = 0; ai < 2; ++ai)
#pragma unroll
            for (int m = 0; m < 4; ++m) { bf16_t* rowp = O + (size_t)(row0 + ai * HALF + m * 16) * ldc + col0;
#pragma unroll
                for (int bj = 0; bj < 2; ++bj) { const f32x4 v0 = acc[ai][bj][m][0], v1 = acc[ai][bj][m][1];
                    u32x4 w; w.x = cvt_pk_bf16(v0[0], v0[1]); w.y = cvt_pk_bf16(v0[2], v0[3]); w.z = cvt_pk_bf16(v1[0], v1[1]); w.w = cvt_pk_bf16(v1[2], v1[3]);
                    *(u32x4*)(rowp + bj * HALF) = w; } }
    }
};
template <class Epi, class Sched, bool ALIGN_EPI = false, bool SP2 = false>
__device__ __forceinline__ void gemm_phase(PG8_LAS unsigned char* lds, const Gemm g, const Sched& S, const Epi& E, const int tid) {
    const int wid = __builtin_amdgcn_readfirstlane(tid >> 6), lane = tid & 63, wr = wid >> 2, wc = wid & 3, fr = lane & 15, fq = lane >> 4;
    const int K = g.K, nt = K / BK;
    unsigned voffA[2], voffB[2];
#pragma unroll
    for (int i = 0; i < 2; ++i) { int R, C; stage_rc(tid * 16 + i * 8192, R, C); const int Rb = Epi::PERM ? ((R & ~31) + perm32(R & 31)) : R;
        voffA[i] = (unsigned)(R * K + C) * 2u; voffB[i] = (unsigned)(Rb * K + C) * 2u; }
    const size_t kstep = (size_t)(BK * 2);
    const size_t hstep = (size_t)HALF * K * 2;
    const size_t tstep = 2 * hstep;
    const unsigned ldsw = (unsigned)wid * 1024u;
    const int aoff = lds_byte(wr * 64 + fr, fq * 8), boff = lds_byte(wc * 32 + fr, fq * 8);
#define PG8_SA(b, h) (((b) * 2 + (h)) * HTB)
#define PG8_SB(b, h) ((4 + (b) * 2 + (h)) * HTB)
#define PG8_STAGE(bufoff, gbase, voff) do { _Pragma("unroll") for (int _i = 0; _i < 2; ++_i) \
        __builtin_amdgcn_global_load_lds((const unsigned*)((const char*)(gbase) + (voff)[_i]), (PG8_LAS unsigned*)(lds + (bufoff) + ldsw + _i * 8192), 16, 0, 0); } while (0)
#define PG8_LDA(dst, b, h) do { _Pragma("unroll") for (int m = 0; m < 4; ++m) _Pragma("unroll") for (int k = 0; k < 2; ++k) dst[m][k] = *(const PG8_LAS bf16x8*)(lds + PG8_SA(b, h) + aoff + m * 2048 + k * 1024); } while (0)
#define PG8_LDB(dst, b, h) do { _Pragma("unroll") for (int n = 0; n < 2; ++n) _Pragma("unroll") for (int k = 0; k < 2; ++k) dst[n][k] = *(const PG8_LAS bf16x8*)(lds + PG8_SB(b, h) + boff + n * 2048 + k * 1024); } while (0)
#define PG8_MMA(ai, bj, At, Bt) do { __builtin_amdgcn_s_setprio(1); _Pragma("unroll") for (int m = 0; m < 4; ++m) _Pragma("unroll") for (int n = 0; n < 2; ++n) _Pragma("unroll") for (int k = 0; k < 2; ++k) \
        acc[ai][bj][m][n] = __builtin_amdgcn_mfma_f32_16x16x32_bf16(Bt[n][k], At[m][k], acc[ai][bj][m][n], 0, 0, 0); __builtin_amdgcn_s_setprio(0); } while (0)
#define PG8_WAIT_V(n) asm volatile("s_waitcnt vmcnt(" #n ")" ::: "memory")
#define PG8_WAIT_L(n) asm volatile("s_waitcnt lgkmcnt(" #n ")" ::: "memory")
#define PG8_BAR __builtin_amdgcn_s_barrier()
#define PG8_SCHED __builtin_amdgcn_sched_barrier(0)
    Unit cur, nxt; int ui = 0;
    if (!S.next(0, cur)) return;
    f32x4 acc[2][2][4][2];
#pragma unroll
    for (int a = 0; a < 2; ++a)
#pragma unroll
        for (int b = 0; b < 2; ++b)
#pragma unroll
            for (int m = 0; m < 4; ++m)
#pragma unroll
                for (int n = 0; n < 2; ++n) acc[a][b][m][n] = (f32x4){0.f, 0.f, 0.f, 0.f};
    bf16x8 At[4][2], B0[2][2], B1[2][2];
    const char* cA = (const char*)g.A + (size_t)cur.pm * tstep; const char* cB = (const char*)g.Bt + (size_t)cur.pn * tstep;
    S.a_ready(cur);
    if constexpr (SP2) {
        PG8_STAGE(PG8_SB(0, 0), cB, voffB); PG8_STAGE(PG8_SB(0, 1), cB + hstep, voffB); PG8_STAGE(PG8_SA(0, 0), cA, voffA); PG8_STAGE(PG8_SA(0, 1), cA + hstep, voffA);
        if (wr == 1) PG8_BAR;
        PG8_WAIT_V(2); PG8_BAR;
        PG8_STAGE(PG8_SB(1, 0), cB + kstep, voffB); PG8_STAGE(PG8_SA(1, 0), cA + kstep, voffA); PG8_STAGE(PG8_SB(1, 1), cB + hstep + kstep, voffB);
        PG8_WAIT_V(6); PG8_BAR;
    } else {
        PG8_STAGE(PG8_SB(0, 0), cB, voffB); PG8_STAGE(PG8_SA(0, 0), cA, voffA); PG8_STAGE(PG8_SB(0, 1), cB + hstep, voffB); PG8_STAGE(PG8_SA(0, 1), cA + hstep, voffA);
        if (wr == 1) PG8_BAR;
        PG8_WAIT_V(4); PG8_BAR;
        PG8_STAGE(PG8_SB(1, 0), cB + kstep, voffB); PG8_STAGE(PG8_SA(1, 0), cA + kstep, voffA); PG8_STAGE(PG8_SB(1, 1), cB + hstep + kstep, voffB);
        PG8_WAIT_V(6); PG8_BAR;
    }
    for (;;) {
        const bool has_next = S.next(ui + 1, nxt);
        const char* nA = has_next ? (const char*)g.A + (size_t)nxt.pm * tstep : cA; const char* nB = has_next ? (const char*)g.Bt + (size_t)nxt.pn * tstep : cB;
        const int seg = Epi::MID ? 8 : nt;
        for (int t0 = 0; t0 < nt; t0 += seg) {
        for (int t = t0; t < t0 + seg; t += 2) {
            const bool last = (t == nt - 2);
            const char* a1 = cA + (size_t)(t + 1) * kstep;
            const char* a2 = last ? nA : cA + (size_t)(t + 2) * kstep; const char* b2 = last ? nB : cB + (size_t)(t + 2) * kstep;
            const char* a3 = a2 + kstep; const char* b3 = b2 + kstep;
            if (last && has_next) S.a_ready(nxt);
            if constexpr (SP2) {
            PG8_LDB(B0, 0, 0); PG8_LDB(B1, 0, 1); PG8_SCHED; PG8_LDA(At, 0, 0); PG8_STAGE(PG8_SA(1, 1), a1 + hstep, voffA);
            PG8_WAIT_V(8); PG8_WAIT_L(0); PG8_BAR; PG8_MMA(0, 0, At, B0); PG8_MMA(0, 1, At, B1); PG8_BAR; PG8_SCHED;
            PG8_LDA(At, 0, 1); PG8_STAGE(PG8_SB(0, 0), b2, voffB); PG8_STAGE(PG8_SB(0, 1), b2 + hstep, voffB); PG8_STAGE(PG8_SA(0, 0), a2, voffA);
            PG8_WAIT_V(8); PG8_WAIT_L(0); PG8_BAR; PG8_MMA(1, 0, At, B0); PG8_MMA(1, 1, At, B1); PG8_BAR; PG8_SCHED;
            PG8_LDB(B0, 1, 0); PG8_LDB(B1, 1, 1); PG8_SCHED; PG8_LDA(At, 1, 0); PG8_STAGE(PG8_SA(0, 1), a2 + hstep, voffA);
            PG8_WAIT_V(8); PG8_WAIT_L(0); PG8_BAR; PG8_MMA(0, 0, At, B0); PG8_MMA(0, 1, At, B1); PG8_BAR; PG8_SCHED;
            PG8_LDA(At, 1, 1); PG8_STAGE(PG8_SB(1, 0), b3, voffB); PG8_STAGE(PG8_SB(1, 1), b3 + hstep, voffB); PG8_STAGE(PG8_SA(1, 0), a3, voffA);
            PG8_WAIT_V(8); PG8_WAIT_L(0); PG8_BAR; PG8_MMA(1, 0, At, B0); PG8_MMA(1, 1, At, B1); PG8_BAR; PG8_SCHED;
            } else {
            PG8_LDB(B0, 0, 0); PG8_SCHED; PG8_LDA(At, 0, 0); PG8_STAGE(PG8_SA(1, 1), a1 + hstep, voffA);
            PG8_WAIT_L(8); PG8_BAR; PG8_WAIT_L(0); PG8_MMA(0, 0, At, B0); PG8_BAR; PG8_SCHED;
            PG8_LDB(B1, 0, 1); PG8_STAGE(PG8_SB(0, 0), b2, voffB);
            PG8_BAR; PG8_WAIT_L(0); PG8_MMA(0, 1, At, B1); PG8_BAR;
            PG8_LDA(At, 0, 1); PG8_STAGE(PG8_SA(0, 0), a2, voffA);
            PG8_BAR; PG8_WAIT_L(0); PG8_MMA(1, 0, At, B0); PG8_BAR; PG8_SCHED;
            PG8_STAGE(PG8_SB(0, 1), b2 + hstep, voffB);
            PG8_WAIT_V(6); PG8_BAR; PG8_MMA(1, 1, At, B1); PG8_BAR;
            PG8_LDB(B0, 1, 0); PG8_SCHED; PG8_LDA(At, 1, 0); PG8_STAGE(PG8_SA(0, 1), a2 + hstep, voffA);
            PG8_WAIT_L(8); PG8_BAR; PG8_WAIT_L(0); PG8_MMA(0, 0, At, B0); PG8_BAR; PG8_SCHED;
            PG8_LDB(B1, 1, 1); PG8_STAGE(PG8_SB(1, 0), b3, voffB);
            PG8_BAR; PG8_WAIT_L(0); PG8_MMA(0, 1, At, B1); PG8_BAR;
            PG8_LDA(At, 1, 1); PG8_STAGE(PG8_SA(1, 0), a3, voffA);
            PG8_BAR; PG8_WAIT_L(0); PG8_MMA(1, 0, At, B0); PG8_BAR; PG8_SCHED;
            PG8_STAGE(PG8_SB(1, 1), b3 + hstep, voffB);
            PG8_WAIT_V(6); PG8_BAR; PG8_MMA(1, 1, At, B1); PG8_BAR;
            }
        }
        if constexpr (Epi::MID) { if (t0 + seg < nt) E.mid(acc, cur, t0 / seg + 1, wr, wc, fr, fq); }
        }
        if constexpr (ALIGN_EPI) { if (wr == 0) PG8_BAR; }
        if constexpr (!Epi::AFTER_DRAIN) { E(acc, cur, wr, wc, fr, fq); S.done(cur); }
        if (!has_next) break;
#pragma unroll
        for (int a = 0; a < 2; ++a)
#pragma unroll
            for (int b = 0; b < 2; ++b)
#pragma unroll
                for (int m = 0; m < 4; ++m)
#pragma unroll
                    for (int n = 0; n < 2; ++n) acc[a][b][m][n] = (f32x4){0.f, 0.f, 0.f, 0.f};
        cur = nxt; cA = nA; cB = nB; ++ui;
        if constexpr (ALIGN_EPI) { if (wr == 1) PG8_BAR; }
    }
    PG8_WAIT_V(0);
    if constexpr (!ALIGN_EPI) { if (wr == 0) PG8_BAR; }
    PG8_BAR;
    if constexpr (Epi::AFTER_DRAIN) { E.fused(acc, cur, wr, wc, fr, fq, lds, wid, lane); S.done(cur); }
#undef PG8_SA
#undef PG8_SB
#undef PG8_STAGE
#undef PG8_LDA
#undef PG8_LDB
#undef PG8_MMA
#undef PG8_WAIT_V
#undef PG8_WAIT_L
#undef PG8_BAR
#undef PG8_SCHED
}
}


constexpr int NWAVES = 8, NTHR = 512;
constexpr int D = 1024, BATCH = 16, SEQ = 2048, BLK = 128, NMETA = 16, PADF = 112, LP = 2176;
constexpr int PW = 8448;
constexpr int HB = 8, MH = HB * SEQ, NCB = SEQ / BLK;
constexpr int C_AQ = 0, C_AK = 512, C_AV = 640, C_AG = 768, C_RQ = 1280, C_RK = 1792, C_RV = 2304, C_RG = 2816, C_CB = 3328, C_CC = 3840, C_CX = 4352, C_CG = 4864, C_MG = 5376;
constexpr int BRW = 1536;
constexpr float RMS_EPS = 1e-6f, GN_EPS = 1e-6f;
constexpr int NPH = 6, NSTEPS = 1 + 4 * NPH;

constexpr size_t MiB = 1u << 20;
constexpr size_t WS_CTL = 0, CTL_ZERO_BYTES = 1 * MiB;
constexpr size_t WS_WIN = 1 * MiB, WIN_BYTES = (size_t)PW * D * 2;
constexpr size_t WS_WBR = 34 * MiB, WBR_BYTES = (size_t)D * BRW * 2;
constexpr size_t WS_WOUT = 40 * MiB, WOUT_BYTES = (size_t)D * D * 2;
constexpr size_t WS_ROT = 44 * MiB;
constexpr size_t WS_XN = 46 * MiB;
constexpr size_t WS_BR = 78 * MiB;
constexpr size_t WS_H = 126 * MiB;
constexpr size_t WS_PROJ = 190 * MiB;
constexpr size_t WS_KV = 454 * MiB;
constexpr size_t WS_PROJM = 470 * MiB;
constexpr size_t WS_BRM = 473 * MiB;
constexpr size_t WS_MIXM = 474 * MiB, WS_YM = WS_MIXM + 64 * 1024, WS_XNM = WS_YM + 64 * 1024, WS_KVM = WS_XNM + 64 * 1024;
constexpr size_t WS_END = 476 * MiB;
static_assert(WS_WIN + 2 * WIN_BYTES <= WS_WBR && WS_WBR + 2 * WBR_BYTES <= WS_WOUT && WS_WOUT + 2 * WOUT_BYTES <= WS_ROT && WS_ROT + (size_t)LP * 64 * 8 <= WS_XN, "ws map 1");
static_assert(WS_XN + (size_t)MH * D * 2 <= WS_BR && WS_BR + (size_t)MH * BRW * 2 <= WS_H && WS_H + (size_t)MH * D * 4 <= WS_PROJ && WS_PROJ + (size_t)MH * PW * 2 <= WS_KV && WS_KV + (size_t)HB * 4 * NCB * 32768 <= WS_PROJM, "ws map 2");
static_assert(WS_PROJM + (size_t)128 * PW * 2 <= WS_BRM && WS_BRM + (size_t)128 * BRW * 2 <= WS_MIXM && WS_KVM + 4 * 32768 <= WS_END, "ws map 3");
constexpr int CW_TMO = 0, CW_CODE = 1, CW_BAR = 4096;

constexpr int RING_OFF = 0, RING_BYTES = 131072;
constexpr int LDS_BYTES = 147456;
constexpr int LDSCTL_OFF = LDS_BYTES - 1024, MISC_OFF = LDSCTL_OFF + 320;

#define GAS __attribute__((address_space(1)))
#define LAS __attribute__((address_space(3)))
typedef unsigned short bf16;
typedef unsigned v4u __attribute__((ext_vector_type(4)));
typedef unsigned v2u __attribute__((ext_vector_type(2)));
typedef float f32x4 __attribute__((ext_vector_type(4)));
typedef GAS unsigned gu32;
#define RLX_AGENT __ATOMIC_RELAXED, __HIP_MEMORY_SCOPE_AGENT
#define LDS_WAIT() asm volatile("s_waitcnt lgkmcnt(0)" ::: "memory")
#define VM_WAIT() asm volatile("s_waitcnt vmcnt(0)" ::: "memory")
__device__ __forceinline__ unsigned f2bf(float f) { unsigned u = __builtin_bit_cast(unsigned, f); return (u + 0x7fffu + ((u >> 16) & 1u)) >> 16; }
__device__ __forceinline__ unsigned pk2(float lo, float hi) { return f2bf(lo) | (f2bf(hi) << 16); }
__device__ __forceinline__ float bf2f(bf16 h) { return __uint_as_float((unsigned)h << 16); }
__device__ __forceinline__ float bflo(unsigned w) { return __uint_as_float(w << 16); }
__device__ __forceinline__ float bfhi(unsigned w) { return __uint_as_float(w & 0xffff0000u); }
__device__ __forceinline__ v4u zero4() { unsigned z = 0u; asm volatile("" : "+v"(z)); return (v4u){z, z, z, z}; }
__device__ __forceinline__ float silu(float g) { return g / (1.0f + __expf(-g)); }
__device__ __forceinline__ float wave_sum(float v) {
#pragma unroll
    for (int o = 1; o < 64; o <<= 1) v += __shfl_xor(v, o);
    return v;
}
__device__ __forceinline__ int t5_bucket(int n) {
    return n < 16 ? n : 16 + (n >= 19) + (n >= 21) + (n >= 24) + (n >= 27) + (n >= 31) + (n >= 35) + (n >= 40) + (n >= 46) + (n >= 52) + (n >= 59) + (n >= 67) + (n >= 77) + (n >= 87) + (n >= 99) + (n >= 113);
}

#define XB_TMO      128
#define XB_XCNT(j)  (256  + 64 * (j))
#define XB_XSUB(j)  (1280 + 64 * (j))
#define XB_XGEN(j)  (2304 + 64 * (j))
#define XB_TOP      3328
#define XB_TOPGEN   3392
#define XCD_BAR_WORDS 3456
#define XB_SPIN_CAP (1u << 18)

__device__ __forceinline__ unsigned xb_ld(unsigned* p)              { return __hip_atomic_load(p, __ATOMIC_RELAXED, __HIP_MEMORY_SCOPE_AGENT); }
__device__ __forceinline__ unsigned xb_add(unsigned* p, unsigned v) { return __hip_atomic_fetch_add(p, v, __ATOMIC_RELAXED, __HIP_MEMORY_SCOPE_AGENT); }
__device__ __forceinline__ unsigned xb_xcc_id() { return (unsigned)__builtin_amdgcn_s_getreg((3 << 11) | 20) & 0xFu; }
#define XB_SPIN(cond, bar) do { unsigned _sp = 0; while (cond) { __builtin_amdgcn_s_sleep(1); \
    if ((++_sp & 255u) == 0u) { if (xb_ld(&(bar)[XB_TMO])) break; if (_sp > XB_SPIN_CAP) { atomicAdd(&(bar)[XB_TMO], 1u); break; } } } } while (0)

struct XcdBarrier {
    unsigned* bar; unsigned x;
    volatile LAS unsigned* st;
};

__device__ __forceinline__ XcdBarrier xcd_barrier_post(unsigned* bar, volatile LAS unsigned* st) {
    XcdBarrier b; b.bar = bar; b.x = xb_xcc_id(); b.st = st;
    if (threadIdx.x == 0) (void)xb_add(&bar[XB_XCNT(b.x)], 1u);
    return b;
}
__device__ __forceinline__ void xcd_barrier_complete(unsigned* bar, unsigned x, unsigned& nloc, unsigned& nx) {
    const unsigned G = gridDim.x * gridDim.y * gridDim.z;
    unsigned sum, cnt, mine, sp = 0u;
    for (;;) {
        sum = 0u; cnt = 0u; mine = 0u;
#pragma unroll
        for (unsigned j = 0; j < 16; ++j) { const unsigned c = xb_ld(&bar[XB_XCNT(j)]); sum += c; cnt += (c > 0u) ? 1u : 0u; mine = (j == x) ? c : mine; }
        if (sum == G) break;
        __builtin_amdgcn_s_sleep(1);
        if ((++sp & 255u) == 0u) { if (xb_ld(&bar[XB_TMO])) break; if (sp > XB_SPIN_CAP) { atomicAdd(&bar[XB_TMO], 1u); break; } }
    }
    nloc = mine > 0u ? mine : 1u; nx = cnt > 0u ? cnt : 1u;
}

__device__ __forceinline__ void xcd_barrier(const XcdBarrier& b) {
    asm volatile("s_waitcnt vmcnt(0)" ::: "memory");
    __syncthreads();
    if (threadIdx.x == 0) {
        unsigned* bar = b.bar;
        __builtin_amdgcn_s_waitcnt(0);
        unsigned nloc = b.st[0], nx = b.st[1];
        if (nloc == 0u) { xcd_barrier_complete(bar, b.x, nloc, nx); b.st[0] = nloc; b.st[1] = nx; }
        const unsigned old = xb_add(&bar[XB_XSUB(b.x)], 1u);
        const unsigned gen = old / nloc;
        if (old + 1u == (gen + 1u) * nloc) {
            __builtin_amdgcn_fence(__ATOMIC_RELEASE, "agent");
            asm volatile("s_waitcnt vmcnt(0)" ::: "memory");
            const unsigned og = xb_add(&bar[XB_TOP], 1u);
            const unsigned tg = og / nx;
            if (og + 1u == (tg + 1u) * nx) xb_add(&bar[XB_TOPGEN], 1u);
            else XB_SPIN(xb_ld(&bar[XB_TOPGEN]) == tg, bar);
            __builtin_amdgcn_fence(__ATOMIC_ACQUIRE, "agent");
            xb_add(&bar[XB_XGEN(b.x)], 1u);
            asm volatile("s_waitcnt vmcnt(0)" ::: "memory");
        } else {
            XB_SPIN(xb_ld(&bar[XB_XGEN(b.x)]) == gen, bar);
            __builtin_amdgcn_fence(__ATOMIC_ACQUIRE, "agent");
            asm volatile("s_waitcnt vmcnt(0)" ::: "memory");
        }
    }
    __syncthreads();
}


struct Args { const float* in[10]; float* out; unsigned char* ws; int ph_lo, ph_hi; };

__device__ __forceinline__ void p0_transpose_item(const float* W, int K, int N, bf16* WT, int ldt, int koff, LAS float* scr, int item, int lane) {
    const int nblk = N / 32, kb = item / nblk, nb = item % nblk, k0 = 64 * kb, n0 = 32 * nb;
#pragma unroll 8
    for (int i = 0; i < 32; ++i) { const int kk = 2 * i + (lane >> 5); scr[kk * 33 + (lane & 31)] = W[(size_t)(k0 + kk) * N + n0 + (lane & 31)]; }
    LDS_WAIT(); asm volatile("" ::: "memory");
    const int c = lane & 7;
#pragma unroll
    for (int j = 0; j < 4; ++j) { const int n = (lane >> 3) + 8 * j; const LAS float* s = scr + (8 * c) * 33 + n;
        v4u o; o.x = pk2(s[0 * 33], s[1 * 33]); o.y = pk2(s[2 * 33], s[3 * 33]); o.z = pk2(s[4 * 33], s[5 * 33]); o.w = pk2(s[6 * 33], s[7 * 33]);
        *(GAS v4u*)(WT + (size_t)(n0 + n) * ldt + koff + k0 + 8 * c) = o; }
    LDS_WAIT(); asm volatile("" ::: "memory");
}

__device__ __forceinline__ void rms_row_to_bf16(const f32x4 (&v)[4], const float* g, bf16* orow, int lane) {
    float s2 = 0.f;
#pragma unroll
    for (int j = 0; j < 4; ++j) s2 += (v[j].x * v[j].x + v[j].y * v[j].y) + (v[j].z * v[j].z + v[j].w * v[j].w);
    const float rstd = 1.0f / sqrtf(wave_sum(s2) * (1.f / D) + RMS_EPS);
    GAS v2u* o8 = (GAS v2u*)orow + lane;
#pragma unroll
    for (int j = 0; j < 4; ++j) { const f32x4 gg = ((const f32x4*)g)[lane + 64 * j]; v2u w; w.x = pk2(v[j].x * rstd * gg.x, v[j].y * rstd * gg.y); w.y = pk2(v[j].z * rstd * gg.z, v[j].w * rstd * gg.w); o8[64 * j] = w; }
}
__device__ __forceinline__ void xn_from_input(const Args& a, int half, int gw, int NGW, int lane) {
    bf16* XN = (bf16*)(a.ws + WS_XN);
    for (int r = gw; r < MH + NMETA; r += NGW) {
        const float* src = r < MH ? a.in[0] + ((size_t)half * MH + r) * D : a.in[1] + (size_t)(r - MH) * D;
        bf16* orow = r < MH ? XN + (size_t)r * D : (bf16*)(a.ws + WS_XNM) + (size_t)(r - MH) * D;
        f32x4 v[4];
#pragma unroll
        for (int j = 0; j < 4; ++j) v[j] = ((const f32x4*)src)[lane + 64 * j];
        rms_row_to_bf16(v, a.in[3], orow, lane);
    }
}

__device__ __forceinline__ void p0_prologue(const Args& a, LAS unsigned char* lds, int tid, int wave, int lane) {
    LAS float* scr = (LAS float*)(lds + RING_OFF + wave * 16384);
    const int gw = blockIdx.x * NWAVES + wave, NGW = gridDim.x * NWAVES;
    constexpr int I_IN = (D / 64) * (PW / 32), I_BR = (512 / 64) * (D / 32), I_OUT = (D / 64) * (D / 32);
    constexpr int PER_LAYER = I_IN + 3 * I_BR + I_OUT, NITEMS = 2 * PER_LAYER;
    for (int it = gw; it < NITEMS; it += NGW) {
        const int l = it / PER_LAYER; int r = it - l * PER_LAYER;
        if (r < I_IN) { p0_transpose_item(a.in[4] + (size_t)l * D * PW, D, PW, (bf16*)(a.ws + WS_WIN + l * WIN_BYTES), D, 0, scr, r, lane); continue; } r -= I_IN;
        if (r < 3 * I_BR) { const int g = r / I_BR; p0_transpose_item(a.in[7] + ((size_t)l * 3 + g) * 512 * D, 512, D, (bf16*)(a.ws + WS_WBR + l * WBR_BYTES), BRW, g * 512, scr, r - g * I_BR, lane); continue; } r -= 3 * I_BR;
        p0_transpose_item(a.in[8] + (size_t)l * D * D, D, D, (bf16*)(a.ws + WS_WOUT + l * WOUT_BYTES), D, 0, scr, r, lane);
    }
    float* rc = (float*)(a.ws + WS_ROT); float* rs = rc + LP * 64;
    for (int e = (blockIdx.x * NTHR + tid); e < LP * 64; e += gridDim.x * NTHR) {
        const int idx = e >> 6, i = e & 63;
        const float lin = (float)i / 63.0f;
        const float theta = (float)(1.0 / pow(10000.0, (double)lin));
        const float ang = (float)(idx - PADF) * theta;
        rc[e] = (float)cos((double)ang); rs[e] = (float)sin((double)ang);
    }
    { v4u* pz = (v4u*)(a.ws + WS_PROJM); const v4u z4 = zero4(); for (int i = blockIdx.x * NTHR + tid; i < PADF * PW * 2 / 16; i += gridDim.x * NTHR) pz[i] = z4; }
    xn_from_input(a, 0, gw, NGW, lane);
}

__device__ __forceinline__ void p5_norm_residual(const Args& a, int half, int layer, int gw, int NGW, int lane) {
    const float* Y = (const float*)(a.ws + WS_PROJ); float* H = (float*)(a.ws + WS_H); bf16* XN = (bf16*)(a.ws + WS_XN);
    const float* gpost = a.in[9] + layer * D;
    const int nrows = layer == 0 ? MH + NMETA : MH;
    for (int r = gw; r < nrows; r += NGW) {
        const bool meta = r >= MH;
        const float* ysrc = meta ? (const float*)(a.ws + WS_YM) + (size_t)(r - MH) * D : Y + (size_t)r * D;
        const float* hsrc = meta ? a.in[1] + (size_t)(r - MH) * D : (layer == 0 ? a.in[0] + ((size_t)half * MH + r) * D : H + (size_t)r * D);
        f32x4 y[4], h[4]; float s2 = 0.f;
#pragma unroll
        for (int j = 0; j < 4; ++j) { y[j] = ((const f32x4*)ysrc)[lane + 64 * j]; h[j] = ((const f32x4*)hsrc)[lane + 64 * j]; s2 += (y[j].x * y[j].x + y[j].y * y[j].y) + (y[j].z * y[j].z + y[j].w * y[j].w); }
        const float rstd = 1.0f / sqrtf(wave_sum(s2) * (1.f / D) + RMS_EPS);
#pragma unroll
        for (int j = 0; j < 4; ++j) { const f32x4 gg = ((const f32x4*)gpost)[lane + 64 * j];
            h[j].x += y[j].x * rstd * gg.x; h[j].y += y[j].y * rstd * gg.y; h[j].z += y[j].z * rstd * gg.z; h[j].w += y[j].w * rstd * gg.w; }
        if (layer == 0) {
            if (!meta) {
#pragma unroll
                for (int j = 0; j < 4; ++j) ((f32x4*)(H + (size_t)r * D))[lane + 64 * j] = h[j];
            }
            rms_row_to_bf16(h, a.in[3] + D, meta ? (bf16*)(a.ws + WS_XNM) + (size_t)(r - MH) * D : XN + (size_t)r * D, lane);
        } else {
            float* orow = a.out + ((size_t)half * MH + r) * D;
#pragma unroll
            for (int j = 0; j < 4; ++j) ((f32x4*)orow)[lane + 64 * j] = h[j];
        }
    }
}

typedef short bf16x8m __attribute__((ext_vector_type(8)));
#define MFMA16(a, b, c) __builtin_amdgcn_mfma_f32_16x16x32_bf16((a), (b), (c), 0, 0, 0)
__device__ __forceinline__ f32x4 small16_dot(const bf16* A, int lda, const bf16* Bt, int ldb, int K, int lane) {
    const bf16* ap = A + (size_t)(lane & 15) * lda + 8 * (lane >> 4); const bf16* bp = Bt + (size_t)(lane & 15) * ldb + 8 * (lane >> 4);
    f32x4 acc = (f32x4){0.f, 0.f, 0.f, 0.f};
    for (int ks = 0; ks < K / 32; ++ks) acc = MFMA16(*(const bf16x8m*)(ap + 32 * ks), *(const bf16x8m*)(bp + 32 * ks), acc);
    return acc;
}
__device__ __forceinline__ void meta_inproj_task(const Args& a, int layer, int nt, int lane) {
    const f32x4 acc = small16_dot((const bf16*)(a.ws + WS_XNM), D, (const bf16*)(a.ws + WS_WIN + layer * WIN_BYTES) + (size_t)(16 * nt) * D, D, D, lane);
    bf16* o = (bf16*)(a.ws + WS_PROJM) + (size_t)(PADF + 4 * (lane >> 4)) * PW + 16 * nt + (lane & 15);
#pragma unroll
    for (int r = 0; r < 4; ++r) o[(size_t)r * PW] = (bf16)f2bf(acc[r]);
}
__device__ __forceinline__ void meta_branch_task(const Args& a, int layer, int nt, int lane) {
    const bf16* PM = (const bf16*)(a.ws + WS_PROJM) + (size_t)PADF * PW; const bf16* BM = (const bf16*)(a.ws + WS_BRM) + (size_t)PADF * BRW;
    const bf16* W = (const bf16*)(a.ws + WS_WBR + layer * WBR_BYTES) + (size_t)(16 * nt) * BRW;
    float o[4] = {0.f, 0.f, 0.f, 0.f};
#pragma unroll
    for (int g = 0; g < 3; ++g) {
        const f32x4 acc = small16_dot(BM + g * 512, BRW, W + g * 512, BRW, 512, lane);
#pragma unroll
        for (int r = 0; r < 4; ++r) { const float mg = bf2f(PM[(size_t)(4 * (lane >> 4) + r) * PW + C_MG + g * 1024 + 16 * nt + (lane & 15)]); o[r] += acc[r] / (1.0f + __expf(-mg)); }
    }
    bf16* op = (bf16*)(a.ws + WS_MIXM) + (size_t)(4 * (lane >> 4)) * D + 16 * nt + (lane & 15);
#pragma unroll
    for (int r = 0; r < 4; ++r) op[(size_t)r * D] = (bf16)f2bf(o[r]);
}
__device__ __forceinline__ void meta_out_task(const Args& a, int layer, int nt, int lane) {
    const f32x4 acc = small16_dot((const bf16*)(a.ws + WS_MIXM), D, (const bf16*)(a.ws + WS_WOUT + layer * WOUT_BYTES) + (size_t)(16 * nt) * D, D, D, lane);
    float* o = (float*)(a.ws + WS_YM) + (size_t)(4 * (lane >> 4)) * D + 16 * nt + (lane & 15);
#pragma unroll
    for (int r = 0; r < 4; ++r) o[(size_t)r * D] = acc[r];
}

struct Chunk { const bf16* cur; const bf16* prev; bf16* br; int cur_from, prev_from, idx0; };
__device__ __forceinline__ Chunk make_chunk(unsigned char* ws, int bl, int c) {
    Chunk k;
    const bf16* PROJ = (const bf16*)(ws + WS_PROJ); const bf16* PM = (const bf16*)(ws + WS_PROJM);
    if (c < 0) { k.cur = PM; k.prev = nullptr; k.br = (bf16*)(ws + WS_BRM); k.cur_from = PADF; k.prev_from = BLK; k.idx0 = 0; }
    else { const size_t r0 = (size_t)bl * SEQ + (size_t)c * BLK; k.cur = PROJ + r0 * PW; k.prev = c > 0 ? k.cur - (size_t)BLK * PW : PM; k.br = (bf16*)(ws + WS_BR) + r0 * BRW; k.cur_from = 0; k.prev_from = c > 0 ? 0 : PADF; k.idx0 = BLK + c * BLK; }
    return k;
}
typedef float f32x16 __attribute__((ext_vector_type(16)));
typedef short bf16x8 __attribute__((ext_vector_type(8)));
#define MFMA32(a, b, c) __builtin_amdgcn_mfma_f32_32x32x16_bf16((a), (b), (c), 0, 0, 0)
__device__ __forceinline__ unsigned cvtpk(float lo, float hi) { return pg8::cvt_pk_bf16(lo, hi); }
__device__ __forceinline__ bf16x8 pack8(float a0, float a1, float a2, float a3, float a4, float a5, float a6, float a7) {
    v4u w; w.x = cvtpk(a0, a1); w.y = cvtpk(a2, a3); w.z = cvtpk(a4, a5); w.w = cvtpk(a6, a7); return __builtin_bit_cast(bf16x8, w);
}
__device__ __forceinline__ bf16x8 join2(v2u lo, v2u hi) { v4u w; w.x = lo.x; w.y = lo.y; w.z = hi.x; w.w = hi.y; return __builtin_bit_cast(bf16x8, w); }

constexpr int AT_KP = 144, AT_VP = 520;
constexpr int AT_K_OFF = 0, AT_VT_OFF = 256 * AT_KP, AT_BIAS_OFF = AT_VT_OFF + 64 * AT_VP, AT_END = AT_BIAS_OFF + 4 * 128 * 4;
__device__ __forceinline__ void attn_unit(const Args& a, int layer, const Chunk ck, int hk, LAS unsigned char* lds, int tid) {
    asm volatile("" : "+v"(tid));
    const int lane = tid & 63, wave = __builtin_amdgcn_readfirstlane(tid >> 6);
#pragma unroll
    for (int k4 = 0; k4 < 4; ++k4) {
        const int it = tid + k4 * NTHR, c = it >> 3, ch = it & 7; v4u v = zero4();
        if (c >= BLK) v = *(const v4u*)(ck.cur + (size_t)(c - BLK) * PW + C_AK + hk * 64 + ch * 8);
        else if (ck.prev) v = *(const v4u*)(ck.prev + (size_t)c * PW + C_AK + hk * 64 + ch * 8);
        *(LAS v4u*)(lds + AT_K_OFF + c * AT_KP + ch * 16) = v;
    }
#pragma unroll
    for (int k2 = 0; k2 < 2; ++k2) {
        const int it = tid + k2 * NTHR, ch = it >> 7, i = it & 127, c0 = 2 * i; v4u v0 = zero4(), v1 = v0;
        if (c0 >= BLK || ck.prev) { const bf16* p = (c0 >= BLK ? ck.cur + (size_t)(c0 - BLK) * PW : ck.prev + (size_t)c0 * PW) + C_AV + hk * 64 + ch * 8; v0 = *(const v4u*)p; v1 = *(const v4u*)(p + PW); }
        const unsigned e0[4] = {v0.x, v0.y, v0.z, v0.w}, e1[4] = {v1.x, v1.y, v1.z, v1.w};
#pragma unroll
        for (int k = 0; k < 4; ++k) {
            const unsigned lo = (e0[k] & 0xffffu) | (e1[k] << 16), hi = (e0[k] >> 16) | (e1[k] & 0xffff0000u);
            *(LAS unsigned*)(lds + AT_VT_OFF + (ch * 8 + 2 * k) * AT_VP + c0 * 2) = lo;
            *(LAS unsigned*)(lds + AT_VT_OFF + (ch * 8 + 2 * k + 1) * AT_VP + c0 * 2) = hi;
        }
    }
    { const int g = tid >> 7, dist = tid & 127; ((LAS float*)(lds + AT_BIAS_OFF))[tid] = a.in[2][t5_bucket(dist) * 8 + hk * 4 + g]; }
    __syncthreads();
    const int g = wave & 3, qh = wave >> 2, hq = hk * 4 + g, q = lane & 31, h = lane >> 5;
    const float sink = a.in[6][layer * 8 + hq];
    const LAS float* biasd = (const LAS float*)(lds + AT_BIAS_OFF) + g * 128;
    for (int qb2 = 0; qb2 < 2; ++qb2) {
        const int r0 = 64 * qh + 32 * qb2;
        const bf16* qrow = ck.cur + (size_t)(r0 + q) * PW;
        bf16x8 qf[4];
#pragma unroll
        for (int ks = 0; ks < 4; ++ks) qf[ks] = *(const bf16x8*)(qrow + C_AQ + hq * 64 + 16 * ks + 8 * h);
        f32x16 sc[5];
#pragma unroll
        for (int t = 0; t < 5; ++t) {
            f32x16 acc;
#pragma unroll
            for (int i = 0; i < 16; ++i) acc[i] = 0.f;
#pragma unroll
            for (int ks = 0; ks < 4; ++ks) { const bf16x8 kf = *(const LAS bf16x8*)(lds + AT_K_OFF + (r0 + 32 * t + q) * AT_KP + (16 * ks + 8 * h) * 2); acc = MFMA32(kf, qf[ks], acc); }
            sc[t] = acc;
        }
        float mloc = -1e30f;
#pragma unroll
        for (int t = 0; t < 5; ++t)
#pragma unroll
            for (int reg = 0; reg < 16; ++reg) {
                const int kk = (reg & 3) + 8 * (reg >> 2) + 4 * h, dist = 128 + q - 32 * t - kk, c = r0 + 32 * t + kk;
                const bool ok = (dist >= 0) && (dist < 128) && (c >= BLK ? c - BLK >= ck.cur_from : c >= ck.prev_from);
                const float s = ok ? sc[t][reg] * 0.125f + biasd[dist & 127] : -1e30f;
                sc[t][reg] = s; mloc = fmaxf(mloc, s);
            }
        const float m = fmaxf(fmaxf(mloc, __shfl_xor(mloc, 32)), sink);
        float lloc = 0.f;
#pragma unroll
        for (int t = 0; t < 5; ++t)
#pragma unroll
            for (int reg = 0; reg < 16; ++reg) { const float p = __expf(sc[t][reg] - m); sc[t][reg] = p; lloc += p; }
        const float inv = 1.0f / (lloc + __shfl_xor(lloc, 32) + __expf(sink - m));
        f32x16 o[2];
#pragma unroll
        for (int db = 0; db < 2; ++db)
#pragma unroll
            for (int i = 0; i < 16; ++i) o[db][i] = 0.f;
#pragma unroll
        for (int t = 0; t < 5; ++t)
#pragma unroll
            for (int s2 = 0; s2 < 2; ++s2) {
                const bf16x8 pf = pack8(sc[t][8 * s2 + 0], sc[t][8 * s2 + 1], sc[t][8 * s2 + 2], sc[t][8 * s2 + 3], sc[t][8 * s2 + 4], sc[t][8 * s2 + 5], sc[t][8 * s2 + 6], sc[t][8 * s2 + 7]);
                const int keyb = r0 + 32 * t + 16 * s2 + 4 * h;
#pragma unroll
                for (int db = 0; db < 2; ++db) {
                    const LAS unsigned char* vp = lds + AT_VT_OFF + (32 * db + q) * AT_VP + keyb * 2;
                    const bf16x8 vf = join2(*(const LAS v2u*)vp, *(const LAS v2u*)(vp + 16));
                    o[db] = MFMA32(vf, pf, o[db]);
                }
            }
        const bf16* grp = qrow + C_AG + hq * 64; bf16* orp = ck.br + (size_t)(r0 + q) * BRW + hq * 64;
#pragma unroll
        for (int db = 0; db < 2; ++db)
#pragma unroll
            for (int g4 = 0; g4 < 4; ++g4) {
                const int d0 = 32 * db + 8 * g4 + 4 * h;
                const v2u gw = *(const v2u*)(grp + d0);
                v2u w; w.x = cvtpk(o[db][4 * g4 + 0] * inv * silu(bflo(gw.x)), o[db][4 * g4 + 1] * inv * silu(bfhi(gw.x)));
                w.y = cvtpk(o[db][4 * g4 + 2] * inv * silu(bflo(gw.y)), o[db][4 * g4 + 3] * inv * silu(bfhi(gw.y)));
                *(v2u*)(orp + d0) = w;
            }
    }
    __syncthreads();
}

constexpr int CV_RUN = 8;
__device__ __forceinline__ void conv_item(const Args& a, int layer, const bf16* cur, const bf16* p1, const bf16* p2, bf16* out, int lane) {
    asm volatile("" : "+v"(lane));
    const float* cw = a.in[5] + layer * 3 * 512 + lane * 8;
    float w0[8], w1[8], w2[8];
#pragma unroll
    for (int e = 0; e < 8; ++e) { w0[e] = cw[e]; w1[e] = cw[512 + e]; w2[e] = cw[1024 + e]; }
    float u1[8], u2[8];
#pragma unroll
    for (int k = 2; k >= 1; --k) {
        const bf16* p = (k == 2 ? p2 : p1) + lane * 8;
        const v4u c = *(const v4u*)(p + C_CC), x = *(const v4u*)(p + C_CX);
        const unsigned cc[4] = {c.x, c.y, c.z, c.w}, xx[4] = {x.x, x.y, x.z, x.w};
#pragma unroll
        for (int e = 0; e < 4; ++e) { const float ua = bflo(cc[e]) * bflo(xx[e]), ub = bfhi(cc[e]) * bfhi(xx[e]); if (k == 2) { u2[2 * e] = ua; u2[2 * e + 1] = ub; } else { u1[2 * e] = ua; u1[2 * e + 1] = ub; } }
    }
    for (int k = 0; k < CV_RUN; ++k) {
        const bf16* p = cur + (size_t)k * PW + lane * 8;
        const v4u c = *(const v4u*)(p + C_CC), x = *(const v4u*)(p + C_CX), b = *(const v4u*)(p + C_CB), gt = *(const v4u*)(p + C_CG);
        const unsigned cc[4] = {c.x, c.y, c.z, c.w}, xx[4] = {x.x, x.y, x.z, x.w}, bb[4] = {b.x, b.y, b.z, b.w}, gg[4] = {gt.x, gt.y, gt.z, gt.w};
        unsigned ow[4];
#pragma unroll
        for (int e = 0; e < 4; ++e) {
            const float ua = bflo(cc[e]) * bflo(xx[e]), ub = bfhi(cc[e]) * bfhi(xx[e]);
            const float ya = w2[2 * e] * ua + w1[2 * e] * u1[2 * e] + w0[2 * e] * u2[2 * e], yb = w2[2 * e + 1] * ub + w1[2 * e + 1] * u1[2 * e + 1] + w0[2 * e + 1] * u2[2 * e + 1];
            u2[2 * e] = u1[2 * e]; u2[2 * e + 1] = u1[2 * e + 1]; u1[2 * e] = ua; u1[2 * e + 1] = ub;
            ow[e] = cvtpk(bflo(bb[e]) * ya * silu(bflo(gg[e])), bfhi(bb[e]) * yb * silu(bfhi(gg[e])));
        }
        *(v4u*)(out + (size_t)k * BRW + 1024 + lane * 8) = (v4u){ow[0], ow[1], ow[2], ow[3]};
    }
}
__device__ __forceinline__ void conv_run(const Args& a, int layer, int item, int lane) {
    const bf16* PROJ = (const bf16*)(a.ws + WS_PROJ); const bf16* PM = (const bf16*)(a.ws + WS_PROJM);
    if (item < MH / CV_RUN) {
        const size_t r = (size_t)item * CV_RUN; const bf16* cur = PROJ + r * PW;
        const bool first = (item % (SEQ / CV_RUN)) == 0;
        conv_item(a, layer, cur, first ? PM + (size_t)127 * PW : cur - PW, first ? PM + (size_t)126 * PW : cur - 2 * (size_t)PW, (bf16*)(a.ws + WS_BR) + r * BRW, lane);
    } else {
        const int r = PADF + (item - MH / CV_RUN) * CV_RUN; const bf16* cur = PM + (size_t)r * PW;
        conv_item(a, layer, cur, cur - PW, cur - 2 * (size_t)PW, (bf16*)(a.ws + WS_BRM) + (size_t)r * BRW, lane);
    }
}
constexpr int RT_P = 272;
constexpr int RT_KP = 0, RT_VT = 128 * RT_P, RT_KZT = 2 * 128 * RT_P, RT_ST = 2 * 128 * RT_P, RT_STAT = 3 * 128 * RT_P, RT_END = RT_STAT + 2 * 128 * 8;
constexpr int KV_IMG = 128 * 128;

template <bool W_KP, bool W_KZT>
__device__ __forceinline__ void ret_stage_k(const bf16* cur, int cidx0, const float* rc, const float* rs, LAS unsigned char* lds, int hd, float l2g, int wave, int lane) {
    const int c = wave, jp = lane, j0 = 2 * jp;
    const bf16* p = cur + (size_t)j0 * PW + C_RK + hd * 128 + c * 8;
    const v4u a0 = *(const v4u*)p, a1 = *(const v4u*)(p + 64), b0 = *(const v4u*)(p + PW), b1 = *(const v4u*)(p + PW + 64);
    const int idx0 = cidx0 + j0;
    const f32x4 ca0 = *(const f32x4*)(rc + idx0 * 64 + c * 8), ca1 = *(const f32x4*)(rc + idx0 * 64 + c * 8 + 4), sa0 = *(const f32x4*)(rs + idx0 * 64 + c * 8), sa1 = *(const f32x4*)(rs + idx0 * 64 + c * 8 + 4);
    const f32x4 cb0 = *(const f32x4*)(rc + (idx0 + 1) * 64 + c * 8), cb1 = *(const f32x4*)(rc + (idx0 + 1) * 64 + c * 8 + 4), sb0 = *(const f32x4*)(rs + (idx0 + 1) * 64 + c * 8), sb1 = *(const f32x4*)(rs + (idx0 + 1) * 64 + c * 8 + 4);
    const unsigned A0[4] = {a0.x, a0.y, a0.z, a0.w}, A1[4] = {a1.x, a1.y, a1.z, a1.w}, B0[4] = {b0.x, b0.y, b0.z, b0.w}, B1[4] = {b1.x, b1.y, b1.z, b1.w};
    const float CA[8] = {ca0.x, ca0.y, ca0.z, ca0.w, ca1.x, ca1.y, ca1.z, ca1.w}, SA[8] = {sa0.x, sa0.y, sa0.z, sa0.w, sa1.x, sa1.y, sa1.z, sa1.w};
    const float CB[8] = {cb0.x, cb0.y, cb0.z, cb0.w, cb1.x, cb1.y, cb1.z, cb1.w}, SB[8] = {sb0.x, sb0.y, sb0.z, sb0.w, sb1.x, sb1.y, sb1.z, sb1.w};
    const float ksc = 0.08838834764831845f;
    float ra1[8], ra2[8], rb1[8], rb2[8];
#pragma unroll
    for (int e = 0; e < 8; ++e) {
        const float t1a = (e & 1) ? bfhi(A0[e >> 1]) : bflo(A0[e >> 1]), t2a = (e & 1) ? bfhi(A1[e >> 1]) : bflo(A1[e >> 1]);
        const float t1b = (e & 1) ? bfhi(B0[e >> 1]) : bflo(B0[e >> 1]), t2b = (e & 1) ? bfhi(B1[e >> 1]) : bflo(B1[e >> 1]);
        ra1[e] = (t1a * CA[e] - t2a * SA[e]) * ksc; ra2[e] = (t1a * SA[e] + t2a * CA[e]) * ksc;
        rb1[e] = (t1b * CB[e] - t2b * SB[e]) * ksc; rb2[e] = (t1b * SB[e] + t2b * CB[e]) * ksc;
    }
    if (W_KP) {
        v4u w;
        w.x = cvtpk(ra1[0], ra1[1]); w.y = cvtpk(ra1[2], ra1[3]); w.z = cvtpk(ra1[4], ra1[5]); w.w = cvtpk(ra1[6], ra1[7]); *(LAS v4u*)(lds + RT_KP + j0 * RT_P + (c * 8) * 2) = w;
        w.x = cvtpk(ra2[0], ra2[1]); w.y = cvtpk(ra2[2], ra2[3]); w.z = cvtpk(ra2[4], ra2[5]); w.w = cvtpk(ra2[6], ra2[7]); *(LAS v4u*)(lds + RT_KP + j0 * RT_P + (64 + c * 8) * 2) = w;
        w.x = cvtpk(rb1[0], rb1[1]); w.y = cvtpk(rb1[2], rb1[3]); w.z = cvtpk(rb1[4], rb1[5]); w.w = cvtpk(rb1[6], rb1[7]); *(LAS v4u*)(lds + RT_KP + (j0 + 1) * RT_P + (c * 8) * 2) = w;
        w.x = cvtpk(rb2[0], rb2[1]); w.y = cvtpk(rb2[2], rb2[3]); w.z = cvtpk(rb2[4], rb2[5]); w.w = cvtpk(rb2[6], rb2[7]); *(LAS v4u*)(lds + RT_KP + (j0 + 1) * RT_P + (64 + c * 8) * 2) = w;
    }
    if (W_KZT) {
        const float za = exp2f((float)(127 - j0) * l2g), zb = exp2f((float)(126 - j0) * l2g);
#pragma unroll
        for (int e = 0; e < 8; ++e) {
            *(LAS unsigned*)(lds + RT_KZT + (c * 8 + e) * RT_P + j0 * 2) = cvtpk(ra1[e] * za, rb1[e] * zb);
            *(LAS unsigned*)(lds + RT_KZT + (64 + c * 8 + e) * RT_P + j0 * 2) = cvtpk(ra2[e] * za, rb2[e] * zb);
        }
    }
}
__device__ __forceinline__ void ret_stage_vt(const bf16* cur, LAS unsigned char* lds, int hd, int wave, int lane) {
#pragma unroll
    for (int cc = 0; cc < 2; ++cc) {
        const int c = wave + 8 * cc, j0 = 2 * lane;
        const bf16* p = cur + (size_t)j0 * PW + C_RV + hd * 128 + c * 8;
        const v4u v0 = *(const v4u*)p, v1 = *(const v4u*)(p + PW);
        const unsigned e0[4] = {v0.x, v0.y, v0.z, v0.w}, e1[4] = {v1.x, v1.y, v1.z, v1.w};
#pragma unroll
        for (int k = 0; k < 4; ++k) {
            *(LAS unsigned*)(lds + RT_VT + (c * 8 + 2 * k) * RT_P + j0 * 2) = (e0[k] & 0xffffu) | (e1[k] << 16);
            *(LAS unsigned*)(lds + RT_VT + (c * 8 + 2 * k + 1) * RT_P + j0 * 2) = (e0[k] >> 16) | (e1[k] & 0xffff0000u);
        }
    }
}
__device__ __forceinline__ void ret_kv_unit(const Args& a, const Chunk ck, int hd, bf16* img, LAS unsigned char* lds, int tid) {
    asm volatile("" : "+v"(tid));
    const float* rc = (const float*)(a.ws + WS_ROT); const float* rs = rc + LP * 64;
    const int lane = tid & 63, wave = __builtin_amdgcn_readfirstlane(tid >> 6);
    const float l2g = log2f(1.0f - exp2f(-5.0f - (float)hd));
    const int it = wave & 3, eh = wave >> 2, q = lane & 31, h = lane >> 5;
    ret_stage_k<false, true>(ck.cur, ck.idx0, rc, rs, lds, hd, l2g, wave, lane);
    ret_stage_vt(ck.cur, lds, hd, wave, lane);
    __syncthreads();
#pragma unroll
    for (int eb = 0; eb < 2; ++eb) {
        const int et = 2 * eh + eb;
        f32x16 acc;
#pragma unroll
        for (int i = 0; i < 16; ++i) acc[i] = 0.f;
#pragma unroll
        for (int s8 = 0; s8 < 8; ++s8) {
            const bf16x8 kz = *(const LAS bf16x8*)(lds + RT_KZT + (32 * it + q) * RT_P + (16 * s8 + 8 * h) * 2);
            const bf16x8 vf = *(const LAS bf16x8*)(lds + RT_VT + (32 * et + q) * RT_P + (16 * s8 + 8 * h) * 2);
            acc = MFMA32(kz, vf, acc);
        }
        v4u w0, w1;
        w0.x = cvtpk(acc[0], acc[1]); w0.y = cvtpk(acc[2], acc[3]); w0.z = cvtpk(acc[4], acc[5]); w0.w = cvtpk(acc[6], acc[7]);
        w1.x = cvtpk(acc[8], acc[9]); w1.y = cvtpk(acc[10], acc[11]); w1.z = cvtpk(acc[12], acc[13]); w1.w = cvtpk(acc[14], acc[15]);
        v4u* op = (v4u*)(img + ((wave * 2 + eb) * 64 + lane) * 16);
        op[0] = w0; op[1] = w1;
    }
    __syncthreads();
}
__device__ __forceinline__ void ret_out_unit(const Args& a, const Chunk ck, int hd, const bf16* kv0, int nprev, const bf16* kvm, LAS unsigned char* lds, int tid) {
    asm volatile("" : "+v"(tid));
    const float* rc = (const float*)(a.ws + WS_ROT); const float* rs = rc + LP * 64;
    const int lane = tid & 63, wave = __builtin_amdgcn_readfirstlane(tid >> 6);
    const float l2g = log2f(1.0f - exp2f(-5.0f - (float)hd));
    const int it = wave & 3, eh = wave >> 2, q = lane & 31, h = lane >> 5;
    {
        f32x16 Sacc[2];
#pragma unroll
        for (int b = 0; b < 2; ++b)
#pragma unroll
            for (int i = 0; i < 16; ++i) Sacc[b][i] = 0.f;
        const int loff = (wave * 2 * 64 + lane) * 16;
        for (int m = (kvm ? -1 : 0); m < nprev; ++m) {
            const float w = exp2f(128.0f * (float)(nprev - 1 - m) * l2g);
            const v4u* ip = (const v4u*)((m < 0 ? kvm : kv0 + (size_t)m * KV_IMG) + loff);
            const v4u x0 = ip[0], x1 = ip[1], y0 = ip[64 * 2], y1 = ip[64 * 2 + 1];
            const unsigned X[8] = {x0.x, x0.y, x0.z, x0.w, x1.x, x1.y, x1.z, x1.w}, Y[8] = {y0.x, y0.y, y0.z, y0.w, y1.x, y1.y, y1.z, y1.w};
#pragma unroll
            for (int k = 0; k < 8; ++k) { Sacc[0][2 * k] += w * bflo(X[k]); Sacc[0][2 * k + 1] += w * bfhi(X[k]); Sacc[1][2 * k] += w * bflo(Y[k]); Sacc[1][2 * k + 1] += w * bfhi(Y[k]); }
        }
#pragma unroll
        for (int eb = 0; eb < 2; ++eb)
#pragma unroll
            for (int g4 = 0; g4 < 4; ++g4) {
                v2u w; w.x = cvtpk(Sacc[eb][4 * g4 + 0], Sacc[eb][4 * g4 + 1]); w.y = cvtpk(Sacc[eb][4 * g4 + 2], Sacc[eb][4 * g4 + 3]);
                *(LAS v2u*)(lds + RT_ST + (32 * (2 * eh + eb) + q) * RT_P + (32 * it + 8 * g4 + 4 * h) * 2) = w;
            }
    }
    ret_stage_k<true, false>(ck.cur, ck.idx0, rc, rs, lds, hd, l2g, wave, lane);
    ret_stage_vt(ck.cur, lds, hd, wave, lane);
    bf16x8 qf[8];
    {
        const int il = 32 * it + q, idx = ck.idx0 + il;
        const bf16* p = ck.cur + (size_t)il * PW + C_RQ + hd * 128;
#pragma unroll
        for (int ks = 0; ks < 4; ++ks) {
            const int d0 = 16 * ks + 8 * h;
            const v4u x1 = *(const v4u*)(p + d0), x2 = *(const v4u*)(p + 64 + d0);
            const f32x4 c0 = *(const f32x4*)(rc + idx * 64 + d0), c1 = *(const f32x4*)(rc + idx * 64 + d0 + 4), s0 = *(const f32x4*)(rs + idx * 64 + d0), s1 = *(const f32x4*)(rs + idx * 64 + d0 + 4);
            const unsigned X1[4] = {x1.x, x1.y, x1.z, x1.w}, X2[4] = {x2.x, x2.y, x2.z, x2.w};
            const float C[8] = {c0.x, c0.y, c0.z, c0.w, c1.x, c1.y, c1.z, c1.w}, S[8] = {s0.x, s0.y, s0.z, s0.w, s1.x, s1.y, s1.z, s1.w};
            float r1[8], r2[8];
#pragma unroll
            for (int e = 0; e < 8; ++e) { const float t1 = (e & 1) ? bfhi(X1[e >> 1]) : bflo(X1[e >> 1]), t2 = (e & 1) ? bfhi(X2[e >> 1]) : bflo(X2[e >> 1]); r1[e] = t1 * C[e] - t2 * S[e]; r2[e] = t1 * S[e] + t2 * C[e]; }
            qf[ks] = pack8(r1[0], r1[1], r1[2], r1[3], r1[4], r1[5], r1[6], r1[7]);
            qf[ks + 4] = pack8(r2[0], r2[1], r2[2], r2[3], r2[4], r2[5], r2[6], r2[7]);
        }
    }
    __syncthreads();
    bf16x8 tf[4][2];
#pragma unroll
    for (int jt = 0; jt < 4; ++jt) {
        if (jt <= it) {
            f32x16 acc;
#pragma unroll
            for (int i = 0; i < 16; ++i) acc[i] = 0.f;
#pragma unroll
            for (int ks = 0; ks < 8; ++ks) { const bf16x8 kf = *(const LAS bf16x8*)(lds + RT_KP + (32 * jt + q) * RT_P + (16 * ks + 8 * h) * 2); acc = MFMA32(kf, qf[ks], acc); }
#pragma unroll
            for (int reg = 0; reg < 16; ++reg) {
                const int diff = (32 * it + q) - (32 * jt + (reg & 3) + 8 * (reg >> 2) + 4 * h);
                acc[reg] = diff >= 0 ? acc[reg] * exp2f((float)diff * l2g) : 0.f;
            }
            tf[jt][0] = pack8(acc[0], acc[1], acc[2], acc[3], acc[4], acc[5], acc[6], acc[7]);
            tf[jt][1] = pack8(acc[8], acc[9], acc[10], acc[11], acc[12], acc[13], acc[14], acc[15]);
        }
    }
    const float xi = exp2f((float)(32 * it + q + 1) * l2g);
    f32x16 o[2];
#pragma unroll
    for (int eb = 0; eb < 2; ++eb) {
        const int et = 2 * eh + eb;
        f32x16 ain, ac;
#pragma unroll
        for (int i = 0; i < 16; ++i) { ain[i] = 0.f; ac[i] = 0.f; }
#pragma unroll
        for (int jt = 0; jt < 4; ++jt) {
            if (jt <= it) {
#pragma unroll
                for (int s2 = 0; s2 < 2; ++s2) {
                    const LAS unsigned char* vp = lds + RT_VT + (32 * et + q) * RT_P + (32 * jt + 16 * s2 + 4 * h) * 2;
                    ain = MFMA32(join2(*(const LAS v2u*)vp, *(const LAS v2u*)(vp + 16)), tf[jt][s2], ain);
                }
            }
        }
#pragma unroll
        for (int ks = 0; ks < 8; ++ks) { const bf16x8 sf = *(const LAS bf16x8*)(lds + RT_ST + (32 * et + q) * RT_P + (16 * ks + 8 * h) * 2); ac = MFMA32(sf, qf[ks], ac); }
#pragma unroll
        for (int i = 0; i < 16; ++i) o[eb][i] = ain[i] + xi * ac[i];
    }
    float sm = 0.f;
#pragma unroll
    for (int eb = 0; eb < 2; ++eb)
#pragma unroll
        for (int i = 0; i < 16; ++i) sm += o[eb][i];
    sm += __shfl_xor(sm, 32);
    const float mw = sm * (1.0f / 64.0f);
    float m2 = 0.f;
#pragma unroll
    for (int eb = 0; eb < 2; ++eb)
#pragma unroll
        for (int i = 0; i < 16; ++i) { const float dlt = o[eb][i] - mw; m2 += dlt * dlt; }
    m2 += __shfl_xor(m2, 32);
    if (h == 0) { LAS float* st = (LAS float*)(lds + RT_STAT) + (eh * 128 + 32 * it + q) * 2; st[0] = mw; st[1] = m2; }
    __syncthreads();
    {
        const LAS float* s0 = (const LAS float*)(lds + RT_STAT) + (0 * 128 + 32 * it + q) * 2; const LAS float* s1 = (const LAS float*)(lds + RT_STAT) + (1 * 128 + 32 * it + q) * 2;
        const float m0 = s0[0], q0 = s0[1], m1 = s1[0], q1 = s1[1];
        const float mean = 0.5f * (m0 + m1), dm = m0 - m1;
        const float var = (q0 + q1 + 32.0f * dm * dm) * (1.0f / 128.0f);
        const float rstd = 1.0f / sqrtf(var + GN_EPS);
        const bf16* grp = ck.cur + (size_t)(32 * it + q) * PW + C_RG + hd * 128; bf16* orp = ck.br + (size_t)(32 * it + q) * BRW + 512 + hd * 128;
#pragma unroll
        for (int eb = 0; eb < 2; ++eb)
#pragma unroll
            for (int g4 = 0; g4 < 4; ++g4) {
                const int e0 = 32 * (2 * eh + eb) + 8 * g4 + 4 * h;
                const v2u gw = *(const v2u*)(grp + e0);
                v2u w; w.x = cvtpk((o[eb][4 * g4 + 0] - mean) * rstd * silu(bflo(gw.x)), (o[eb][4 * g4 + 1] - mean) * rstd * silu(bfhi(gw.x)));
                w.y = cvtpk((o[eb][4 * g4 + 2] - mean) * rstd * silu(bflo(gw.y)), (o[eb][4 * g4 + 3] - mean) * rstd * silu(bfhi(gw.y)));
                *(v2u*)(orp + e0) = w;
            }
    }
    __syncthreads();
}
static_assert(AT_END <= LDSCTL_OFF && RT_END <= LDSCTL_OFF, "mixer LDS images fit below the control words");

#ifndef PROBE_RET
#define PROBE_RET 1
#endif
#ifndef PROBE_ATT
#define PROBE_ATT 1
#endif
#ifndef PROBE_CONV
#define PROBE_CONV 1
#endif
#ifndef PROBE_REP
#define PROBE_REP -1
#endif
#ifndef MK_PER_STEP
#define MK_PER_STEP 0
#endif
__device__ __forceinline__ void run_step(const Args& args, int s, LAS unsigned char* lds, int tid, int bid, int G) {
    const int lane = tid & 63, wave = __builtin_amdgcn_readfirstlane(tid >> 6);
    const int gw = bid * NWAVES + wave, NGW = G * NWAVES;
    if (s == 0) {
        p0_prologue(args, lds, tid, wave, lane);
    } else {
        const int q = s - 1, hl = q / NPH, ph = q - hl * NPH, half = hl >> 1, layer = hl & 1;
        bf16* KV = (bf16*)(args.ws + WS_KV); bf16* KVM = (bf16*)(args.ws + WS_KVM);
        if (ph == 0) {
            for (int nt = gw; nt < PW / 16; nt += NGW) meta_inproj_task(args, layer, nt, lane);
            pg8::Gemm g{(const pg8::bf16_t*)(args.ws + WS_XN), (const pg8::bf16_t*)(args.ws + WS_WIN + layer * WIN_BYTES), MH, PW, D};
            pg8::StaticOrder S; S.init(MH, PW, G, bid);
            pg8::EpiBf16 E{(pg8::bf16_t*)(args.ws + WS_PROJ), PW};
            pg8::gemm_phase<pg8::EpiBf16, pg8::StaticOrder, true, true>(lds + RING_OFF, g, S, E, tid);
        } else if (ph == 1) {
            const int NATT = HB * NCB * 2 + (layer == 0 ? 2 : 0), NKV = HB * 4 * NCB + 4, NCV = MH / CV_RUN + (layer == 0 ? 2 : 0);
            for (int rep = 0; rep < PROBE_ATT; ++rep) for (int u = bid; u < NATT; u += G) {
                if (u < HB * NCB * 2) attn_unit(args, layer, make_chunk(args.ws, u / (NCB * 2), (u % (NCB * 2)) >> 1), u & 1, lds, tid);
                else attn_unit(args, layer, make_chunk(args.ws, 0, -1), u & 1, lds, tid);
            }
            for (int rep = 0; rep < PROBE_RET; ++rep) for (int u = G - 1 - bid; u < NKV; u += G) {
                if (u < HB * 4 * NCB) { const int bh = u / NCB, c = u % NCB; ret_kv_unit(args, make_chunk(args.ws, bh >> 2, c), bh & 3, KV + (size_t)u * KV_IMG, lds, tid); }
                else { const int hd = u - HB * 4 * NCB; ret_kv_unit(args, make_chunk(args.ws, 0, -1), hd, KVM + (size_t)hd * KV_IMG, lds, tid); }
            }
            for (int rep = 0; rep < PROBE_CONV; ++rep) for (int it = gw; it < NCV; it += NGW) conv_run(args, layer, it, lane);
        } else if (ph == 2) {
            const int NOUT = HB * 4 * NCB + (layer == 0 ? 4 : 0);
            for (int rep = 0; rep < PROBE_RET; ++rep) for (int j = bid; j < NOUT; j += G) {
                if (j < HB * 4 * NCB) { const int c = NCB - 1 - j / (HB * 4), bh = j % (HB * 4); ret_out_unit(args, make_chunk(args.ws, bh >> 2, c), bh & 3, KV + (size_t)(bh * NCB) * KV_IMG, c, KVM + (size_t)(bh & 3) * KV_IMG, lds, tid); }
                else { const int hd = j - HB * 4 * NCB; ret_out_unit(args, make_chunk(args.ws, 0, -1), hd, KV, 0, nullptr, lds, tid); }
            }
        } else if (ph == 3) {
            if (layer == 0 && wave == 0 && bid < D / 16) meta_branch_task(args, layer, bid, lane);
            pg8::Gemm g{(const pg8::bf16_t*)(args.ws + WS_BR), (const pg8::bf16_t*)(args.ws + WS_WBR + layer * WBR_BYTES), MH, D, BRW};
            pg8::StaticOrder S; S.init(MH, D, G, bid);
            pg8::EpiGate E{(pg8::bf16_t*)(args.ws + WS_XN), D, (const pg8::bf16_t*)(args.ws + WS_PROJ) + C_MG};
            pg8::gemm_phase<pg8::EpiGate, pg8::StaticOrder, true, true>(lds + RING_OFF, g, S, E, tid);
        } else if (ph == 4) {
            if (layer == 0 && wave == 0 && bid < D / 16) meta_out_task(args, layer, bid, lane);
            pg8::Gemm g{(const pg8::bf16_t*)(args.ws + WS_XN), (const pg8::bf16_t*)(args.ws + WS_WOUT + layer * WOUT_BYTES), MH, D, D};
            pg8::StaticOrder S; S.init(MH, D, G, bid);
            pg8::EpiF32 E{(float*)(args.ws + WS_PROJ), D};
            pg8::gemm_phase<pg8::EpiF32, pg8::StaticOrder, true, true>(lds + RING_OFF, g, S, E, tid);
        } else {
            p5_norm_residual(args, half, layer, gw, NGW, lane);
            if (half == 0 && layer == 1) xn_from_input(args, 1, gw, NGW, lane);
        }
    }
}
typedef const __attribute__((address_space(4))) Args* KArgsPtr;
#if defined(__HIP_DEVICE_COMPILE__)
#define LOAD_ARGS(a) KArgsPtr a##_p = (KArgsPtr)__builtin_amdgcn_kernarg_segment_ptr(); asm volatile("" : "+s"(a##_p)); Args a; \
    _Pragma("unroll") for (int _i = 0; _i < 10; ++_i) a.in[_i] = a##_p->in[_i]; a.out = a##_p->out; a.ws = a##_p->ws; a.ph_lo = a##_p->ph_lo; a.ph_hi = a##_p->ph_hi
#else
#define LOAD_ARGS(a) const Args a = args
#endif

__global__ void __launch_bounds__(NTHR, 2) fwd_kernel(Args args) {
    extern __shared__ __attribute__((aligned(16))) unsigned char lds_raw[];
    LAS unsigned char* lds = (LAS unsigned char*)lds_raw;
    for (int u = threadIdx.x; u < (LDS_BYTES - LDSCTL_OFF) / 4; u += NTHR) ((LAS unsigned*)(lds + LDSCTL_OFF))[u] = 0u;
    __syncthreads();
    const int lo = args.ph_lo, hi = args.ph_hi;
#if MK_PER_STEP
    run_step(args, lo, lds, (int)threadIdx.x, (int)blockIdx.x, (int)gridDim.x);
#else
    (void)xcd_barrier_post((unsigned*)((gu32*)(args.ws + WS_CTL) + CW_BAR), (volatile LAS unsigned*)(lds + MISC_OFF) + 8);
#define GRID_BARRIER() do { LOAD_ARGS(b); XcdBarrier bar; bar.bar = (unsigned*)((gu32*)(b.ws + WS_CTL) + CW_BAR); bar.x = xb_xcc_id(); bar.st = (volatile LAS unsigned*)(lds + MISC_OFF) + 8; xcd_barrier(bar); } while (0)
    int s0 = lo;
    const int wave_s = __builtin_amdgcn_readfirstlane((int)threadIdx.x >> 6);
    if (s0 == 0) {
        { LOAD_ARGS(a); run_step(a, 0, lds, (int)threadIdx.x, (int)blockIdx.x, (int)gridDim.x); }
        if (hi > 1) GRID_BARRIER();
        s0 = 1;
    }
    for (int s = s0; s < hi; ++s) {
        LAS unsigned char* ldsq = lds; asm volatile("" : "+s"(ldsq));
        int bid = blockIdx.x, gsz = gridDim.x; asm volatile("" : "+s"(bid), "+s"(gsz));
        int tid; asm volatile("v_mbcnt_lo_u32_b32 %0, -1, 0\n\tv_mbcnt_hi_u32_b32 %0, -1, %0\n\tv_lshl_add_u32 %0, %1, 6, %0" : "=&v"(tid) : "s"(wave_s));
        int sq = s; asm volatile("" : "+s"(sq));
        if (sq == 0) continue;
        { LOAD_ARGS(a); run_step(a, sq, ldsq, tid, bid, gsz); }
#if PROBE_REP >= 0
        if ((sq - 1) % NPH == PROBE_REP) { GRID_BARRIER(); LOAD_ARGS(a); run_step(a, sq, ldsq, tid, bid, gsz); }
#endif
        if (s + 1 < hi) GRID_BARRIER();
    }
#endif
}

extern "C" void kernel_launch(void* const* d_in, const int* in_sizes, int n_in, void* d_out, int out_size, void* d_ws, size_t ws_size, hipStream_t stream) {
    static int grid = 0;
    if (grid == 0) {
        if (n_in != 10 || in_sizes[0] != BATCH * SEQ * D || out_size != BATCH * SEQ * D || ws_size < WS_END) { fprintf(stderr, "kernel_launch: unexpected shapes (n_in %d in0 %d out %d ws %zu)\n", n_in, n_in > 0 ? in_sizes[0] : -1, out_size, ws_size); grid = -1; return; }
        int dev = 0, cus = 0;
        if (hipGetDevice(&dev) != hipSuccess || hipDeviceGetAttribute(&cus, hipDeviceAttributeMultiprocessorCount, dev) != hipSuccess) { grid = -1; return; }
        if (hipFuncSetAttribute((const void*)fwd_kernel, hipFuncAttributeMaxDynamicSharedMemorySize, LDS_BYTES) != hipSuccess) { fprintf(stderr, "kernel_launch: hipFuncSetAttribute failed\n"); grid = -1; return; }
        (void)hipGetLastError();
        grid = cus;
    }
    if (grid < 0) return;
    if (hipMemsetAsync((char*)d_ws + WS_CTL, 0, CTL_ZERO_BYTES, stream) != hipSuccess) return;
    Args a{};
    for (int i = 0; i < 10; ++i) a.in[i] = (const float*)d_in[i];
    a.out = (float*)d_out; a.ws = (unsigned char*)d_ws;
#if MK_PER_STEP
    for (int s = 0; s < NSTEPS; ++s) { a.ph_lo = s; a.ph_hi = s + 1; hipLaunchKernelGGL(fwd_kernel, dim3(grid), dim3(NTHR), LDS_BYTES, stream, a); }
#else
    a.ph_lo = 0; a.ph_hi = NSTEPS; hipLaunchKernelGGL(fwd_kernel, dim3(grid), dim3(NTHR), LDS_BYTES, stream, a);
#endif
}
```

```cpp
#include <hip/hip_runtime.h>
#include <cstdio>
#include <cstdint>
#include <cmath>
namespace pg8 {
#define PG8_LAS __attribute__((address_space(3)))
typedef unsigned short bf16_t;
typedef short bf16x8 __attribute__((ext_vector_type(8)));
typedef float f32x4 __attribute__((ext_vector_type(4)));
typedef unsigned u32x4 __attribute__((ext_vector_type(4)));
constexpr int BM = 256, BK = 64, HALF = 128, HTB = HALF * BK * 2  , STAGE_BYTES = 8 * HTB, NXCD = 8, WGM = 8;

__host__ __device__ __forceinline__ int lds_byte(int r, int c) { const int st = (r >> 4) * 2 + (c >> 5), rr = r & 15, cc = c & 31, ob = rr * 64 + cc * 2; return st * 1024 + (ob ^ (((ob >> 9) & 1) << 5)); }
__host__ __device__ __forceinline__ void stage_rc(int b, int& R, int& C) { const int st = b / 1024, sb = b % 1024, swz = sb ^ (((sb >> 9) & 1) << 5); R = (st >> 1) * 16 + swz / 64; C = (st & 1) * 32 + (swz % 64) / 2; }
__host__ __device__ __forceinline__ int perm32(int rho) { const int n = rho >> 4, i = rho & 15; return 8 * (i >> 2) + 4 * n + (i & 3); }

struct Unit { int pm, pn; };
struct Gemm { const bf16_t* A; const bf16_t* Bt; int M, N, K; };

struct StaticOrder {
    int nM, nN, nwg, G, c;
    __host__ __device__ void init(int M, int N, int G_, int c_) { nM = M / BM; nN = N / BM; nwg = nM * nN; G = G_; c = c_; }
    __host__ __device__ bool next(int i, Unit& u) const {
        const long L = (long)i * G + c; if (L >= nwg) return false;
        int wgid = (int)L; { const int q = nwg / NXCD, r = nwg % NXCD, xcd = wgid % NXCD, off = wgid / NXCD; wgid = (xcd < r ? xcd * (q + 1) : r * (q + 1) + (xcd - r) * q) + off; }
        const int nig = WGM * nN, gid = wgid / nig, fm = gid * WGM, gsz = (nM - fm) < WGM ? (nM - fm) : WGM;
        u.pm = fm + ((wgid % nig) % gsz); u.pn = (wgid % nig) / gsz; return true;
    }
    __device__ __forceinline__ void a_ready(const Unit&) const {}
    __device__ __forceinline__ void done(const Unit&) const {}
};


typedef __bf16 bf16x2n __attribute__((ext_vector_type(2))); typedef float f32x2n __attribute__((ext_vector_type(2)));
__device__ __forceinline__ unsigned cvt_pk_bf16(float lo, float hi) { const f32x2n v = {lo, hi}; return __builtin_bit_cast(unsigned, __builtin_convertvector(v, bf16x2n)); }
__device__ __forceinline__ float bflo(unsigned w) { return __uint_as_float(w << 16); }
__device__ __forceinline__ float bfhi(unsigned w) { return __uint_as_float(w & 0xffff0000u); }

struct EpiF32 {
    static constexpr bool PERM = false, AFTER_DRAIN = false, MID = false;
    float* C; int ldc;
    __device__ __forceinline__ void operator()(const f32x4 (&acc)[2][2][4][2], const Unit& u, int wr, int wc, int fr, int fq) const {
        const int row0 = u.pm * BM + wr * 64 + fr, col0 = u.pn * BM + wc * 32 + 4 * fq;
#pragma unroll
        for (int ai = 0; ai < 2; ++ai)
#pragma unroll
            for (int m = 0; m < 4; ++m) { float* rowp = C + (size_t)(row0 + ai * HALF + m * 16) * ldc + col0;
#pragma unroll
                for (int bj = 0; bj < 2; ++bj)
#pragma unroll
                    for (int n = 0; n < 2; ++n) *(f32x4*)(rowp + bj * HALF + n * 16) = acc[ai][bj][m][n]; }
    }
};
struct EpiBf16 {
    static constexpr bool PERM = true, AFTER_DRAIN = false, MID = false;
    bf16_t* O; int ldc;
    __device__ __forceinline__ void operator()(const f32x4 (&acc)[2][2][4][2], const Unit& u, int wr, int wc, int fr, int fq) const {
        const int row0 = u.pm * BM + wr * 64 + fr; const int col0 = u.pn * BM + wc * 32 + 8 * fq;
#pragma unroll
        for (int ai = 0; ai < 2; ++ai)
#pragma unroll
            for (int m = 0; m < 4; ++m) { bf16_t* rowp = O + (size_t)(row0 + ai * HALF + m * 16) * ldc + col0;
#pragma unroll
                for (int bj = 0; bj < 2; ++bj) { const f32x4 v0 = acc[ai][bj][m][0], v1 = acc[ai][bj][m][1];
                    u32x4 w; w.x = cvt_pk_bf16(v0[0], v0[1]); w.y = cvt_pk_bf16(v0[2], v0[3]); w.z = cvt_pk_bf16(v1[0], v1[1]); w.w = cvt_pk_bf16(v1[2], v1[3]);
                    *(u32x4*)(rowp + bj * HALF) = w; } }
    }
};
struct EpiInProj {
    static constexpr bool PERM = true, AFTER_DRAIN = false, MID = false;
    static constexpr int NMIX = 21;
    bf16_t* O; int ldc; unsigned char* G; size_t gstride;
    __device__ __forceinline__ void operator()(const f32x4 (&acc)[2][2][4][2], const Unit& u, int wr, int wc, int fr, int fq) const {
        if (u.pn < NMIX) {
            const int row0 = u.pm * BM + wr * 64 + fr; const int col0 = u.pn * BM + wc * 32 + 8 * fq;
#pragma unroll
            for (int ai = 0; ai < 2; ++ai)
#pragma unroll
                for (int m = 0; m < 4; ++m) { bf16_t* rowp = O + (size_t)(row0 + ai * HALF + m * 16) * ldc + col0;
#pragma unroll
                    for (int bj = 0; bj < 2; ++bj) { const f32x4 v0 = acc[ai][bj][m][0], v1 = acc[ai][bj][m][1];
                        u32x4 w; w.x = cvt_pk_bf16(v0[0], v0[1]); w.y = cvt_pk_bf16(v0[2], v0[3]); w.z = cvt_pk_bf16(v1[0], v1[1]); w.w = cvt_pk_bf16(v1[2], v1[3]);
                        *(u32x4*)(rowp + bj * HALF) = w; } }
        } else {
            const int t = u.pn - NMIX, g = t >> 2, pc = t & 3;
            unsigned char* gp = G + (size_t)g * gstride + (size_t)((u.pm * 4 + pc) * 16) * 8192 + ((wr * 4 + wc) * 64 + fq * 16 + fr) * 16;
#pragma unroll
            for (int ai = 0; ai < 2; ++ai)
#pragma unroll
                for (int m = 0; m < 4; ++m)
#pragma unroll
                    for (int bj = 0; bj < 2; ++bj) { const f32x4 v0 = acc[ai][bj][m][0], v1 = acc[ai][bj][m][1];
                        float sg[8] = {v0[0], v0[1], v0[2], v0[3], v1[0], v1[1], v1[2], v1[3]};
#pragma unroll
                        for (int e = 0; e < 8; ++e) sg[e] = __builtin_amdgcn_rcpf(1.0f + __expf(-sg[e]));
                        u32x4 w; w.x = cvt_pk_bf16(sg[0], sg[1]); w.y = cvt_pk_bf16(sg[2], sg[3]); w.z = cvt_pk_bf16(sg[4], sg[5]); w.w = cvt_pk_bf16(sg[6], sg[7]);
                        *(u32x4*)(gp + ((ai * 4 + m) * 2 + bj) * 8192) = w; }
        }
    }
};
struct EpiGate {
    static constexpr bool PERM = true, AFTER_DRAIN = false, MID = true;
    bf16_t* O; int ldc; const unsigned char* G; size_t gstride;
    __device__ __forceinline__ void scale(f32x4 (&acc)[2][2][4][2], const Unit& u, int which, int wr, int wc, int fr, int fq) const {
        unsigned off0 = (unsigned)((u.pm * 4 + u.pn) * 16) * 8192u + (unsigned)(((wr * 4 + wc) * 64 + fq * 16 + fr) * 16);
        asm volatile("" : "+v"(off0));
        const unsigned char* ga = G + (size_t)(which == 3 ? 2 : which - 1) * gstride; const unsigned char* gb = ga + gstride;
#pragma unroll
        for (int kq = 0; kq < 4; ++kq) {
            u32x4 wa[4], wb[4];
#pragma unroll
            for (int j = 0; j < 4; ++j) { wa[j] = *(const u32x4*)(ga + off0 + (kq * 4 + j) * 8192); if (which != 3) wb[j] = *(const u32x4*)(gb + off0 + (kq * 4 + j) * 8192); }
#pragma unroll
            for (int j = 0; j < 4; ++j) {
                const int k = kq * 4 + j, ai = k >> 3, m = (k >> 1) & 3, bj = k & 1;
                const float a[8] = {bflo(wa[j].x), bfhi(wa[j].x), bflo(wa[j].y), bfhi(wa[j].y), bflo(wa[j].z), bfhi(wa[j].z), bflo(wa[j].w), bfhi(wa[j].w)};
                float f[8];
                if (which == 3) {
#pragma unroll
                    for (int e = 0; e < 8; ++e) f[e] = a[e];
                } else {
                    const float b[8] = {bflo(wb[j].x), bfhi(wb[j].x), bflo(wb[j].y), bfhi(wb[j].y), bflo(wb[j].z), bfhi(wb[j].z), bflo(wb[j].w), bfhi(wb[j].w)};
#pragma unroll
                    for (int e = 0; e < 8; ++e) f[e] = a[e] * __builtin_amdgcn_rcpf(b[e]);
                }
                f32x4 v0 = acc[ai][bj][m][0], v1 = acc[ai][bj][m][1];
                v0[0] *= f[0]; v0[1] *= f[1]; v0[2] *= f[2]; v0[3] *= f[3]; v1[0] *= f[4]; v1[1] *= f[5]; v1[2] *= f[6]; v1[3] *= f[7];
                acc[ai][bj][m][0] = v0; acc[ai][bj][m][1] = v1;
            }
            asm volatile("" ::: "memory");
        }
    }
    __device__ __forceinline__ void mid(f32x4 (&acc)[2][2][4][2], const Unit& u, int which, int wr, int wc, int fr, int fq) const { scale(acc, u, which, wr, wc, fr, fq); }
    __device__ __forceinline__ void operator()(f32x4 (&acc)[2][2][4][2], const Unit& u, int wr, int wc, int fr, int fq) const {
        scale(acc, u, 3, wr, wc, fr, fq);
        const int row0 = u.pm * BM + wr * 64 + fr; const int col0 = u.pn * BM + wc * 32 + 8 * fq;
#pragma unroll
        for (int ai = 0; ai < 2; ++ai)
#pragma unroll
            for (int m = 0; m < 4; ++m) { bf16_t* rowp = O + (size_t)(row0 + ai * HALF + m * 16) * ldc + col0;
#pragma unroll
                for (int bj = 0; bj < 2; ++bj) { const f32x4 v0 = acc[ai][bj][m][0], v1 = acc[ai][bj][m][1];
                    u32x4 w; w.x = cvt_pk_bf16(v0[0], v0[1]); w.y = cvt_pk_bf16(v0[2], v0[3]); w.z = cvt_pk_bf16(v1[0], v1[1]); w.w = cvt_pk_bf16(v1[2], v1[3]);
                    *(u32x4*)(rowp + bj * HALF) = w; } }
    }
};
template <class Epi, class Sched, bool ALIGN_EPI = false, bool SP2 = false>
__device__ __forceinline__ void gemm_phase(PG8_LAS unsigned char* lds, const Gemm g, const Sched& S, const Epi& E, const int tid) {
    const int wid = __builtin_amdgcn_readfirstlane(tid >> 6), lane = tid & 63, wr = wid >> 2, wc = wid & 3, fr = lane & 15, fq = lane >> 4;
    const int K = g.K, nt = K / BK;
    unsigned voffA[2], voffB[2];
#pragma unroll
    for (int i = 0; i < 2; ++i) { int R, C; stage_rc(tid * 16 + i * 8192, R, C); const int Rb = Epi::PERM ? ((R & ~31) + perm32(R & 31)) : R;
        voffA[i] = (unsigned)(R * K + C) * 2u; voffB[i] = (unsigned)(Rb * K + C) * 2u; }
    const size_t kstep = (size_t)(BK * 2);
    const size_t hstep = (size_t)HALF * K * 2;
    const size_t tstep = 2 * hstep;
    const unsigned ldsw = (unsigned)wid * 1024u;
    const int aoff = lds_byte(wr * 64 + fr, fq * 8), boff = lds_byte(wc * 32 + fr, fq * 8);
#define PG8_SA(b, h) (((b) * 2 + (h)) * HTB)
#define PG8_SB(b, h) ((4 + (b) * 2 + (h)) * HTB)
#define PG8_STAGE(bufoff, gbase, voff) do { _Pragma("unroll") for (int _i = 0; _i < 2; ++_i) \
        __builtin_amdgcn_global_load_lds((const unsigned*)((const char*)(gbase) + (voff)[_i]), (PG8_LAS unsigned*)(lds + (bufoff) + ldsw + _i * 8192), 16, 0, 0); } while (0)
#define PG8_LDA(dst, b, h) do { _Pragma("unroll") for (int m = 0; m < 4; ++m) _Pragma("unroll") for (int k = 0; k < 2; ++k) dst[m][k] = *(const PG8_LAS bf16x8*)(lds + PG8_SA(b, h) + aoff + m * 2048 + k * 1024); } while (0)
#define PG8_LDB(dst, b, h) do { _Pragma("unroll") for (int n = 0; n < 2; ++n) _Pragma("unroll") for (int k = 0; k < 2; ++k) dst[n][k] = *(const PG8_LAS bf16x8*)(lds + PG8_SB(b, h) + boff + n * 2048 + k * 1024); } while (0)
#define PG8_MMA(ai, bj, At, Bt) do { __builtin_amdgcn_s_setprio(1); _Pragma("unroll") for (int m = 0; m < 4; ++m) _Pragma("unroll") for (int n = 0; n < 2; ++n) _Pragma("unroll") for (int k = 0; k < 2; ++k) \
        acc[ai][bj][m][n] = __builtin_amdgcn_mfma_f32_16x16x32_bf16(Bt[n][k], At[m][k], acc[ai][bj][m][n], 0, 0, 0); __builtin_amdgcn_s_setprio(0); } while (0)
#define PG8_WAIT_V(n) asm volatile("s_waitcnt vmcnt(" #n ")" ::: "memory")
#define PG8_WAIT_L(n) asm volatile("s_waitcnt lgkmcnt(" #n ")" ::: "memory")
#define PG8_BAR __builtin_amdgcn_s_barrier()
#define PG8_SCHED __builtin_amdgcn_sched_barrier(0)
    Unit cur, nxt; int ui = 0;
    if (!S.next(0, cur)) return;
    f32x4 acc[2][2][4][2];
#pragma unroll
    for (int a = 0; a < 2; ++a)
#pragma unroll
        for (int b = 0; b < 2; ++b)
#pragma unroll
            for (int m = 0; m < 4; ++m)
#pragma unroll
                for (int n = 0; n < 2; ++n) acc[a][b][m][n] = (f32x4){0.f, 0.f, 0.f, 0.f};
    bf16x8 At[4][2], B0[2][2], B1[2][2];
    const char* cA = (const char*)g.A + (size_t)cur.pm * tstep; const char* cB = (const char*)g.Bt + (size_t)cur.pn * tstep;
    S.a_ready(cur);
    if constexpr (SP2) {
        PG8_STAGE(PG8_SB(0, 0), cB, voffB); PG8_STAGE(PG8_SB(0, 1), cB + hstep, voffB); PG8_STAGE(PG8_SA(0, 0), cA, voffA); PG8_STAGE(PG8_SA(0, 1), cA + hstep, voffA);
        if (wr == 1) PG8_BAR;
        PG8_WAIT_V(2); PG8_BAR;
        PG8_STAGE(PG8_SB(1, 0), cB + kstep, voffB); PG8_STAGE(PG8_SA(1, 0), cA + kstep, voffA); PG8_STAGE(PG8_SB(1, 1), cB + hstep + kstep, voffB);
        PG8_WAIT_V(6); PG8_BAR;
    } else {
        PG8_STAGE(PG8_SB(0, 0), cB, voffB); PG8_STAGE(PG8_SA(0, 0), cA, voffA); PG8_STAGE(PG8_SB(0, 1), cB + hstep, voffB); PG8_STAGE(PG8_SA(0, 1), cA + hstep, voffA);
        if (wr == 1) PG8_BAR;
        PG8_WAIT_V(4); PG8_BAR;
        PG8_STAGE(PG8_SB(1, 0), cB + kstep, voffB); PG8_STAGE(PG8_SA(1, 0), cA + kstep, voffA); PG8_STAGE(PG8_SB(1, 1), cB + hstep + kstep, voffB);
        PG8_WAIT_V(6); PG8_BAR;
    }
    for (;;) {
        const bool has_next = S.next(ui + 1, nxt);
        const char* nA = has_next ? (const char*)g.A + (size_t)nxt.pm * tstep : cA; const char* nB = has_next ? (const char*)g.Bt + (size_t)nxt.pn * tstep : cB;
        const int seg = Epi::MID ? 8 : nt;
        for (int t0 = 0; t0 < nt; t0 += seg) {
        for (int t = t0; t < t0 + seg; t += 2) {
            const bool last = (t == nt - 2);
            const char* a1 = cA + (size_t)(t + 1) * kstep;
            const char* a2 = last ? nA : cA + (size_t)(t + 2) * kstep; const char* b2 = last ? nB : cB + (size_t)(t + 2) * kstep;
            const char* a3 = a2 + kstep; const char* b3 = b2 + kstep;
            if (last && has_next) S.a_ready(nxt);
            if constexpr (SP2) {
            PG8_LDB(B0, 0, 0); PG8_LDB(B1, 0, 1); PG8_SCHED; PG8_LDA(At, 0, 0); PG8_STAGE(PG8_SA(1, 1), a1 + hstep, voffA);
            PG8_WAIT_V(8); PG8_WAIT_L(0); PG8_BAR; PG8_MMA(0, 0, At, B0); PG8_MMA(0, 1, At, B1); PG8_BAR; PG8_SCHED;
            PG8_LDA(At, 0, 1); PG8_STAGE(PG8_SB(0, 0), b2, voffB); PG8_STAGE(PG8_SB(0, 1), b2 + hstep, voffB); PG8_STAGE(PG8_SA(0, 0), a2, voffA);
            PG8_WAIT_V(8); PG8_WAIT_L(0); PG8_BAR; PG8_MMA(1, 0, At, B0); PG8_MMA(1, 1, At, B1); PG8_BAR; PG8_SCHED;
            PG8_LDB(B0, 1, 0); PG8_LDB(B1, 1, 1); PG8_SCHED; PG8_LDA(At, 1, 0); PG8_STAGE(PG8_SA(0, 1), a2 + hstep, voffA);
            PG8_WAIT_V(8); PG8_WAIT_L(0); PG8_BAR; PG8_MMA(0, 0, At, B0); PG8_MMA(0, 1, At, B1); PG8_BAR; PG8_SCHED;
            PG8_LDA(At, 1, 1); PG8_STAGE(PG8_SB(1, 0), b3, voffB); PG8_STAGE(PG8_SB(1, 1), b3 + hstep, voffB); PG8_STAGE(PG8_SA(1, 0), a3, voffA);
            PG8_WAIT_V(8); PG8_WAIT_L(0); PG8_BAR; PG8_MMA(1, 0, At, B0); PG8_MMA(1, 1, At, B1); PG8_BAR; PG8_SCHED;
            } else {
            PG8_LDB(B0, 0, 0); PG8_SCHED; PG8_LDA(At, 0, 0); PG8_STAGE(PG8_SA(1, 1), a1 + hstep, voffA);
            PG8_WAIT_L(8); PG8_BAR; PG8_WAIT_L(0); PG8_MMA(0, 0, At, B0); PG8_BAR; PG8_SCHED;
            PG8_LDB(B1, 0, 1); PG8_STAGE(PG8_SB(0, 0), b2, voffB);
            PG8_BAR; PG8_WAIT_L(0); PG8_MMA(0, 1, At, B1); PG8_BAR;
            PG8_LDA(At, 0, 1); PG8_STAGE(PG8_SA(0, 0), a2, voffA);
            PG8_BAR; PG8_WAIT_L(0); PG8_MMA(1, 0, At, B0); PG8_BAR; PG8_SCHED;
            PG8_STAGE(PG8_SB(0, 1), b2 + hstep, voffB);
            PG8_WAIT_V(6); PG8_BAR; PG8_MMA(1, 1, At, B1); PG8_BAR;
            PG8_LDB(B0, 1, 0); PG8_SCHED; PG8_LDA(At, 1, 0); PG8_STAGE(PG8_SA(0, 1), a2 + hstep, voffA);
            PG8_WAIT_L(8); PG8_BAR; PG8_WAIT_L(0); PG8_MMA(0, 0, At, B0); PG8_BAR; PG8_SCHED;
            PG8_LDB(B1, 1, 1); PG8_STAGE(PG8_SB(1, 0), b3, voffB);
            PG8_BAR; PG8_WAIT_L(0); PG8_MMA(0, 1, At, B1); PG8_BAR;
            PG8_LDA(At, 1, 1); PG8_STAGE(PG8_SA(1, 0), a3, voffA);
            PG8_BAR; PG8_WAIT_L(0); PG8_MMA(1, 0, At, B0); PG8_BAR; PG8_SCHED;
            PG8_STAGE(PG8_SB(1, 1), b3 + hstep, voffB);
            PG8_WAIT_V(6); PG8_BAR; PG8_MMA(1, 1, At, B1); PG8_BAR;
            }
        }
        if constexpr (Epi::MID) { if (t0 + seg < nt) E.mid(acc, cur, t0 / seg + 1, wr, wc, fr, fq); }
        }
        if constexpr (ALIGN_EPI) { if (wr == 0) PG8_BAR; }
        if constexpr (!Epi::AFTER_DRAIN) { E(acc, cur, wr, wc, fr, fq); S.done(cur); }
        if (!has_next) break;
#pragma unroll
        for (int a = 0; a < 2; ++a)
#pragma unroll
            for (int b = 0; b < 2; ++b)
#pragma unroll
                for (int m = 0; m < 4; ++m)
#pragma unroll
                    for (int n = 0; n < 2; ++n) acc[a][b][m][n] = (f32x4){0.f, 0.f, 0.f, 0.f};
        cur = nxt; cA = nA; cB = nB; ++ui;
        if constexpr (ALIGN_EPI) { if (wr == 1) PG8_BAR; }
    }
    PG8_WAIT_V(0);
    if constexpr (!ALIGN_EPI) { if (wr == 0) PG8_BAR; }
    PG8_BAR;
    if constexpr (Epi::AFTER_DRAIN) { E.fused(acc, cur, wr, wc, fr, fq, lds, wid, lane); S.done(cur); }
#undef PG8_SA
#undef PG8_SB
#undef PG8_STAGE
#undef PG8_LDA
#undef PG8_LDB
#undef PG8_MMA
#undef PG8_WAIT_V
#undef PG8_WAIT_L
#undef PG8_BAR
#undef PG8_SCHED
}
}


constexpr int NWAVES = 8, NTHR = 512;
constexpr int D = 1024, BATCH = 16, SEQ = 2048, BLK = 128, NMETA = 16, PADF = 112, LP = 2176;
constexpr int PW = 8448;
constexpr int PP = 5376;
constexpr int HB = 8, MH = HB * SEQ, NCB = SEQ / BLK;
constexpr int C_AQ = 0, C_AK = 512, C_AV = 640, C_AG = 768, C_RQ = 1280, C_RK = 1792, C_RV = 2304, C_RG = 2816, C_CB = 3328, C_CC = 3840, C_CX = 4352, C_CG = 4864, C_MG = 5376;
constexpr int BRW = 1536;
constexpr float RMS_EPS = 1e-6f, GN_EPS = 1e-6f;
constexpr int NPH = 6, NSTEPS = 1 + 4 * NPH;

constexpr size_t MiB = 1u << 20;
constexpr size_t WS_CTL = 0, CTL_ZERO_BYTES = 1 * MiB;
constexpr size_t WS_WIN = 1 * MiB, WIN_BYTES = (size_t)PW * D * 2;
constexpr size_t WS_WBR = 34 * MiB, WBR_BYTES = (size_t)D * BRW * 2;
constexpr size_t WS_WOUT = 40 * MiB, WOUT_BYTES = (size_t)D * D * 2;
constexpr size_t WS_ROT = 44 * MiB;
constexpr size_t WS_XN = 46 * MiB;
constexpr size_t WS_BR = 78 * MiB;
constexpr size_t WS_H = 126 * MiB;
constexpr size_t WS_PROJ = 190 * MiB;
constexpr size_t WS_GATE = 358 * MiB, GATE_G_BYTES = (size_t)MH * D * 2;
constexpr size_t WS_KV = 454 * MiB;
constexpr size_t WS_PROJM = 470 * MiB;
constexpr size_t WS_BRM = 473 * MiB;
constexpr size_t WS_MIXM = 474 * MiB, WS_YM = WS_MIXM + 64 * 1024, WS_XNM = WS_YM + 64 * 1024, WS_KVM = WS_XNM + 64 * 1024, WS_GM = WS_KVM + 128 * 1024;
constexpr size_t WS_END = 476 * MiB;
static_assert(WS_WIN + 2 * WIN_BYTES <= WS_WBR && WS_WBR + 2 * WBR_BYTES <= WS_WOUT && WS_WOUT + 2 * WOUT_BYTES <= WS_ROT && WS_ROT + (size_t)LP * 64 * 8 <= WS_XN, "ws map 1");
static_assert(WS_XN + (size_t)MH * D * 2 <= WS_BR && WS_BR + (size_t)MH * BRW * 2 <= WS_H && WS_H + (size_t)MH * D * 4 <= WS_PROJ && WS_PROJ + (size_t)MH * PP * 2 <= WS_GATE && WS_GATE + 3 * GATE_G_BYTES <= WS_KV && WS_KV + (size_t)HB * 4 * NCB * 32768 <= WS_PROJM, "ws map 2");
static_assert(WS_PROJM + (size_t)128 * PP * 2 <= WS_BRM && WS_BRM + (size_t)128 * BRW * 2 <= WS_MIXM && WS_GM + 16 * 3072 * 2 <= WS_END, "ws map 3");
constexpr int CW_TMO = 0, CW_CODE = 1, CW_BAR = 4096;

constexpr int RING_OFF = 0, RING_BYTES = 131072;
constexpr int LDS_BYTES = 147456;
constexpr int LDSCTL_OFF = LDS_BYTES - 1024, MISC_OFF = LDSCTL_OFF + 320;

#define GAS __attribute__((address_space(1)))
#define LAS __attribute__((address_space(3)))
typedef unsigned short bf16;
typedef unsigned v4u __attribute__((ext_vector_type(4)));
typedef unsigned v2u __attribute__((ext_vector_type(2)));
typedef float f32x4 __attribute__((ext_vector_type(4)));
typedef GAS unsigned gu32;
#define RLX_AGENT __ATOMIC_RELAXED, __HIP_MEMORY_SCOPE_AGENT
#define LDS_WAIT() asm volatile("s_waitcnt lgkmcnt(0)" ::: "memory")
#define VM_WAIT() asm volatile("s_waitcnt vmcnt(0)" ::: "memory")
__device__ __forceinline__ unsigned f2bf(float f) { unsigned u = __builtin_bit_cast(unsigned, f); return (u + 0x7fffu + ((u >> 16) & 1u)) >> 16; }
__device__ __forceinline__ unsigned pk2(float lo, float hi) { return f2bf(lo) | (f2bf(hi) << 16); }
__device__ __forceinline__ float bf2f(bf16 h) { return __uint_as_float((unsigned)h << 16); }
__device__ __forceinline__ float bflo(unsigned w) { return __uint_as_float(w << 16); }
__device__ __forceinline__ float bfhi(unsigned w) { return __uint_as_float(w & 0xffff0000u); }
__device__ __forceinline__ v4u zero4() { unsigned z = 0u; asm volatile("" : "+v"(z)); return (v4u){z, z, z, z}; }
__device__ __forceinline__ float silu(float g) { return g / (1.0f + __expf(-g)); }
__device__ __forceinline__ float wave_sum(float v) {
#pragma unroll
    for (int o = 1; o < 64; o <<= 1) v += __shfl_xor(v, o);
    return v;
}
__device__ __forceinline__ int t5_bucket(int n) {
    return n < 16 ? n : 16 + (n >= 19) + (n >= 21) + (n >= 24) + (n >= 27) + (n >= 31) + (n >= 35) + (n >= 40) + (n >= 46) + (n >= 52) + (n >= 59) + (n >= 67) + (n >= 77) + (n >= 87) + (n >= 99) + (n >= 113);
}

#define XB_TMO      128
#define XB_XCNT(j)  (256  + 64 * (j))
#define XB_XSUB(j)  (1280 + 64 * (j))
#define XB_XGEN(j)  (2304 + 64 * (j))
#define XB_TOP      3328
#define XB_TOPGEN   3392
#define XCD_BAR_WORDS 3456
#define XB_SPIN_CAP (1u << 18)

__device__ __forceinline__ unsigned xb_ld(unsigned* p)              { return __hip_atomic_load(p, __ATOMIC_RELAXED, __HIP_MEMORY_SCOPE_AGENT); }
__device__ __forceinline__ unsigned xb_add(unsigned* p, unsigned v) { return __hip_atomic_fetch_add(p, v, __ATOMIC_RELAXED, __HIP_MEMORY_SCOPE_AGENT); }
__device__ __forceinline__ unsigned xb_xcc_id() { return (unsigned)__builtin_amdgcn_s_getreg((3 << 11) | 20) & 0xFu; }
#define XB_SPIN(cond, bar) do { unsigned _sp = 0; while (cond) { __builtin_amdgcn_s_sleep(1); \
    if ((++_sp & 255u) == 0u) { if (xb_ld(&(bar)[XB_TMO])) break; if (_sp > XB_SPIN_CAP) { atomicAdd(&(bar)[XB_TMO], 1u); break; } } } } while (0)

struct XcdBarrier {
    unsigned* bar; unsigned x;
    volatile LAS unsigned* st;
};

__device__ __forceinline__ XcdBarrier xcd_barrier_post(unsigned* bar, volatile LAS unsigned* st) {
    XcdBarrier b; b.bar = bar; b.x = xb_xcc_id(); b.st = st;
    if (threadIdx.x == 0) (void)xb_add(&bar[XB_XCNT(b.x)], 1u);
    return b;
}
__device__ __forceinline__ void xcd_barrier_complete(unsigned* bar, unsigned x, unsigned& nloc, unsigned& nx) {
    const unsigned G = gridDim.x * gridDim.y * gridDim.z;
    unsigned sum, cnt, mine, sp = 0u;
    for (;;) {
        sum = 0u; cnt = 0u; mine = 0u;
#pragma unroll
        for (unsigned j = 0; j < 16; ++j) { const unsigned c = xb_ld(&bar[XB_XCNT(j)]); sum += c; cnt += (c > 0u) ? 1u : 0u; mine = (j == x) ? c : mine; }
        if (sum == G) break;
        __builtin_amdgcn_s_sleep(1);
        if ((++sp & 255u) == 0u) { if (xb_ld(&bar[XB_TMO])) break; if (sp > XB_SPIN_CAP) { atomicAdd(&bar[XB_TMO], 1u); break; } }
    }
    nloc = mine > 0u ? mine : 1u; nx = cnt > 0u ? cnt : 1u;
}

__device__ __forceinline__ void xcd_barrier(const XcdBarrier& b) {
    asm volatile("s_waitcnt vmcnt(0)" ::: "memory");
    __syncthreads();
    if (threadIdx.x == 0) {
        unsigned* bar = b.bar;
        __builtin_amdgcn_s_waitcnt(0);
        unsigned nloc = b.st[0], nx = b.st[1];
        if (nloc == 0u) { xcd_barrier_complete(bar, b.x, nloc, nx); b.st[0] = nloc; b.st[1] = nx; }
        const unsigned old = xb_add(&bar[XB_XSUB(b.x)], 1u);
        const unsigned gen = old / nloc;
        if (old + 1u == (gen + 1u) * nloc) {
            __builtin_amdgcn_fence(__ATOMIC_RELEASE, "agent");
            asm volatile("s_waitcnt vmcnt(0)" ::: "memory");
            const unsigned og = xb_add(&bar[XB_TOP], 1u);
            const unsigned tg = og / nx;
            if (og + 1u == (tg + 1u) * nx) xb_add(&bar[XB_TOPGEN], 1u);
            else XB_SPIN(xb_ld(&bar[XB_TOPGEN]) == tg, bar);
            __builtin_amdgcn_fence(__ATOMIC_ACQUIRE, "agent");
            xb_add(&bar[XB_XGEN(b.x)], 1u);
            asm volatile("s_waitcnt vmcnt(0)" ::: "memory");
        } else {
            XB_SPIN(xb_ld(&bar[XB_XGEN(b.x)]) == gen, bar);
            __builtin_amdgcn_fence(__ATOMIC_ACQUIRE, "agent");
            asm volatile("s_waitcnt vmcnt(0)" ::: "memory");
        }
    }
    __syncthreads();
}


struct Args { const float* in[10]; float* out; unsigned char* ws; int ph_lo, ph_hi; };

__device__ __forceinline__ void p0_transpose_item(const float* W, int K, int N, bf16* WT, int ldt, int koff, LAS float* scr, int item, int lane) {
    const int nblk = N / 32, kb = item / nblk, nb = item % nblk, k0 = 64 * kb, n0 = 32 * nb;
#pragma unroll 8
    for (int i = 0; i < 32; ++i) { const int kk = 2 * i + (lane >> 5); scr[kk * 33 + (lane & 31)] = W[(size_t)(k0 + kk) * N + n0 + (lane & 31)]; }
    LDS_WAIT(); asm volatile("" ::: "memory");
    const int c = lane & 7;
#pragma unroll
    for (int j = 0; j < 4; ++j) { const int n = (lane >> 3) + 8 * j; const LAS float* s = scr + (8 * c) * 33 + n;
        v4u o; o.x = pk2(s[0 * 33], s[1 * 33]); o.y = pk2(s[2 * 33], s[3 * 33]); o.z = pk2(s[4 * 33], s[5 * 33]); o.w = pk2(s[6 * 33], s[7 * 33]);
        *(GAS v4u*)(WT + (size_t)(n0 + n) * ldt + koff + k0 + 8 * c) = o; }
    LDS_WAIT(); asm volatile("" ::: "memory");
}

__device__ __forceinline__ void rms_row_to_bf16(const f32x4 (&v)[4], const float* g, bf16* orow, int lane) {
    float s2 = 0.f;
#pragma unroll
    for (int j = 0; j < 4; ++j) s2 += (v[j].x * v[j].x + v[j].y * v[j].y) + (v[j].z * v[j].z + v[j].w * v[j].w);
    const float rstd = 1.0f / sqrtf(wave_sum(s2) * (1.f / D) + RMS_EPS);
    GAS v2u* o8 = (GAS v2u*)orow + lane;
#pragma unroll
    for (int j = 0; j < 4; ++j) { const f32x4 gg = ((const f32x4*)g)[lane + 64 * j]; v2u w; w.x = pk2(v[j].x * rstd * gg.x, v[j].y * rstd * gg.y); w.y = pk2(v[j].z * rstd * gg.z, v[j].w * rstd * gg.w); o8[64 * j] = w; }
}
__device__ __forceinline__ void xn_from_input(const Args& a, int half, int gw, int NGW, int lane) {
    bf16* XN = (bf16*)(a.ws + WS_XN);
    for (int r = gw; r < MH + NMETA; r += NGW) {
        const float* src = r < MH ? a.in[0] + ((size_t)half * MH + r) * D : a.in[1] + (size_t)(r - MH) * D;
        bf16* orow = r < MH ? XN + (size_t)r * D : (bf16*)(a.ws + WS_XNM) + (size_t)(r - MH) * D;
        f32x4 v[4];
#pragma unroll
        for (int j = 0; j < 4; ++j) v[j] = ((const f32x4*)src)[lane + 64 * j];
        rms_row_to_bf16(v, a.in[3], orow, lane);
    }
}

__device__ __forceinline__ void p0_prologue(const Args& a, LAS unsigned char* lds, int tid, int wave, int lane) {
    LAS float* scr = (LAS float*)(lds + RING_OFF + wave * 16384);
    const int gw = blockIdx.x * NWAVES + wave, NGW = gridDim.x * NWAVES;
    constexpr int I_IN = (D / 64) * (PW / 32), I_BR = (512 / 64) * (D / 32), I_OUT = (D / 64) * (D / 32);
    constexpr int PER_LAYER = I_IN + 3 * I_BR + I_OUT, NITEMS = 2 * PER_LAYER;
    for (int it = gw; it < NITEMS; it += NGW) {
        const int l = it / PER_LAYER; int r = it - l * PER_LAYER;
        if (r < I_IN) { p0_transpose_item(a.in[4] + (size_t)l * D * PW, D, PW, (bf16*)(a.ws + WS_WIN + l * WIN_BYTES), D, 0, scr, r, lane); continue; } r -= I_IN;
        if (r < 3 * I_BR) { const int g = r / I_BR; p0_transpose_item(a.in[7] + ((size_t)l * 3 + g) * 512 * D, 512, D, (bf16*)(a.ws + WS_WBR + l * WBR_BYTES), BRW, g * 512, scr, r - g * I_BR, lane); continue; } r -= 3 * I_BR;
        p0_transpose_item(a.in[8] + (size_t)l * D * D, D, D, (bf16*)(a.ws + WS_WOUT + l * WOUT_BYTES), D, 0, scr, r, lane);
    }
    float* rc = (float*)(a.ws + WS_ROT); float* rs = rc + LP * 64;
    for (int e = (blockIdx.x * NTHR + tid); e < LP * 64; e += gridDim.x * NTHR) {
        const int idx = e >> 6, i = e & 63;
        const float lin = (float)i / 63.0f;
        const float theta = (float)(1.0 / pow(10000.0, (double)lin));
        const float ang = (float)(idx - PADF) * theta;
        rc[e] = (float)cos((double)ang); rs[e] = (float)sin((double)ang);
    }
    { v4u* pz = (v4u*)(a.ws + WS_PROJM); const v4u z4 = zero4(); for (int i = blockIdx.x * NTHR + tid; i < PADF * PP * 2 / 16; i += gridDim.x * NTHR) pz[i] = z4; }
    xn_from_input(a, 0, gw, NGW, lane);
}

__device__ __forceinline__ void p5_norm_residual(const Args& a, int half, int layer, int gw, int NGW, int lane) {
    const float* Y = (const float*)(a.ws + WS_PROJ); float* H = (float*)(a.ws + WS_H); bf16* XN = (bf16*)(a.ws + WS_XN);
    const float* gpost = a.in[9] + layer * D;
    const int nrows = layer == 0 ? MH + NMETA : MH;
    for (int r = gw; r < nrows; r += NGW) {
        const bool meta = r >= MH;
        const float* ysrc = meta ? (const float*)(a.ws + WS_YM) + (size_t)(r - MH) * D : Y + (size_t)r * D;
        const float* hsrc = meta ? a.in[1] + (size_t)(r - MH) * D : (layer == 0 ? a.in[0] + ((size_t)half * MH + r) * D : H + (size_t)r * D);
        f32x4 y[4], h[4]; float s2 = 0.f;
#pragma unroll
        for (int j = 0; j < 4; ++j) { y[j] = ((const f32x4*)ysrc)[lane + 64 * j]; h[j] = ((const f32x4*)hsrc)[lane + 64 * j]; s2 += (y[j].x * y[j].x + y[j].y * y[j].y) + (y[j].z * y[j].z + y[j].w * y[j].w); }
        const float rstd = 1.0f / sqrtf(wave_sum(s2) * (1.f / D) + RMS_EPS);
#pragma unroll
        for (int j = 0; j < 4; ++j) { const f32x4 gg = ((const f32x4*)gpost)[lane + 64 * j];
            h[j].x += y[j].x * rstd * gg.x; h[j].y += y[j].y * rstd * gg.y; h[j].z += y[j].z * rstd * gg.z; h[j].w += y[j].w * rstd * gg.w; }
        if (layer == 0) {
            if (!meta) {
#pragma unroll
                for (int j = 0; j < 4; ++j) ((f32x4*)(H + (size_t)r * D))[lane + 64 * j] = h[j];
            }
            rms_row_to_bf16(h, a.in[3] + D, meta ? (bf16*)(a.ws + WS_XNM) + (size_t)(r - MH) * D : XN + (size_t)r * D, lane);
        } else {
            float* orow = a.out + ((size_t)half * MH + r) * D;
#pragma unroll
            for (int j = 0; j < 4; ++j) ((f32x4*)orow)[lane + 64 * j] = h[j];
        }
    }
}

typedef short bf16x8m __attribute__((ext_vector_type(8)));
#define MFMA16(a, b, c) __builtin_amdgcn_mfma_f32_16x16x32_bf16((a), (b), (c), 0, 0, 0)
__device__ __forceinline__ f32x4 small16_dot(const bf16* A, int lda, const bf16* Bt, int ldb, int K, int lane) {
    const bf16* ap = A + (size_t)(lane & 15) * lda + 8 * (lane >> 4); const bf16* bp = Bt + (size_t)(lane & 15) * ldb + 8 * (lane >> 4);
    f32x4 acc = (f32x4){0.f, 0.f, 0.f, 0.f};
    for (int ks = 0; ks < K / 32; ++ks) acc = MFMA16(*(const bf16x8m*)(ap + 32 * ks), *(const bf16x8m*)(bp + 32 * ks), acc);
    return acc;
}
__device__ __forceinline__ void meta_inproj_task(const Args& a, int layer, int nt, int lane) {
    const f32x4 acc = small16_dot((const bf16*)(a.ws + WS_XNM), D, (const bf16*)(a.ws + WS_WIN + layer * WIN_BYTES) + (size_t)(16 * nt) * D, D, D, lane);
    const int col = 16 * nt + (lane & 15);
    bf16* o = col < PP ? (bf16*)(a.ws + WS_PROJM) + (size_t)(PADF + 4 * (lane >> 4)) * PP + col : (bf16*)(a.ws + WS_GM) + (size_t)(4 * (lane >> 4)) * 3072 + (col - PP);
    const size_t ld = col < PP ? PP : 3072;
#pragma unroll
    for (int r = 0; r < 4; ++r) o[(size_t)r * ld] = (bf16)f2bf(acc[r]);
}
__device__ __forceinline__ void meta_branch_task(const Args& a, int layer, int nt, int lane) {
    const bf16* GM = (const bf16*)(a.ws + WS_GM); const bf16* BM = (const bf16*)(a.ws + WS_BRM) + (size_t)PADF * BRW;
    const bf16* W = (const bf16*)(a.ws + WS_WBR + layer * WBR_BYTES) + (size_t)(16 * nt) * BRW;
    float o[4] = {0.f, 0.f, 0.f, 0.f};
#pragma unroll
    for (int g = 0; g < 3; ++g) {
        const f32x4 acc = small16_dot(BM + g * 512, BRW, W + g * 512, BRW, 512, lane);
#pragma unroll
        for (int r = 0; r < 4; ++r) { const float mg = bf2f(GM[(size_t)(4 * (lane >> 4) + r) * 3072 + g * 1024 + 16 * nt + (lane & 15)]); o[r] += acc[r] / (1.0f + __expf(-mg)); }
    }
    bf16* op = (bf16*)(a.ws + WS_MIXM) + (size_t)(4 * (lane >> 4)) * D + 16 * nt + (lane & 15);
#pragma unroll
    for (int r = 0; r < 4; ++r) op[(size_t)r * D] = (bf16)f2bf(o[r]);
}
__device__ __forceinline__ void meta_out_task(const Args& a, int layer, int nt, int lane) {
    const f32x4 acc = small16_dot((const bf16*)(a.ws + WS_MIXM), D, (const bf16*)(a.ws + WS_WOUT + layer * WOUT_BYTES) + (size_t)(16 * nt) * D, D, D, lane);
    float* o = (float*)(a.ws + WS_YM) + (size_t)(4 * (lane >> 4)) * D + 16 * nt + (lane & 15);
#pragma unroll
    for (int r = 0; r < 4; ++r) o[(size_t)r * D] = acc[r];
}

struct Chunk { const bf16* cur; const bf16* prev; bf16* br; int cur_from, prev_from, idx0; };
__device__ __forceinline__ Chunk make_chunk(unsigned char* ws, int bl, int c) {
    Chunk k;
    const bf16* PROJ = (const bf16*)(ws + WS_PROJ); const bf16* PM = (const bf16*)(ws + WS_PROJM);
    if (c < 0) { k.cur = PM; k.prev = nullptr; k.br = (bf16*)(ws + WS_BRM); k.cur_from = PADF; k.prev_from = BLK; k.idx0 = 0; }
    else { const size_t r0 = (size_t)bl * SEQ + (size_t)c * BLK; k.cur = PROJ + r0 * PP; k.prev = c > 0 ? k.cur - (size_t)BLK * PP : PM; k.br = (bf16*)(ws + WS_BR) + r0 * BRW; k.cur_from = 0; k.prev_from = c > 0 ? 0 : PADF; k.idx0 = BLK + c * BLK; }
    return k;
}
typedef float f32x16 __attribute__((ext_vector_type(16)));
typedef short bf16x8 __attribute__((ext_vector_type(8)));
#define MFMA32(a, b, c) __builtin_amdgcn_mfma_f32_32x32x16_bf16((a), (b), (c), 0, 0, 0)
__device__ __forceinline__ unsigned cvtpk(float lo, float hi) { return pg8::cvt_pk_bf16(lo, hi); }
__device__ __forceinline__ bf16x8 pack8(float a0, float a1, float a2, float a3, float a4, float a5, float a6, float a7) {
    v4u w; w.x = cvtpk(a0, a1); w.y = cvtpk(a2, a3); w.z = cvtpk(a4, a5); w.w = cvtpk(a6, a7); return __builtin_bit_cast(bf16x8, w);
}
__device__ __forceinline__ bf16x8 join2(v2u lo, v2u hi) { v4u w; w.x = lo.x; w.y = lo.y; w.z = hi.x; w.w = hi.y; return __builtin_bit_cast(bf16x8, w); }

constexpr int AT_KP = 144, AT_VP = 520;
constexpr int AT_K_OFF = 0, AT_VT_OFF = 256 * AT_KP, AT_BIAS_OFF = AT_VT_OFF + 64 * AT_VP, AT_END = AT_BIAS_OFF + 4 * 128 * 4;
__device__ __forceinline__ void attn_unit(const Args& a, int layer, const Chunk ck, int hk, LAS unsigned char* lds, int tid) {
    asm volatile("" : "+v"(tid));
    const int lane = tid & 63, wave = __builtin_amdgcn_readfirstlane(tid >> 6);
#pragma unroll
    for (int k4 = 0; k4 < 4; ++k4) {
        const int it = tid + k4 * NTHR, c = it >> 3, ch = it & 7; v4u v = zero4();
        if (c >= BLK) v = *(const v4u*)(ck.cur + (size_t)(c - BLK) * PP + C_AK + hk * 64 + ch * 8);
        else if (ck.prev) v = *(const v4u*)(ck.prev + (size_t)c * PP + C_AK + hk * 64 + ch * 8);
        *(LAS v4u*)(lds + AT_K_OFF + c * AT_KP + ch * 16) = v;
    }
#pragma unroll
    for (int k2 = 0; k2 < 2; ++k2) {
        const int it = tid + k2 * NTHR, ch = it >> 7, i = it & 127, c0 = 2 * i; v4u v0 = zero4(), v1 = v0;
        if (c0 >= BLK || ck.prev) { const bf16* p = (c0 >= BLK ? ck.cur + (size_t)(c0 - BLK) * PP : ck.prev + (size_t)c0 * PP) + C_AV + hk * 64 + ch * 8; v0 = *(const v4u*)p; v1 = *(const v4u*)(p + PP); }
        const unsigned e0[4] = {v0.x, v0.y, v0.z, v0.w}, e1[4] = {v1.x, v1.y, v1.z, v1.w};
#pragma unroll
        for (int k = 0; k < 4; ++k) {
            const unsigned lo = (e0[k] & 0xffffu) | (e1[k] << 16), hi = (e0[k] >> 16) | (e1[k] & 0xffff0000u);
            *(LAS unsigned*)(lds + AT_VT_OFF + (ch * 8 + 2 * k) * AT_VP + c0 * 2) = lo;
            *(LAS unsigned*)(lds + AT_VT_OFF + (ch * 8 + 2 * k + 1) * AT_VP + c0 * 2) = hi;
        }
    }
    { const int g = tid >> 7, dist = tid & 127; ((LAS float*)(lds + AT_BIAS_OFF))[tid] = a.in[2][t5_bucket(dist) * 8 + hk * 4 + g]; }
    __syncthreads();
    const int g = wave & 3, qh = wave >> 2, hq = hk * 4 + g, q = lane & 31, h = lane >> 5;
    const float sink = a.in[6][layer * 8 + hq];
    const LAS float* biasd = (const LAS float*)(lds + AT_BIAS_OFF) + g * 128;
    for (int qb2 = 0; qb2 < 2; ++qb2) {
        const int r0 = 64 * qh + 32 * qb2;
        const bf16* qrow = ck.cur + (size_t)(r0 + q) * PP;
        bf16x8 qf[4];
#pragma unroll
        for (int ks = 0; ks < 4; ++ks) qf[ks] = *(const bf16x8*)(qrow + C_AQ + hq * 64 + 16 * ks + 8 * h);
        f32x16 sc[5];
#pragma unroll
        for (int t = 0; t < 5; ++t) {
            f32x16 acc;
#pragma unroll
            for (int i = 0; i < 16; ++i) acc[i] = 0.f;
#pragma unroll
            for (int ks = 0; ks < 4; ++ks) { const bf16x8 kf = *(const LAS bf16x8*)(lds + AT_K_OFF + (r0 + 32 * t + q) * AT_KP + (16 * ks + 8 * h) * 2); acc = MFMA32(kf, qf[ks], acc); }
            sc[t] = acc;
        }
        float mloc = -1e30f;
#pragma unroll
        for (int t = 0; t < 5; ++t)
#pragma unroll
            for (int reg = 0; reg < 16; ++reg) {
                const int kk = (reg & 3) + 8 * (reg >> 2) + 4 * h, dist = 128 + q - 32 * t - kk, c = r0 + 32 * t + kk;
                const bool ok = (dist >= 0) && (dist < 128) && (c >= BLK ? c - BLK >= ck.cur_from : c >= ck.prev_from);
                const float s = ok ? sc[t][reg] * 0.125f + biasd[dist & 127] : -1e30f;
                sc[t][reg] = s; mloc = fmaxf(mloc, s);
            }
        const float m = fmaxf(fmaxf(mloc, __shfl_xor(mloc, 32)), sink);
        float lloc = 0.f;
#pragma unroll
        for (int t = 0; t < 5; ++t)
#pragma unroll
            for (int reg = 0; reg < 16; ++reg) { const float p = __expf(sc[t][reg] - m); sc[t][reg] = p; lloc += p; }
        const float inv = 1.0f / (lloc + __shfl_xor(lloc, 32) + __expf(sink - m));
        f32x16 o[2];
#pragma unroll
        for (int db = 0; db < 2; ++db)
#pragma unroll
            for (int i = 0; i < 16; ++i) o[db][i] = 0.f;
#pragma unroll
        for (int t = 0; t < 5; ++t)
#pragma unroll
            for (int s2 = 0; s2 < 2; ++s2) {
                const bf16x8 pf = pack8(sc[t][8 * s2 + 0], sc[t][8 * s2 + 1], sc[t][8 * s2 + 2], sc[t][8 * s2 + 3], sc[t][8 * s2 + 4], sc[t][8 * s2 + 5], sc[t][8 * s2 + 6], sc[t][8 * s2 + 7]);
                const int keyb = r0 + 32 * t + 16 * s2 + 4 * h;
#pragma unroll
                for (int db = 0; db < 2; ++db) {
                    const LAS unsigned char* vp = lds + AT_VT_OFF + (32 * db + q) * AT_VP + keyb * 2;
                    const bf16x8 vf = join2(*(const LAS v2u*)vp, *(const LAS v2u*)(vp + 16));
                    o[db] = MFMA32(vf, pf, o[db]);
                }
            }
        const bf16* grp = qrow + C_AG + hq * 64; bf16* orp = ck.br + (size_t)(r0 + q) * BRW + hq * 64;
#pragma unroll
        for (int db = 0; db < 2; ++db)
#pragma unroll
            for (int g4 = 0; g4 < 4; ++g4) {
                const int d0 = 32 * db + 8 * g4 + 4 * h;
                const v2u gw = *(const v2u*)(grp + d0);
                v2u w; w.x = cvtpk(o[db][4 * g4 + 0] * inv * silu(bflo(gw.x)), o[db][4 * g4 + 1] * inv * silu(bfhi(gw.x)));
                w.y = cvtpk(o[db][4 * g4 + 2] * inv * silu(bflo(gw.y)), o[db][4 * g4 + 3] * inv * silu(bfhi(gw.y)));
                *(v2u*)(orp + d0) = w;
            }
    }
    __syncthreads();
}

constexpr int CV_RUN = 8;
__device__ __forceinline__ void conv_item(const Args& a, int layer, const bf16* cur, const bf16* p1, const bf16* p2, bf16* out, int lane) {
    asm volatile("" : "+v"(lane));
    const float* cw = a.in[5] + layer * 3 * 512 + lane * 8;
    float w0[8], w1[8], w2[8];
#pragma unroll
    for (int e = 0; e < 8; ++e) { w0[e] = cw[e]; w1[e] = cw[512 + e]; w2[e] = cw[1024 + e]; }
    float u1[8], u2[8];
#pragma unroll
    for (int k = 2; k >= 1; --k) {
        const bf16* p = (k == 2 ? p2 : p1) + lane * 8;
        const v4u c = *(const v4u*)(p + C_CC), x = *(const v4u*)(p + C_CX);
        const unsigned cc[4] = {c.x, c.y, c.z, c.w}, xx[4] = {x.x, x.y, x.z, x.w};
#pragma unroll
        for (int e = 0; e < 4; ++e) { const float ua = bflo(cc[e]) * bflo(xx[e]), ub = bfhi(cc[e]) * bfhi(xx[e]); if (k == 2) { u2[2 * e] = ua; u2[2 * e + 1] = ub; } else { u1[2 * e] = ua; u1[2 * e + 1] = ub; } }
    }
    for (int k = 0; k < CV_RUN; ++k) {
        const bf16* p = cur + (size_t)k * PP + lane * 8;
        const v4u c = *(const v4u*)(p + C_CC), x = *(const v4u*)(p + C_CX), b = *(const v4u*)(p + C_CB), gt = *(const v4u*)(p + C_CG);
        const unsigned cc[4] = {c.x, c.y, c.z, c.w}, xx[4] = {x.x, x.y, x.z, x.w}, bb[4] = {b.x, b.y, b.z, b.w}, gg[4] = {gt.x, gt.y, gt.z, gt.w};
        unsigned ow[4];
#pragma unroll
        for (int e = 0; e < 4; ++e) {
            const float ua = bflo(cc[e]) * bflo(xx[e]), ub = bfhi(cc[e]) * bfhi(xx[e]);
            const float ya = w2[2 * e] * ua + w1[2 * e] * u1[2 * e] + w0[2 * e] * u2[2 * e], yb = w2[2 * e + 1] * ub + w1[2 * e + 1] * u1[2 * e + 1] + w0[2 * e + 1] * u2[2 * e + 1];
            u2[2 * e] = u1[2 * e]; u2[2 * e + 1] = u1[2 * e + 1]; u1[2 * e] = ua; u1[2 * e + 1] = ub;
            ow[e] = cvtpk(bflo(bb[e]) * ya * silu(bflo(gg[e])), bfhi(bb[e]) * yb * silu(bfhi(gg[e])));
        }
        *(v4u*)(out + (size_t)k * BRW + 1024 + lane * 8) = (v4u){ow[0], ow[1], ow[2], ow[3]};
    }
}
__device__ __forceinline__ void conv_run(const Args& a, int layer, int item, int lane) {
    const bf16* PROJ = (const bf16*)(a.ws + WS_PROJ); const bf16* PM = (const bf16*)(a.ws + WS_PROJM);
    if (item < MH / CV_RUN) {
        const size_t r = (size_t)item * CV_RUN; const bf16* cur = PROJ + r * PP;
        const bool first = (item % (SEQ / CV_RUN)) == 0;
        conv_item(a, layer, cur, first ? PM + (size_t)127 * PP : cur - PP, first ? PM + (size_t)126 * PP : cur - 2 * (size_t)PP, (bf16*)(a.ws + WS_BR) + r * BRW, lane);
    } else {
        const int r = PADF + (item - MH / CV_RUN) * CV_RUN; const bf16* cur = PM + (size_t)r * PP;
        conv_item(a, layer, cur, cur - PP, cur - 2 * (size_t)PP, (bf16*)(a.ws + WS_BRM) + (size_t)r * BRW, lane);
    }
}
constexpr int RT_P = 272;
constexpr int RT_KP = 0, RT_VT = 128 * RT_P, RT_KZT = 2 * 128 * RT_P, RT_ST = 2 * 128 * RT_P, RT_STAT = 3 * 128 * RT_P, RT_END = RT_STAT + 2 * 128 * 8;
constexpr int KV_IMG = 128 * 128;

template <bool W_KP, bool W_KZT>
__device__ __forceinline__ void ret_stage_k(const bf16* cur, int cidx0, const float* rc, const float* rs, LAS unsigned char* lds, int hd, float l2g, int wave, int lane) {
    const int c = wave, jp = lane, j0 = 2 * jp;
    const bf16* p = cur + (size_t)j0 * PP + C_RK + hd * 128 + c * 8;
    const v4u a0 = *(const v4u*)p, a1 = *(const v4u*)(p + 64), b0 = *(const v4u*)(p + PP), b1 = *(const v4u*)(p + PP + 64);
    const int idx0 = cidx0 + j0;
    const f32x4 ca0 = *(const f32x4*)(rc + idx0 * 64 + c * 8), ca1 = *(const f32x4*)(rc + idx0 * 64 + c * 8 + 4), sa0 = *(const f32x4*)(rs + idx0 * 64 + c * 8), sa1 = *(const f32x4*)(rs + idx0 * 64 + c * 8 + 4);
    const f32x4 cb0 = *(const f32x4*)(rc + (idx0 + 1) * 64 + c * 8), cb1 = *(const f32x4*)(rc + (idx0 + 1) * 64 + c * 8 + 4), sb0 = *(const f32x4*)(rs + (idx0 + 1) * 64 + c * 8), sb1 = *(const f32x4*)(rs + (idx0 + 1) * 64 + c * 8 + 4);
    const unsigned A0[4] = {a0.x, a0.y, a0.z, a0.w}, A1[4] = {a1.x, a1.y, a1.z, a1.w}, B0[4] = {b0.x, b0.y, b0.z, b0.w}, B1[4] = {b1.x, b1.y, b1.z, b1.w};
    const float CA[8] = {ca0.x, ca0.y, ca0.z, ca0.w, ca1.x, ca1.y, ca1.z, ca1.w}, SA[8] = {sa0.x, sa0.y, sa0.z, sa0.w, sa1.x, sa1.y, sa1.z, sa1.w};
    const float CB[8] = {cb0.x, cb0.y, cb0.z, cb0.w, cb1.x, cb1.y, cb1.z, cb1.w}, SB[8] = {sb0.x, sb0.y, sb0.z, sb0.w, sb1.x, sb1.y, sb1.z, sb1.w};
    const float ksc = 0.08838834764831845f;
    float ra1[8], ra2[8], rb1[8], rb2[8];
#pragma unroll
    for (int e = 0; e < 8; ++e) {
        const float t1a = (e & 1) ? bfhi(A0[e >> 1]) : bflo(A0[e >> 1]), t2a = (e & 1) ? bfhi(A1[e >> 1]) : bflo(A1[e >> 1]);
        const float t1b = (e & 1) ? bfhi(B0[e >> 1]) : bflo(B0[e >> 1]), t2b = (e & 1) ? bfhi(B1[e >> 1]) : bflo(B1[e >> 1]);
        ra1[e] = (t1a * CA[e] - t2a * SA[e]) * ksc; ra2[e] = (t1a * SA[e] + t2a * CA[e]) * ksc;
        rb1[e] = (t1b * CB[e] - t2b * SB[e]) * ksc; rb2[e] = (t1b * SB[e] + t2b * CB[e]) * ksc;
    }
    if (W_KP) {
        v4u w;
        w.x = cvtpk(ra1[0], ra1[1]); w.y = cvtpk(ra1[2], ra1[3]); w.z = cvtpk(ra1[4], ra1[5]); w.w = cvtpk(ra1[6], ra1[7]); *(LAS v4u*)(lds + RT_KP + j0 * RT_P + (c * 8) * 2) = w;
        w.x = cvtpk(ra2[0], ra2[1]); w.y = cvtpk(ra2[2], ra2[3]); w.z = cvtpk(ra2[4], ra2[5]); w.w = cvtpk(ra2[6], ra2[7]); *(LAS v4u*)(lds + RT_KP + j0 * RT_P + (64 + c * 8) * 2) = w;
        w.x = cvtpk(rb1[0], rb1[1]); w.y = cvtpk(rb1[2], rb1[3]); w.z = cvtpk(rb1[4], rb1[5]); w.w = cvtpk(rb1[6], rb1[7]); *(LAS v4u*)(lds + RT_KP + (j0 + 1) * RT_P + (c * 8) * 2) = w;
        w.x = cvtpk(rb2[0], rb2[1]); w.y = cvtpk(rb2[2], rb2[3]); w.z = cvtpk(rb2[4], rb2[5]); w.w = cvtpk(rb2[6], rb2[7]); *(LAS v4u*)(lds + RT_KP + (j0 + 1) * RT_P + (64 + c * 8) * 2) = w;
    }
    if (W_KZT) {
        const float za = exp2f((float)(127 - j0) * l2g), zb = exp2f((float)(126 - j0) * l2g);
#pragma unroll
        for (int e = 0; e < 8; ++e) {
            *(LAS unsigned*)(lds + RT_KZT + (c * 8 + e) * RT_P + j0 * 2) = cvtpk(ra1[e] * za, rb1[e] * zb);
            *(LAS unsigned*)(lds + RT_KZT + (64 + c * 8 + e) * RT_P + j0 * 2) = cvtpk(ra2[e] * za, rb2[e] * zb);
        }
    }
}
__device__ __forceinline__ void ret_stage_vt(const bf16* cur, LAS unsigned char* lds, int hd, int wave, int lane) {
#pragma unroll
    for (int cc = 0; cc < 2; ++cc) {
        const int c = wave + 8 * cc, j0 = 2 * lane;
        const bf16* p = cur + (size_t)j0 * PP + C_RV + hd * 128 + c * 8;
        const v4u v0 = *(const v4u*)p, v1 = *(const v4u*)(p + PP);
        const unsigned e0[4] = {v0.x, v0.y, v0.z, v0.w}, e1[4] = {v1.x, v1.y, v1.z, v1.w};
#pragma unroll
        for (int k = 0; k < 4; ++k) {
            *(LAS unsigned*)(lds + RT_VT + (c * 8 + 2 * k) * RT_P + j0 * 2) = (e0[k] & 0xffffu) | (e1[k] << 16);
            *(LAS unsigned*)(lds + RT_VT + (c * 8 + 2 * k + 1) * RT_P + j0 * 2) = (e0[k] >> 16) | (e1[k] & 0xffff0000u);
        }
    }
}
__device__ __forceinline__ void ret_kv_unit(const Args& a, const Chunk ck, int hd, bf16* img, LAS unsigned char* lds, int tid) {
    asm volatile("" : "+v"(tid));
    const float* rc = (const float*)(a.ws + WS_ROT); const float* rs = rc + LP * 64;
    const int lane = tid & 63, wave = __builtin_amdgcn_readfirstlane(tid >> 6);
    const float l2g = log2f(1.0f - exp2f(-5.0f - (float)hd));
    const int it = wave & 3, eh = wave >> 2, q = lane & 31, h = lane >> 5;
    ret_stage_k<false, true>(ck.cur, ck.idx0, rc, rs, lds, hd, l2g, wave, lane);
    ret_stage_vt(ck.cur, lds, hd, wave, lane);
    __syncthreads();
#pragma unroll
    for (int eb = 0; eb < 2; ++eb) {
        const int et = 2 * eh + eb;
        f32x16 acc;
#pragma unroll
        for (int i = 0; i < 16; ++i) acc[i] = 0.f;
#pragma unroll
        for (int s8 = 0; s8 < 8; ++s8) {
            const bf16x8 kz = *(const LAS bf16x8*)(lds + RT_KZT + (32 * it + q) * RT_P + (16 * s8 + 8 * h) * 2);
            const bf16x8 vf = *(const LAS bf16x8*)(lds + RT_VT + (32 * et + q) * RT_P + (16 * s8 + 8 * h) * 2);
            acc = MFMA32(kz, vf, acc);
        }
        v4u w0, w1;
        w0.x = cvtpk(acc[0], acc[1]); w0.y = cvtpk(acc[2], acc[3]); w0.z = cvtpk(acc[4], acc[5]); w0.w = cvtpk(acc[6], acc[7]);
        w1.x = cvtpk(acc[8], acc[9]); w1.y = cvtpk(acc[10], acc[11]); w1.z = cvtpk(acc[12], acc[13]); w1.w = cvtpk(acc[14], acc[15]);
        v4u* op = (v4u*)(img + ((wave * 2 + eb) * 64 + lane) * 16);
        op[0] = w0; op[1] = w1;
    }
    __syncthreads();
}
__device__ __forceinline__ void ret_out_unit(const Args& a, const Chunk ck, int hd, const bf16* kv0, int nprev, const bf16* kvm, LAS unsigned char* lds, int tid) {
    asm volatile("" : "+v"(tid));
    const float* rc = (const float*)(a.ws + WS_ROT); const float* rs = rc + LP * 64;
    const int lane = tid & 63, wave = __builtin_amdgcn_readfirstlane(tid >> 6);
    const float l2g = log2f(1.0f - exp2f(-5.0f - (float)hd));
    const int it = wave & 3, eh = wave >> 2, q = lane & 31, h = lane >> 5;
    {
        f32x16 Sacc[2];
#pragma unroll
        for (int b = 0; b < 2; ++b)
#pragma unroll
            for (int i = 0; i < 16; ++i) Sacc[b][i] = 0.f;
        const int loff = (wave * 2 * 64 + lane) * 16;
        for (int m = (kvm ? -1 : 0); m < nprev; ++m) {
            const float w = exp2f(128.0f * (float)(nprev - 1 - m) * l2g);
            const v4u* ip = (const v4u*)((m < 0 ? kvm : kv0 + (size_t)m * KV_IMG) + loff);
            const v4u x0 = ip[0], x1 = ip[1], y0 = ip[64 * 2], y1 = ip[64 * 2 + 1];
            const unsigned X[8] = {x0.x, x0.y, x0.z, x0.w, x1.x, x1.y, x1.z, x1.w}, Y[8] = {y0.x, y0.y, y0.z, y0.w, y1.x, y1.y, y1.z, y1.w};
#pragma unroll
            for (int k = 0; k < 8; ++k) { Sacc[0][2 * k] += w * bflo(X[k]); Sacc[0][2 * k + 1] += w * bfhi(X[k]); Sacc[1][2 * k] += w * bflo(Y[k]); Sacc[1][2 * k + 1] += w * bfhi(Y[k]); }
        }
#pragma unroll
        for (int eb = 0; eb < 2; ++eb)
#pragma unroll
            for (int g4 = 0; g4 < 4; ++g4) {
                v2u w; w.x = cvtpk(Sacc[eb][4 * g4 + 0], Sacc[eb][4 * g4 + 1]); w.y = cvtpk(Sacc[eb][4 * g4 + 2], Sacc[eb][4 * g4 + 3]);
                *(LAS v2u*)(lds + RT_ST + (32 * (2 * eh + eb) + q) * RT_P + (32 * it + 8 * g4 + 4 * h) * 2) = w;
            }
    }
    ret_stage_k<true, false>(ck.cur, ck.idx0, rc, rs, lds, hd, l2g, wave, lane);
    ret_stage_vt(ck.cur, lds, hd, wave, lane);
    bf16x8 qf[8];
    {
        const int il = 32 * it + q, idx = ck.idx0 + il;
        const bf16* p = ck.cur + (size_t)il * PP + C_RQ + hd * 128;
#pragma unroll
        for (int ks = 0; ks < 4; ++ks) {
            const int d0 = 16 * ks + 8 * h;
            const v4u x1 = *(const v4u*)(p + d0), x2 = *(const v4u*)(p + 64 + d0);
            const f32x4 c0 = *(const f32x4*)(rc + idx * 64 + d0), c1 = *(const f32x4*)(rc + idx * 64 + d0 + 4), s0 = *(const f32x4*)(rs + idx * 64 + d0), s1 = *(const f32x4*)(rs + idx * 64 + d0 + 4);
            const unsigned X1[4] = {x1.x, x1.y, x1.z, x1.w}, X2[4] = {x2.x, x2.y, x2.z, x2.w};
            const float C[8] = {c0.x, c0.y, c0.z, c0.w, c1.x, c1.y, c1.z, c1.w}, S[8] = {s0.x, s0.y, s0.z, s0.w, s1.x, s1.y, s1.z, s1.w};
            float r1[8], r2[8];
#pragma unroll
            for (int e = 0; e < 8; ++e) { const float t1 = (e & 1) ? bfhi(X1[e >> 1]) : bflo(X1[e >> 1]), t2 = (e & 1) ? bfhi(X2[e >> 1]) : bflo(X2[e >> 1]); r1[e] = t1 * C[e] - t2 * S[e]; r2[e] = t1 * S[e] + t2 * C[e]; }
            qf[ks] = pack8(r1[0], r1[1], r1[2], r1[3], r1[4], r1[5], r1[6], r1[7]);
            qf[ks + 4] = pack8(r2[0], r2[1], r2[2], r2[3], r2[4], r2[5], r2[6], r2[7]);
        }
    }
    __syncthreads();
    bf16x8 tf[4][2];
#pragma unroll
    for (int jt = 0; jt < 4; ++jt) {
        if (jt <= it) {
            f32x16 acc;
#pragma unroll
            for (int i = 0; i < 16; ++i) acc[i] = 0.f;
#pragma unroll
            for (int ks = 0; ks < 8; ++ks) { const bf16x8 kf = *(const LAS bf16x8*)(lds + RT_KP + (32 * jt + q) * RT_P + (16 * ks + 8 * h) * 2); acc = MFMA32(kf, qf[ks], acc); }
#pragma unroll
            for (int reg = 0; reg < 16; ++reg) {
                const int diff = (32 * it + q) - (32 * jt + (reg & 3) + 8 * (reg >> 2) + 4 * h);
                acc[reg] = diff >= 0 ? acc[reg] * exp2f((float)diff * l2g) : 0.f;
            }
            tf[jt][0] = pack8(acc[0], acc[1], acc[2], acc[3], acc[4], acc[5], acc[6], acc[7]);
            tf[jt][1] = pack8(acc[8], acc[9], acc[10], acc[11], acc[12], acc[13], acc[14], acc[15]);
        }
    }
    const float xi = exp2f((float)(32 * it + q + 1) * l2g);
    f32x16 o[2];
#pragma unroll
    for (int eb = 0; eb < 2; ++eb) {
        const int et = 2 * eh + eb;
        f32x16 ain, ac;
#pragma unroll
        for (int i = 0; i < 16; ++i) { ain[i] = 0.f; ac[i] = 0.f; }
#pragma unroll
        for (int jt = 0; jt < 4; ++jt) {
            if (jt <= it) {
#pragma unroll
                for (int s2 = 0; s2 < 2; ++s2) {
                    const LAS unsigned char* vp = lds + RT_VT + (32 * et + q) * RT_P + (32 * jt + 16 * s2 + 4 * h) * 2;
                    ain = MFMA32(join2(*(const LAS v2u*)vp, *(const LAS v2u*)(vp + 16)), tf[jt][s2], ain);
                }
            }
        }
#pragma unroll
        for (int ks = 0; ks < 8; ++ks) { const bf16x8 sf = *(const LAS bf16x8*)(lds + RT_ST + (32 * et + q) * RT_P + (16 * ks + 8 * h) * 2); ac = MFMA32(sf, qf[ks], ac); }
#pragma unroll
        for (int i = 0; i < 16; ++i) o[eb][i] = ain[i] + xi * ac[i];
    }
    float sm = 0.f;
#pragma unroll
    for (int eb = 0; eb < 2; ++eb)
#pragma unroll
        for (int i = 0; i < 16; ++i) sm += o[eb][i];
    sm += __shfl_xor(sm, 32);
    const float mw = sm * (1.0f / 64.0f);
    float m2 = 0.f;
#pragma unroll
    for (int eb = 0; eb < 2; ++eb)
#pragma unroll
        for (int i = 0; i < 16; ++i) { const float dlt = o[eb][i] - mw; m2 += dlt * dlt; }
    m2 += __shfl_xor(m2, 32);
    if (h == 0) { LAS float* st = (LAS float*)(lds + RT_STAT) + (eh * 128 + 32 * it + q) * 2; st[0] = mw; st[1] = m2; }
    __syncthreads();
    {
        const LAS float* s0 = (const LAS float*)(lds + RT_STAT) + (0 * 128 + 32 * it + q) * 2; const LAS float* s1 = (const LAS float*)(lds + RT_STAT) + (1 * 128 + 32 * it + q) * 2;
        const float m0 = s0[0], q0 = s0[1], m1 = s1[0], q1 = s1[1];
        const float mean = 0.5f * (m0 + m1), dm = m0 - m1;
        const float var = (q0 + q1 + 32.0f * dm * dm) * (1.0f / 128.0f);
        const float rstd = 1.0f / sqrtf(var + GN_EPS);
        const bf16* grp = ck.cur + (size_t)(32 * it + q) * PP + C_RG + hd * 128; bf16* orp = ck.br + (size_t)(32 * it + q) * BRW + 512 + hd * 128;
#pragma unroll
        for (int eb = 0; eb < 2; ++eb)
#pragma unroll
            for (int g4 = 0; g4 < 4; ++g4) {
                const int e0 = 32 * (2 * eh + eb) + 8 * g4 + 4 * h;
                const v2u gw = *(const v2u*)(grp + e0);
                v2u w; w.x = cvtpk((o[eb][4 * g4 + 0] - mean) * rstd * silu(bflo(gw.x)), (o[eb][4 * g4 + 1] - mean) * rstd * silu(bfhi(gw.x)));
                w.y = cvtpk((o[eb][4 * g4 + 2] - mean) * rstd * silu(bflo(gw.y)), (o[eb][4 * g4 + 3] - mean) * rstd * silu(bfhi(gw.y)));
                *(v2u*)(orp + e0) = w;
            }
    }
    __syncthreads();
}
static_assert(AT_END <= LDSCTL_OFF && RT_END <= LDSCTL_OFF, "mixer LDS images fit below the control words");

#ifndef PROBE_RET
#define PROBE_RET 1
#endif
#ifndef PROBE_ATT
#define PROBE_ATT 1
#endif
#ifndef PROBE_CONV
#define PROBE_CONV 1
#endif
#ifndef PROBE_REP
#define PROBE_REP -1
#endif
#ifndef MK_PER_STEP
#define MK_PER_STEP 0
#endif
__device__ __forceinline__ void run_step(const Args& args, int s, LAS unsigned char* lds, int tid, int bid, int G) {
    const int lane = tid & 63, wave = __builtin_amdgcn_readfirstlane(tid >> 6);
    const int gw = bid * NWAVES + wave, NGW = G * NWAVES;
    if (s == 0) {
        p0_prologue(args, lds, tid, wave, lane);
    } else {
        const int q = s - 1, hl = q / NPH, ph = q - hl * NPH, half = hl >> 1, layer = hl & 1;
        bf16* KV = (bf16*)(args.ws + WS_KV); bf16* KVM = (bf16*)(args.ws + WS_KVM);
        if (ph == 0) {
            for (int nt = gw; nt < PW / 16; nt += NGW) meta_inproj_task(args, layer, nt, lane);
            pg8::Gemm g{(const pg8::bf16_t*)(args.ws + WS_XN), (const pg8::bf16_t*)(args.ws + WS_WIN + layer * WIN_BYTES), MH, PW, D};
            pg8::StaticOrder S; S.init(MH, PW, G, bid);
            pg8::EpiInProj E{(pg8::bf16_t*)(args.ws + WS_PROJ), PP, args.ws + WS_GATE, GATE_G_BYTES};
            pg8::gemm_phase<pg8::EpiInProj, pg8::StaticOrder, true, true>(lds + RING_OFF, g, S, E, tid);
        } else if (ph == 1) {
            const int NATT = HB * NCB * 2 + (layer == 0 ? 2 : 0), NKV = HB * 4 * NCB + 4, NCV = MH / CV_RUN + (layer == 0 ? 2 : 0);
            for (int rep = 0; rep < PROBE_ATT; ++rep) for (int u = bid; u < NATT; u += G) {
                if (u < HB * NCB * 2) attn_unit(args, layer, make_chunk(args.ws, u / (NCB * 2), (u % (NCB * 2)) >> 1), u & 1, lds, tid);
                else attn_unit(args, layer, make_chunk(args.ws, 0, -1), u & 1, lds, tid);
            }
            for (int rep = 0; rep < PROBE_RET; ++rep) for (int u = G - 1 - bid; u < NKV; u += G) {
                if (u < HB * 4 * NCB) { const int bh = u / NCB, c = u % NCB; ret_kv_unit(args, make_chunk(args.ws, bh >> 2, c), bh & 3, KV + (size_t)u * KV_IMG, lds, tid); }
                else { const int hd = u - HB * 4 * NCB; ret_kv_unit(args, make_chunk(args.ws, 0, -1), hd, KVM + (size_t)hd * KV_IMG, lds, tid); }
            }
            for (int rep = 0; rep < PROBE_CONV; ++rep) for (int it = gw; it < NCV; it += NGW) conv_run(args, layer, it, lane);
        } else if (ph == 2) {
            const int NOUT = HB * 4 * NCB + (layer == 0 ? 4 : 0);
            for (int rep = 0; rep < PROBE_RET; ++rep) for (int j = bid; j < NOUT; j += G) {
                if (j < HB * 4 * NCB) { const int c = NCB - 1 - j / (HB * 4), bh = j % (HB * 4); ret_out_unit(args, make_chunk(args.ws, bh >> 2, c), bh & 3, KV + (size_t)(bh * NCB) * KV_IMG, c, KVM + (size_t)(bh & 3) * KV_IMG, lds, tid); }
                else { const int hd = j - HB * 4 * NCB; ret_out_unit(args, make_chunk(args.ws, 0, -1), hd, KV, 0, nullptr, lds, tid); }
            }
        } else if (ph == 3) {
            if (layer == 0 && wave == 0 && bid < D / 16) meta_branch_task(args, layer, bid, lane);
            pg8::Gemm g{(const pg8::bf16_t*)(args.ws + WS_BR), (const pg8::bf16_t*)(args.ws + WS_WBR + layer * WBR_BYTES), MH, D, BRW};
            pg8::StaticOrder S; S.init(MH, D, G, bid);
            pg8::EpiGate E{(pg8::bf16_t*)(args.ws + WS_XN), D, args.ws + WS_GATE, GATE_G_BYTES};
            pg8::gemm_phase<pg8::EpiGate, pg8::StaticOrder, true, true>(lds + RING_OFF, g, S, E, tid);
        } else if (ph == 4) {
            if (layer == 0 && wave == 0 && bid < D / 16) meta_out_task(args, layer, bid, lane);
            pg8::Gemm g{(const pg8::bf16_t*)(args.ws + WS_XN), (const pg8::bf16_t*)(args.ws + WS_WOUT + layer * WOUT_BYTES), MH, D, D};
            pg8::StaticOrder S; S.init(MH, D, G, bid);
            pg8::EpiF32 E{(float*)(args.ws + WS_PROJ), D};
            pg8::gemm_phase<pg8::EpiF32, pg8::StaticOrder, true, true>(lds + RING_OFF, g, S, E, tid);
        } else {
            p5_norm_residual(args, half, layer, gw, NGW, lane);
            if (half == 0 && layer == 1) xn_from_input(args, 1, gw, NGW, lane);
        }
    }
}
typedef const __attribute__((address_space(4))) Args* KArgsPtr;
#if defined(__HIP_DEVICE_COMPILE__)
#define LOAD_ARGS(a) KArgsPtr a##_p = (KArgsPtr)__builtin_amdgcn_kernarg_segment_ptr(); asm volatile("" : "+s"(a##_p)); Args a; \
    _Pragma("unroll") for (int _i = 0; _i < 10; ++_i) a.in[_i] = a##_p->in[_i]; a.out = a##_p->out; a.ws = a##_p->ws; a.ph_lo = a##_p->ph_lo; a.ph_hi = a##_p->ph_hi
#else
#define LOAD_ARGS(a) const Args a = args
#endif

__global__ void __launch_bounds__(NTHR, 2) fwd_kernel(Args args) {
    extern __shared__ __attribute__((aligned(16))) unsigned char lds_raw[];
    LAS unsigned char* lds = (LAS unsigned char*)lds_raw;
    for (int u = threadIdx.x; u < (LDS_BYTES - LDSCTL_OFF) / 4; u += NTHR) ((LAS unsigned*)(lds + LDSCTL_OFF))[u] = 0u;
    __syncthreads();
    const int lo = args.ph_lo, hi = args.ph_hi;
#if MK_PER_STEP
    run_step(args, lo, lds, (int)threadIdx.x, (int)blockIdx.x, (int)gridDim.x);
#else
    (void)xcd_barrier_post((unsigned*)((gu32*)(args.ws + WS_CTL) + CW_BAR), (volatile LAS unsigned*)(lds + MISC_OFF) + 8);
#define GRID_BARRIER() do { LOAD_ARGS(b); XcdBarrier bar; bar.bar = (unsigned*)((gu32*)(b.ws + WS_CTL) + CW_BAR); bar.x = xb_xcc_id(); bar.st = (volatile LAS unsigned*)(lds + MISC_OFF) + 8; xcd_barrier(bar); } while (0)
    int s0 = lo;
    const int wave_s = __builtin_amdgcn_readfirstlane((int)threadIdx.x >> 6);
    if (s0 == 0) {
        { LOAD_ARGS(a); run_step(a, 0, lds, (int)threadIdx.x, (int)blockIdx.x, (int)gridDim.x); }
        if (hi > 1) GRID_BARRIER();
        s0 = 1;
    }
    for (int s = s0; s < hi; ++s) {
        LAS unsigned char* ldsq = lds; asm volatile("" : "+s"(ldsq));
        int bid = blockIdx.x, gsz = gridDim.x; asm volatile("" : "+s"(bid), "+s"(gsz));
        int tid; asm volatile("v_mbcnt_lo_u32_b32 %0, -1, 0\n\tv_mbcnt_hi_u32_b32 %0, -1, %0\n\tv_lshl_add_u32 %0, %1, 6, %0" : "=&v"(tid) : "s"(wave_s));
        int sq = s; asm volatile("" : "+s"(sq));
        if (sq == 0) continue;
        { LOAD_ARGS(a); run_step(a, sq, ldsq, tid, bid, gsz); }
#if PROBE_REP >= 0
        if ((sq - 1) % NPH == PROBE_REP) { GRID_BARRIER(); LOAD_ARGS(a); run_step(a, sq, ldsq, tid, bid, gsz); }
#endif
        if (s + 1 < hi) GRID_BARRIER();
    }
#endif
}

extern "C" void kernel_launch(void* const* d_in, const int* in_sizes, int n_in, void* d_out, int out_size, void* d_ws, size_t ws_size, hipStream_t stream) {
    static int grid = 0;
    if (grid == 0) {
        if (n_in != 10 || in_sizes[0] != BATCH * SEQ * D || out_size != BATCH * SEQ * D || ws_size < WS_END) { fprintf(stderr, "kernel_launch: unexpected shapes (n_in %d in0 %d out %d ws %zu)\n", n_in, n_in > 0 ? in_sizes[0] : -1, out_size, ws_size); grid = -1; return; }
        int dev = 0, cus = 0;
        if (hipGetDevice(&dev) != hipSuccess || hipDeviceGetAttribute(&cus, hipDeviceAttributeMultiprocessorCount, dev) != hipSuccess) { grid = -1; return; }
        if (hipFuncSetAttribute((const void*)fwd_kernel, hipFuncAttributeMaxDynamicSharedMemorySize, LDS_BYTES) != hipSuccess) { fprintf(stderr, "kernel_launch: hipFuncSetAttribute failed\n"); grid = -1; return; }
        (void)hipGetLastError();
        grid = cus;
    }
    if (grid < 0) return;
    if (hipMemsetAsync((char*)d_ws + WS_CTL, 0, CTL_ZERO_BYTES, stream) != hipSuccess) return;
    Args a{};
    for (int i = 0; i < 10; ++i) a.in[i] = (const float*)d_in[i];
    a.out = (float*)d_out; a.ws = (unsigned char*)d_ws;
#if MK_PER_STEP
    for (int s = 0; s < NSTEPS; ++s) { a.ph_lo = s; a.ph_hi = s + 1; hipLaunchKernelGGL(fwd_kernel, dim3(grid), dim3(NTHR), LDS_BYTES, stream, a); }
#else
    a.ph_lo = 0; a.ph_hi = NSTEPS; hipLaunchKernelGGL(fwd_kernel, dim3(grid), dim3(NTHR), LDS_BYTES, stream, a);
#endif
}
```
